# Optimizing an MI355X kernel written in HIP

```python
import math
import jax, jax.numpy as jnp
from jax import lax
import numpy as np

D_MODEL = 1024
BATCH = 4
SEQ = 4096
DEPTH = 2

N_MIXERS = 2
N_HEADS = 16
HEAD_DIM = D_MODEL // N_HEADS
Q_BLOCK = 128
SSM_GROUP = 16
N_GROUPS = D_MODEL // SSM_GROUP
SSM_STATE = 64
D_FF = 4 * D_MODEL
DT_MIN = 0.001
DT_MAX = 0.1
EPS = 1e-6
N_ATTN_LAYERS = (DEPTH + 1) // 2
N_SSM_LAYERS = DEPTH // 2

kernel_name = "fox_s5_interleaved_hybrid"


def rms_norm(x, g):
    xf = x.astype(jnp.float32)
    y = xf * lax.rsqrt(jnp.mean(xf * xf, axis=-1, keepdims=True) + EPS)
    return (y * g.astype(jnp.float32)).astype(x.dtype)


def fox_attention(h, w_in, b_f, q_g, k_g, w_out):
    B, S, D = h.shape
    proj = h @ w_in
    q, k, v, f = jnp.split(proj, [D, 2 * D, 3 * D], axis=-1)
    q = rms_norm(q.reshape(B, S, N_HEADS, HEAD_DIM), q_g)
    k = rms_norm(k.reshape(B, S, N_HEADS, HEAD_DIM), k_g)
    v = v.reshape(B, S, N_HEADS, HEAD_DIM)
    log_f = jax.nn.log_sigmoid((f + b_f).astype(jnp.float32))
    c = jnp.cumsum(log_f, axis=1).transpose(0, 2, 1)
    q = q.transpose(0, 2, 1, 3)
    k = k.transpose(0, 2, 1, 3)
    v = v.transpose(0, 2, 1, 3)
    nb = S // Q_BLOCK
    qb = q.reshape(B, N_HEADS, nb, Q_BLOCK, HEAD_DIM).transpose(2, 0, 1, 3, 4)
    cb = c.reshape(B, N_HEADS, nb, Q_BLOCK).transpose(2, 0, 1, 3)
    k_pos = jnp.arange(S)
    scale = 1.0 / math.sqrt(HEAD_DIM)

    def block(args):
        q_i, c_i, i = args
        q_pos = i * Q_BLOCK + jnp.arange(Q_BLOCK)
        s = jnp.einsum('bhqd,bhkd->bhqk', q_i, k).astype(jnp.float32) * scale
        s = s + c_i[..., :, None] - c[:, :, None, :]
        s = jnp.where(k_pos[None, :] <= q_pos[:, None], s, -jnp.inf)
        p = jax.nn.softmax(s, axis=-1)
        return jnp.einsum('bhqk,bhkd->bhqd', p.astype(v.dtype), v)

    o = lax.map(block, (qb, cb, jnp.arange(nb)))
    o = o.transpose(1, 0, 3, 2, 4).reshape(B, S, D)
    return o @ w_out


def _scan_combine(e1, e2):
    a1r, a1i, b1r, b1i = e1
    a2r, a2i, b2r, b2i = e2
    ar = a1r * a2r - a1i * a2i
    ai = a1r * a2i + a1i * a2r
    br = a2r * b1r - a2i * b1i + b2r
    bi = a2r * b1i + a2i * b1r + b2i
    return (ar, ai, br, bi)


def s5_layer(h, w_in, a_re, a_im, b_re, b_im, c_re, c_im, log_dt, d_skip, w_glu):
    B, S, D = h.shape
    f32 = jnp.float32
    u = (h @ w_in).astype(f32)
    ug = u.reshape(B, S, N_GROUPS, SSM_GROUP)
    a_re = a_re.astype(f32); a_im = a_im.astype(f32)
    dt = jnp.exp(log_dt.astype(f32))[:, None]
    mag = jnp.exp(dt * a_re)
    ab_re = mag * jnp.cos(dt * a_im)
    ab_im = mag * jnp.sin(dt * a_im)
    num_re = ab_re - 1.0
    num_im = ab_im
    den = a_re * a_re + a_im * a_im
    s_re = (num_re * a_re + num_im * a_im) / den
    s_im = (num_im * a_re - num_re * a_im) / den
    b_re = b_re.astype(f32); b_im = b_im.astype(f32)
    bb_re = s_re[..., None] * b_re - s_im[..., None] * b_im
    bb_im = s_re[..., None] * b_im + s_im[..., None] * b_re
    bu_re = jnp.einsum('bsgc,gpc->bsgp', ug, bb_re)
    bu_im = jnp.einsum('bsgc,gpc->bsgp', ug, bb_im)
    ar = jnp.broadcast_to(ab_re, bu_re.shape)
    ai = jnp.broadcast_to(ab_im, bu_re.shape)
    _, _, xr, xi = lax.associative_scan(_scan_combine, (ar, ai, bu_re, bu_im), axis=1)
    y = (jnp.einsum('bsgp,gcp->bsgc', xr, c_re.astype(f32))
         - jnp.einsum('bsgp,gcp->bsgc', xi, c_im.astype(f32)))
    y = y.reshape(B, S, D) + d_skip.astype(f32) * u
    z = jax.nn.gelu(y).astype(h.dtype)
    val, gate = jnp.split(z @ w_glu, 2, axis=-1)
    return val * jax.nn.sigmoid(gate)


def sqrelu_mlp(h, w1, w2):
    return jnp.square(jax.nn.relu(h @ w1)) @ w2


def setup_inputs(seed: int = 0) -> dict:
    key = jax.random.key(seed)
    ks = jax.random.split(key, 20)
    D, H, G, P, C = D_MODEL, N_HEADS, N_GROUPS, SSM_STATE, SSM_GROUP
    nA, nS = N_ATTN_LAYERS, N_SSM_LAYERS
    nrm = jax.random.normal
    x = nrm(ks[0], (BATCH, SEQ, D), jnp.float32)
    norm_mix_g = 1.0 + 0.02 * nrm(ks[1], (DEPTH, D), jnp.float32)
    norm_mlp_g = 1.0 + 0.02 * nrm(ks[2], (DEPTH, D), jnp.float32)
    attn_w_in = nrm(ks[3], (nA, D, 3 * D + H), jnp.float32) * D ** -0.5
    attn_b_f = jax.random.uniform(ks[4], (nA, H), jnp.float32, 1.0, 6.0)
    attn_q_g = 1.0 + 0.02 * nrm(ks[5], (nA, HEAD_DIM), jnp.float32)
    attn_k_g = 1.0 + 0.02 * nrm(ks[6], (nA, HEAD_DIM), jnp.float32)
    attn_w_out = nrm(ks[7], (nA, D, D), jnp.float32) * D ** -0.5
    ssm_w_in = nrm(ks[8], (nS, D, D), jnp.float32) * D ** -0.5
    ssm_a_re = -0.5 * (1.0 + 0.02 * nrm(ks[9], (nS, G, P), jnp.float32))
    ssm_a_im = jnp.broadcast_to(jnp.pi * jnp.arange(P, dtype=jnp.float32), (nS, G, P))
    ssm_b_re = nrm(ks[10], (nS, G, P, C), jnp.float32) * (2.0 * C) ** -0.5
    ssm_b_im = nrm(ks[11], (nS, G, P, C), jnp.float32) * (2.0 * C) ** -0.5
    ssm_c_re = nrm(ks[12], (nS, G, C, P), jnp.float32) * (2.0 * P) ** -0.5
    ssm_c_im = nrm(ks[13], (nS, G, C, P), jnp.float32) * (2.0 * P) ** -0.5
    ssm_log_dt = jax.random.uniform(ks[14], (nS, G), jnp.float32,
                                    math.log(DT_MIN), math.log(DT_MAX))
    ssm_d = nrm(ks[15], (nS, D), jnp.float32)
    ssm_w_glu = nrm(ks[16], (nS, D, 2 * D), jnp.float32) * D ** -0.5
    mlp_w1 = nrm(ks[17], (DEPTH, D, D_FF), jnp.float32) * D ** -0.5
    mlp_w2 = nrm(ks[18], (DEPTH, D_FF, D), jnp.float32) * D_FF ** -0.5
    return {"x": x, "norm_mix_g": norm_mix_g, "norm_mlp_g": norm_mlp_g,
            "attn_w_in": attn_w_in, "attn_b_f": attn_b_f, "attn_q_g": attn_q_g,
            "attn_k_g": attn_k_g, "attn_w_out": attn_w_out,
            "ssm_w_in": ssm_w_in, "ssm_a_re": ssm_a_re, "ssm_a_im": ssm_a_im,
            "ssm_b_re": ssm_b_re, "ssm_b_im": ssm_b_im, "ssm_c_re": ssm_c_re,
            "ssm_c_im": ssm_c_im, "ssm_log_dt": ssm_log_dt, "ssm_d": ssm_d,
            "ssm_w_glu": ssm_w_glu, "mlp_w1": mlp_w1, "mlp_w2": mlp_w2}


def reference(x, norm_mix_g, norm_mlp_g, attn_w_in, attn_b_f, attn_q_g, attn_k_g,
              attn_w_out, ssm_w_in, ssm_a_re, ssm_a_im, ssm_b_re, ssm_b_im,
              ssm_c_re, ssm_c_im, ssm_log_dt, ssm_d, ssm_w_glu, mlp_w1, mlp_w2):
    for i in range(DEPTH):
        h = rms_norm(x, norm_mix_g[i])
        j = i // N_MIXERS
        if i % N_MIXERS == 0:
            mix = fox_attention(h, attn_w_in[j], attn_b_f[j], attn_q_g[j],
                                attn_k_g[j], attn_w_out[j])
        else:
            mix = s5_layer(h, ssm_w_in[j], ssm_a_re[j], ssm_a_im[j], ssm_b_re[j],
                           ssm_b_im[j], ssm_c_re[j], ssm_c_im[j], ssm_log_dt[j],
                           ssm_d[j], ssm_w_glu[j])
        x = x + mix
        h = rms_norm(x, norm_mlp_g[i])
        x = x + sqrelu_mlp(h, mlp_w1[i], mlp_w2[i])
    return x
```

```cpp
#include <hip/hip_runtime.h>
#include <hip/hip_cooperative_groups.h>
#include <hip/hip_bf16.h>
#include <cstdio>
#include <cstdint>
#include <cmath>
namespace cg = cooperative_groups;

namespace pg8 {
#define PG8_LAS __attribute__((address_space(3)))
typedef unsigned short bf16_t;
typedef short bf16x8 __attribute__((ext_vector_type(8)));
typedef float f32x4 __attribute__((ext_vector_type(4)));
typedef unsigned u32x4 __attribute__((ext_vector_type(4)));
constexpr int BM = 256, BK = 64, HALF = 128, HTB = HALF * BK * 2  , STAGE_BYTES = 8 * HTB, NXCD = 8, WGM = 8;

__host__ __device__ __forceinline__ int lds_byte(int r, int c) { const int st = (r >> 4) * 2 + (c >> 5), rr = r & 15, cc = c & 31, ob = rr * 64 + cc * 2; return st * 1024 + (ob ^ (((ob >> 9) & 1) << 5)); }
__host__ __device__ __forceinline__ void stage_rc(int b, int& R, int& C) { const int st = b / 1024, sb = b % 1024, swz = sb ^ (((sb >> 9) & 1) << 5); R = (st >> 1) * 16 + swz / 64; C = (st & 1) * 32 + (swz % 64) / 2; }
__host__ __device__ __forceinline__ int perm32(int rho) { const int n = rho >> 4, i = rho & 15; return 8 * (i >> 2) + 4 * n + (i & 3); }

struct Unit { int pm, pn; };
struct Gemm { const bf16_t* A; const bf16_t* Bt; int M, N, K, lda, ldb; };

struct StaticOrder {
    int nM, nN, nwg, G, c;
    __host__ __device__ void init(int M, int N, int G_, int c_) { nM = M / BM; nN = N / BM; nwg = nM * nN; G = G_; c = c_; }
    __host__ __device__ bool next(int i, Unit& u) const {
        const long L = (long)i * G + c; if (L >= nwg) return false;
        int wgid = (int)L; { const int q = nwg / NXCD, r = nwg % NXCD, xcd = wgid % NXCD, off = wgid / NXCD; wgid = (xcd < r ? xcd * (q + 1) : r * (q + 1) + (xcd - r) * q) + off; }
        const int nig = WGM * nN, gid = wgid / nig, fm = gid * WGM, gsz = (nM - fm) < WGM ? (nM - fm) : WGM;
        u.pm = fm + ((wgid % nig) % gsz); u.pn = (wgid % nig) / gsz; return true;
    }
};
struct BatchOrder {
    int n, G, c;
    __host__ __device__ void init(int n_, int G_, int c_) { n = n_; G = G_; c = c_; }
    __host__ __device__ bool next(int i, Unit& u) const { const long L = (long)i * G + c; if (L >= n) return false; u.pm = (int)L; u.pn = (int)(L >> 2); return true; }
};

__device__ __forceinline__ unsigned cvt_pk_bf16(float lo, float hi) { unsigned r; asm volatile("v_cvt_pk_bf16_f32 %0, %1, %2" : "=v"(r) : "v"(lo), "v"(hi)); return r; }
__device__ __forceinline__ u32x4 pack8(const f32x4 v0, const f32x4 v1) { u32x4 w; w.x = cvt_pk_bf16(v0[0], v0[1]); w.y = cvt_pk_bf16(v0[2], v0[3]); w.z = cvt_pk_bf16(v1[0], v1[1]); w.w = cvt_pk_bf16(v1[2], v1[3]); return w; }
__device__ __forceinline__ float fq_sum(float s) {
    auto a = __builtin_amdgcn_permlane16_swap(__float_as_uint(s), __float_as_uint(s), false, false); s = __uint_as_float(a[0]) + __uint_as_float(a[1]);
    auto b = __builtin_amdgcn_permlane32_swap(__float_as_uint(s), __float_as_uint(s), false, false); return __uint_as_float(b[0]) + __uint_as_float(b[1]); }
__device__ __forceinline__ float bf2f(unsigned short h) { return __uint_as_float(((unsigned)h) << 16); }
__device__ __forceinline__ float sq4(const f32x4 x) { return (x[0] * x[0] + x[1] * x[1]) + (x[2] * x[2] + x[3] * x[3]); }
__device__ __forceinline__ float sigmoid_f(float x) { return __builtin_amdgcn_rcpf(1.0f + __builtin_amdgcn_exp2f(-1.4426950408889634f * x)); }
__device__ __forceinline__ float gelu_tanh_f(float y) { const float a = y * (1.0f + 0.044715f * y * y) * (2.0f * 0.7978845608028654f); return y * sigmoid_f(a); }
constexpr float RMS_EPS = 1e-6f;

struct EpiQKV {
    static constexpr bool PERM = true, AFTER_DRAIN = false;
    bf16_t* Q; size_t kv_stride; PG8_LAS const float* gl;
    __device__ __forceinline__ void operator()(const f32x4 (&acc)[2][2][4][2], const Unit& u, int wr, int wc, int fr, int fq) const {
        const int t = u.pn >> 2;
        bf16_t* base = Q + (size_t)t * kv_stride;
        int row0 = u.pm * BM + wr * 64 + fr, col0 = (u.pn & 3) * BM + wc * 64 + 8 * fq;
        asm volatile("" : "+v"(row0), "+v"(col0));
        f32x4 g[2][2];
#pragma unroll
        for (int bj = 0; bj < 2; ++bj)
#pragma unroll
            for (int n = 0; n < 2; ++n) g[bj][n] = (f32x4){1.f, 1.f, 1.f, 1.f};
        if (t < 2) { PG8_LAS const float* gs = gl + 64 * t + 8 * fq;
#pragma unroll
            for (int bj = 0; bj < 2; ++bj)
#pragma unroll
                for (int n = 0; n < 2; ++n) g[bj][n] = *(PG8_LAS const f32x4*)(gs + 32 * bj + 4 * n); }
#pragma unroll
        for (int ai = 0; ai < 2; ++ai)
#pragma unroll
            for (int m = 0; m < 4; ++m) { bf16_t* rowp = base + (size_t)(row0 + ai * HALF + m * 16) * 1024 + col0;
                float r = 1.f;
                if (t < 2) { float s = (sq4(acc[ai][0][m][0]) + sq4(acc[ai][0][m][1])) + (sq4(acc[ai][1][m][0]) + sq4(acc[ai][1][m][1]));
                    s = fq_sum(s); r = __builtin_amdgcn_rsqf(s * (1.0f / 64.0f) + RMS_EPS); }
#pragma unroll
                for (int bj = 0; bj < 2; ++bj) *(u32x4*)(rowp + bj * 32) = pack8(acc[ai][bj][m][0] * r * g[bj][0], acc[ai][bj][m][1] * r * g[bj][1]); }
    }
};

__device__ __forceinline__ void unpack8(const u32x4 w, f32x4& v0, f32x4& v1) {
    v0[0] = __uint_as_float(w.x << 16); v0[1] = __uint_as_float(w.x & 0xffff0000u); v0[2] = __uint_as_float(w.y << 16); v0[3] = __uint_as_float(w.y & 0xffff0000u);
    v1[0] = __uint_as_float(w.z << 16); v1[1] = __uint_as_float(w.z & 0xffff0000u); v1[2] = __uint_as_float(w.w << 16); v1[3] = __uint_as_float(w.w & 0xffff0000u); }
struct EpiResid {
    static constexpr bool PERM = true, AFTER_DRAIN = false;
    const float* basef; const bf16_t* baseb; float* out; bf16_t* xb; float* rowss; const float* unss; const float* ung; const float* accss;
    __device__ __forceinline__ void operator()(const f32x4 (&acc)[2][2][4][2], const Unit& u, int wr, int wc, int fr, int fq) const {
        const int row0 = u.pm * BM + wr * 64 + fr, col0 = u.pn * BM + wc * 32 + 8 * fq;
        f32x4 ginv[2][2];
#pragma unroll
        for (int bj = 0; bj < 2; ++bj)
#pragma unroll
            for (int n = 0; n < 2; ++n) { ginv[bj][n] = (f32x4){1.f, 1.f, 1.f, 1.f}; if (unss) { const f32x4 gg = *(const f32x4*)(ung + col0 + bj * HALF + 4 * n);
#pragma unroll
                for (int i = 0; i < 4; ++i) ginv[bj][n][i] = __builtin_amdgcn_rcpf(gg[i]); } }
#pragma unroll
        for (int ai = 0; ai < 2; ++ai)
#pragma unroll
            for (int m = 0; m < 4; ++m) { const int row = row0 + ai * HALF + m * 16; const size_t off = (size_t)row * 1024 + col0; float sq = 0.f;
                const float asc = accss ? __builtin_amdgcn_rcpf(accss[row] * (1.0f / 1024.0f) + RMS_EPS) : 1.0f;
#pragma unroll
                for (int bj = 0; bj < 2; ++bj) {
                    f32x4 b0, b1;
                    if (basef) { b0 = *(const f32x4*)(basef + off + bj * HALF); b1 = *(const f32x4*)(basef + off + bj * HALF + 4); }
                    else { unpack8(*(const u32x4*)(baseb + off + bj * HALF), b0, b1);
                        if (unss) { const float ri = __builtin_amdgcn_sqrtf(unss[row] * (1.0f / 1024.0f) + RMS_EPS); b0 = b0 * ri * ginv[bj][0]; b1 = b1 * ri * ginv[bj][1]; } }
                    const f32x4 v0 = acc[ai][bj][m][0] * asc + b0, v1 = acc[ai][bj][m][1] * asc + b1;
                    if (out) { __builtin_nontemporal_store(v0, (f32x4*)(out + off + bj * HALF)); __builtin_nontemporal_store(v1, (f32x4*)(out + off + bj * HALF + 4)); }
                    if (xb) *(u32x4*)(xb + off + bj * HALF) = pack8(v0, v1);
                    sq += sq4(v0) + sq4(v1); }
                if (rowss) { sq = fq_sum(sq); if (fq == 0) atomicAdd(rowss + row, sq); } }
    }
};
struct EpiGlu {
    static constexpr bool PERM = true, AFTER_DRAIN = false;
    bf16_t* xb; float* rowss;
    __device__ __forceinline__ void operator()(const f32x4 (&acc)[2][2][4][2], const Unit& u, int wr, int wc, int fr, int fq) const {
        const int row0 = u.pm * BM + wr * 64 + fr, col0 = u.pn * HALF + wc * 32 + 8 * fq;
#pragma unroll
        for (int ai = 0; ai < 2; ++ai)
#pragma unroll
            for (int m = 0; m < 4; ++m) { const int row = row0 + ai * HALF + m * 16; const size_t off = (size_t)row * 1024 + col0;
                f32x4 v[2]; unpack8(*(const u32x4*)(xb + off), v[0], v[1]);
#pragma unroll
                for (int n = 0; n < 2; ++n) { const f32x4 val = acc[ai][0][m][n], gt = acc[ai][1][m][n];
#pragma unroll
                    for (int i = 0; i < 4; ++i) v[n][i] += val[i] * sigmoid_f(gt[i]); }
                *(u32x4*)(xb + off) = pack8(v[0], v[1]);
                float sq = sq4(v[0]) + sq4(v[1]);
                sq = fq_sum(sq); if (fq == 0) atomicAdd(rowss + row, sq); }
    }
};
struct EpiSqrelu {
    static constexpr bool PERM = true, AFTER_DRAIN = false;
    bf16_t* O; int ldc;
    __device__ __forceinline__ void operator()(const f32x4 (&acc)[2][2][4][2], const Unit& u, int wr, int wc, int fr, int fq) const {
        const int row0 = u.pm * BM + wr * 64 + fr, col0 = u.pn * BM + wc * 32 + 8 * fq;
#pragma unroll
        for (int ai = 0; ai < 2; ++ai)
#pragma unroll
            for (int m = 0; m < 4; ++m) { const int row = row0 + ai * HALF + m * 16;
                bf16_t* rowp = O + (size_t)row * ldc + col0;
#pragma unroll
                for (int bj = 0; bj < 2; ++bj) { f32x4 v0 = acc[ai][bj][m][0], v1 = acc[ai][bj][m][1];
#pragma unroll
                    for (int i = 0; i < 4; ++i) { const float a = fmaxf(v0[i], 0.f), b = fmaxf(v1[i], 0.f); v0[i] = a * a; v1[i] = b * b; }
                    *(u32x4*)(rowp + bj * HALF) = pack8(v0, v1); } }
    }
};
struct EpiU {
    static constexpr bool PERM = true, AFTER_DRAIN = false;
    bf16_t* AA; const float* rowss;
    __device__ __forceinline__ void operator()(const f32x4 (&acc)[2][2][4][2], const Unit& u, int wr, int wc, int fr, int fq) const {
        const int row0 = u.pm * BM + wr * 64 + fr, col0 = u.pn * BM + wc * 32 + 8 * fq;
#pragma unroll
        for (int ai = 0; ai < 2; ++ai)
#pragma unroll
            for (int m = 0; m < 4; ++m) { const int row = row0 + ai * HALF + m * 16; const float rs = __builtin_amdgcn_rsqf(rowss[row] * (1.0f / 1024.0f) + RMS_EPS);
                const int kc = row >> 4, s = row & 15;
#pragma unroll
                for (int bj = 0; bj < 2; ++bj) { const int n = col0 + bj * HALF, g = n >> 4, c0 = n & 15;
                    *(u32x4*)(AA + ((size_t)(g * 1024 + kc) * 384 + s * 16 + c0)) = pack8(acc[ai][bj][m][0] * rs, acc[ai][bj][m][1] * rs); } }
    }
};
struct EpiS {
    static constexpr bool PERM = true, AFTER_DRAIN = false;
    float* S;
    __device__ __forceinline__ void operator()(const f32x4 (&acc)[2][2][4][2], const Unit& u, int wr, int wc, int fr, int fq) const {
        const int row0 = u.pm * BM + wr * 64 + fr, col0 = wc * 32 + 8 * fq;
#pragma unroll
        for (int ai = 0; ai < 2; ++ai)
#pragma unroll
            for (int m = 0; m < 4; ++m) { float* p = S + (size_t)(row0 + ai * HALF + m * 16) * 128 + col0;
                *(f32x4*)p = acc[ai][0][m][0]; *(f32x4*)(p + 4) = acc[ai][0][m][1]; }
    }
};
constexpr int SL_PITCH = 132;
struct EpiSLds {
    static constexpr bool PERM = true, AFTER_DRAIN = true;
    PG8_LAS float* SL;
    __device__ __forceinline__ void operator()(const f32x4 (&acc)[2][2][4][2], const Unit& u, int wr, int wc, int fr, int fq) const {
        const int row0 = wr * 64 + fr, col0 = wc * 32 + 8 * fq;
#pragma unroll
        for (int ai = 0; ai < 2; ++ai)
#pragma unroll
            for (int m = 0; m < 4; ++m) { PG8_LAS float* p = SL + (row0 + ai * HALF + m * 16) * SL_PITCH + col0;
                *(PG8_LAS f32x4*)p = acc[ai][0][m][0]; *(PG8_LAS f32x4*)(p + 4) = acc[ai][0][m][1]; }
    }
};
struct EpiY {
    static constexpr bool PERM = true, AFTER_DRAIN = false;
    bf16_t* Z;
    __device__ __forceinline__ void operator()(const f32x4 (&acc)[2][2][4][2], const Unit& u, int wr, int wc, int fr, int fq) const {
        int row0 = u.pm * BM + wr * 64 + fr, n0 = wc * 32 + 8 * fq; const int g = u.pn;
        asm volatile("" : "+v"(row0), "+v"(n0));
#pragma unroll
        for (int ai = 0; ai < 2; ++ai)
#pragma unroll
            for (int m = 0; m < 4; ++m) { const int row = row0 + ai * HALF + m * 16, kc = row & 1023;
#pragma unroll
                for (int bj = 0; bj < 2; ++bj) { const int n = n0 + bj * HALF, j = n >> 4, c0 = n & 15, ch = 16 * g + c0;
                    f32x4 v0 = acc[ai][bj][m][0], v1 = acc[ai][bj][m][1];
#pragma unroll
                    for (int i = 0; i < 4; ++i) { v0[i] = gelu_tanh_f(v0[i]); v1[i] = gelu_tanh_f(v1[i]); }
                    *(u32x4*)(Z + (size_t)(kc * 16 + j) * 1024 + ch) = pack8(v0, v1); } }
    }
};

template <class Epi, class Sched>
__device__ __forceinline__ void gemm_phase(PG8_LAS unsigned char* lds, const Gemm g, const Sched& S, const Epi& E) {
    int tid_ = threadIdx.x; asm volatile("" : "+v"(tid_));
    const int tid = tid_, wid = __builtin_amdgcn_readfirstlane(tid >> 6), lane = tid & 63, wr = wid >> 2, wc = wid & 3, fr = lane & 15, fq = lane >> 4;
    const int K = g.K, nt = K / BK;
    unsigned voffA[2], voffB[2];
#pragma unroll
    for (int i = 0; i < 2; ++i) { int R, C; stage_rc(tid * 16 + i * 8192, R, C); const int Rb = Epi::PERM ? ((R & ~31) + perm32(R & 31)) : R;
        voffA[i] = (unsigned)(R * g.lda + C) * 2u; voffB[i] = (unsigned)(Rb * g.ldb + C) * 2u; }
    const size_t kstep = (size_t)(BK * 2);
    const size_t hA = (size_t)HALF * g.lda * 2, hB = (size_t)HALF * g.ldb * 2;
    const size_t tA = 2 * hA, tB = 2 * hB;
    const unsigned ldsw = (unsigned)wid * 1024u;
    const int aoff = lds_byte(wr * 64 + fr, fq * 8), boff = lds_byte(wc * 32 + fr, fq * 8);
#define PG8_SA(b, h) (((b) * 2 + (h)) * HTB)
#define PG8_SB(b, h) ((4 + (b) * 2 + (h)) * HTB)
#define PG8_STAGE(bufoff, gbase, voff) do { _Pragma("unroll") for (int _i = 0; _i < 2; ++_i) \
        __builtin_amdgcn_global_load_lds((const unsigned*)((const char*)(gbase) + (voff)[_i]), (PG8_LAS unsigned*)(lds + (bufoff) + ldsw + _i * 8192), 16, 0, 0); } while (0)
#define PG8_LDA(dst, b, h) do { _Pragma("unroll") for (int m = 0; m < 4; ++m) _Pragma("unroll") for (int k = 0; k < 2; ++k) dst[m][k] = *(const PG8_LAS bf16x8*)(lds + PG8_SA(b, h) + aoff + m * 2048 + k * 1024); } while (0)
#define PG8_LDB(dst, b, h) do { _Pragma("unroll") for (int n = 0; n < 2; ++n) _Pragma("unroll") for (int k = 0; k < 2; ++k) dst[n][k] = *(const PG8_LAS bf16x8*)(lds + PG8_SB(b, h) + boff + n * 2048 + k * 1024); } while (0)
#define PG8_MMA(ai, bj, At, Bt) do { __builtin_amdgcn_s_setprio(1); _Pragma("unroll") for (int m = 0; m < 4; ++m) _Pragma("unroll") for (int n = 0; n < 2; ++n) _Pragma("unroll") for (int k = 0; k < 2; ++k) \
        acc[ai][bj][m][n] = __builtin_amdgcn_mfma_f32_16x16x32_bf16(Bt[n][k], At[m][k], acc[ai][bj][m][n], 0, 0, 0); __builtin_amdgcn_s_setprio(0); } while (0)
#define PG8_WAIT_V(n) asm volatile("s_waitcnt vmcnt(" #n ")" ::: "memory")
#define PG8_WAIT_L(n) asm volatile("s_waitcnt lgkmcnt(" #n ")" ::: "memory")
#define PG8_BAR __builtin_amdgcn_s_barrier()
#define PG8_SCHED __builtin_amdgcn_sched_barrier(0)
    Unit cur, nxt; int ui = 0;
    if (!S.next(0, cur)) return;
    f32x4 acc[2][2][4][2];
#pragma unroll
    for (int a = 0; a < 2; ++a)
#pragma unroll
        for (int b = 0; b < 2; ++b)
#pragma unroll
            for (int m = 0; m < 4; ++m)
#pragma unroll
                for (int n = 0; n < 2; ++n) acc[a][b][m][n] = (f32x4){0.f, 0.f, 0.f, 0.f};
    bf16x8 At[4][2], B0[2][2], B1[2][2];
    const char* cA = (const char*)g.A + (size_t)cur.pm * tA; const char* cB = (const char*)g.Bt + (size_t)cur.pn * tB;
    PG8_STAGE(PG8_SB(0, 0), cB, voffB); PG8_STAGE(PG8_SB(0, 1), cB + hB, voffB); PG8_STAGE(PG8_SA(0, 0), cA, voffA); PG8_STAGE(PG8_SA(0, 1), cA + hA, voffA);
    if (wr == 1) PG8_BAR;
    PG8_WAIT_V(2); PG8_BAR;
    PG8_STAGE(PG8_SB(1, 0), cB + kstep, voffB); PG8_STAGE(PG8_SA(1, 0), cA + kstep, voffA); PG8_STAGE(PG8_SB(1, 1), cB + hB + kstep, voffB);
    PG8_WAIT_V(6); PG8_BAR;
    for (;;) {
        const bool has_next = S.next(ui + 1, nxt);
        const char* nA = has_next ? (const char*)g.A + (size_t)nxt.pm * tA : cA; const char* nB = has_next ? (const char*)g.Bt + (size_t)nxt.pn * tB : cB;
        for (int t = 0; t < nt; t += 2) {
            const bool last = (t == nt - 2);
            const char* a1 = cA + (size_t)(t + 1) * kstep;
            const char* a2 = last ? nA : cA + (size_t)(t + 2) * kstep; const char* b2 = last ? nB : cB + (size_t)(t + 2) * kstep;
            const char* a3 = a2 + kstep; const char* b3 = b2 + kstep;
            PG8_LDB(B0, 0, 0); PG8_LDB(B1, 0, 1); PG8_SCHED; PG8_LDA(At, 0, 0); PG8_STAGE(PG8_SA(1, 1), a1 + hA, voffA);
            PG8_WAIT_V(8); PG8_WAIT_L(0); PG8_BAR; PG8_MMA(0, 0, At, B0); PG8_MMA(0, 1, At, B1); PG8_BAR; PG8_SCHED;
            PG8_LDA(At, 0, 1); PG8_STAGE(PG8_SB(0, 0), b2, voffB); PG8_STAGE(PG8_SB(0, 1), b2 + hB, voffB); PG8_STAGE(PG8_SA(0, 0), a2, voffA);
            PG8_WAIT_V(8); PG8_WAIT_L(0); PG8_BAR; PG8_MMA(1, 0, At, B0); PG8_MMA(1, 1, At, B1); PG8_BAR; PG8_SCHED;
            PG8_LDB(B0, 1, 0); PG8_LDB(B1, 1, 1); PG8_SCHED; PG8_LDA(At, 1, 0); PG8_STAGE(PG8_SA(0, 1), a2 + hA, voffA);
            PG8_WAIT_V(8); PG8_WAIT_L(0); PG8_BAR; PG8_MMA(0, 0, At, B0); PG8_MMA(0, 1, At, B1); PG8_BAR; PG8_SCHED;
            PG8_LDA(At, 1, 1); PG8_STAGE(PG8_SB(1, 0), b3, voffB); PG8_STAGE(PG8_SB(1, 1), b3 + hB, voffB); PG8_STAGE(PG8_SA(1, 0), a3, voffA);
            PG8_WAIT_V(8); PG8_WAIT_L(0); PG8_BAR; PG8_MMA(1, 0, At, B0); PG8_MMA(1, 1, At, B1); PG8_BAR; PG8_SCHED;
        }
        if (wr == 0) PG8_BAR;
        if constexpr (!Epi::AFTER_DRAIN) E(acc, cur, wr, wc, fr, fq);
        if (!has_next) break;
#pragma unroll
        for (int a = 0; a < 2; ++a)
#pragma unroll
            for (int b = 0; b < 2; ++b)
#pragma unroll
                for (int m = 0; m < 4; ++m)
#pragma unroll
                    for (int n = 0; n < 2; ++n) acc[a][b][m][n] = (f32x4){0.f, 0.f, 0.f, 0.f};
        cur = nxt; cA = nA; cB = nB; ++ui;
        if (wr == 1) PG8_BAR;
    }
    PG8_WAIT_V(0);
    PG8_BAR;
    if constexpr (Epi::AFTER_DRAIN) E(acc, cur, wr, wc, fr, fq);
#undef PG8_SA
#undef PG8_SB
#undef PG8_STAGE
#undef PG8_LDA
#undef PG8_LDB
#undef PG8_MMA
#undef PG8_WAIT_V
#undef PG8_WAIT_L
#undef PG8_BAR
#undef PG8_SCHED
}
}

#include <hip/hip_bf16.h>
#include <cmath>
namespace attn_body {
using bf16=__hip_bfloat16;
using bf16x8=__attribute__((ext_vector_type(8)))short;
using s16x4=__attribute__((ext_vector_type(4)))short;
using f32x16=__attribute__((ext_vector_type(16)))float;
using u32x4=__attribute__((ext_vector_type(4)))unsigned;
constexpr int BATCH=4,NHEAD=16,SEQ=4096,D=64,DM=NHEAD*D;
constexpr int NW=8,QBLK=32,QB=QBLK*NW,KVBLK=64,NQB=SEQ/QB;
constexpr int ATTN_PITCH=DM, ATTN_UNIT_ROWS=QB;
__device__ __forceinline__ int crow(int r,int hi){return (r&3)+8*(r>>2)+4*hi;}
#define SBAR() __builtin_amdgcn_sched_barrier(0)
__device__ __forceinline__ void cmask(f32x16&p0,f32x16&p1,int jb,int qrel,int hi){
  const float NEG=-INFINITY; int kb=64*jb+4*hi;
  #pragma unroll
  for(int r=0;r<16;++r){int kv=kb+(r&3)+8*(r>>2); if(kv>qrel)p0[r]=NEG; if(kv+32>qrel)p1[r]=NEG;}
}

constexpr int NSLOT=3, SLOTB=8192;
constexpr int LDS_K=0, LDS_V=NSLOT*SLOTB, LDS_WS=2*NSLOT*SLOTB, LDS_OST=LDS_WS+NW*64*4, LDS_KBIAS=LDS_OST+NW*4096, LDS_BYTES=LDS_KBIAS+(SEQ+64)*4;
constexpr float C2=0.125f*1.4426950408889634f;
__device__ __forceinline__ void glds16(const void*gsrc,unsigned lds_dst){unsigned keep;
  asm volatile("s_mov_b32 %0, m0\n\ts_mov_b32 m0, %2\n\ts_nop 0\n\tglobal_load_lds_dwordx4 %1, off\n\ts_mov_b32 m0, %0":"=&s"(keep):"v"(gsrc),"s"(lds_dst):"memory");}
__device__ __forceinline__ float max3f(float a,float b,float c){float r;asm("v_max3_f32 %0, %1, %2, %3":"=v"(r):"v"(a),"v"(b),"v"(c));return r;}
__device__ __forceinline__ float max2f(float a,float b){float r;asm("v_max_f32_e32 %0, %1, %2":"=v"(r):"v"(a),"v"(b));return r;}
__device__ __forceinline__ float fadd_s(float a,float b){float r;asm("v_add_f32_e32 %0, %1, %2":"=v"(r):"v"(a),"v"(b));return r;}
__device__ __forceinline__ float fsub_s(float a,float b){float r;asm("v_sub_f32_e32 %0, %1, %2":"=v"(r):"v"(a),"v"(b));return r;}
typedef float f32x2_t __attribute__((ext_vector_type(2))); typedef __bf16 bf16x2_t __attribute__((ext_vector_type(2)));
__device__ __forceinline__ unsigned cvtpk_s(float lo,float hi){f32x2_t v={lo,hi};bf16x2_t b=__builtin_convertvector(v,bf16x2_t);return __builtin_bit_cast(unsigned,b);}
#define WAIT_BAR(N) asm volatile("s_waitcnt vmcnt(" #N ") lgkmcnt(0)\n\ts_barrier":::"memory")

__device__ __forceinline__ void qkt(f32x16&p0,f32x16&p1,const char*Kslot,const bf16x8*qr,int r32,int hi){
  const char*kb=Kslot+hi*1024+r32*16;
  #pragma unroll
  for(int d0=0;d0<4;++d0){
    const bf16x8 b0=*reinterpret_cast<const bf16x8*>(kb+d0*2048);
    const bf16x8 b1=*reinterpret_cast<const bf16x8*>(kb+d0*2048+512);
    {p0=__builtin_amdgcn_mfma_f32_32x32x16_bf16(b0,qr[d0],p0,0,0,0);p1=__builtin_amdgcn_mfma_f32_32x32x16_bf16(b1,qr[d0],p1,0,0,0);}}
}
typedef __attribute__((address_space(3))) const char* lds_cptr;
typedef short v4i16_t __attribute__((ext_vector_type(4)));
__device__ __forceinline__ void kload8(bf16x8*kf,lds_cptr kp){
  kf[0]=*(const __attribute__((address_space(3))) bf16x8*)(kp);      kf[1]=*(const __attribute__((address_space(3))) bf16x8*)(kp+512);
  kf[2]=*(const __attribute__((address_space(3))) bf16x8*)(kp+2048); kf[3]=*(const __attribute__((address_space(3))) bf16x8*)(kp+2560);
  kf[4]=*(const __attribute__((address_space(3))) bf16x8*)(kp+4096); kf[5]=*(const __attribute__((address_space(3))) bf16x8*)(kp+4608);
  kf[6]=*(const __attribute__((address_space(3))) bf16x8*)(kp+6144); kf[7]=*(const __attribute__((address_space(3))) bf16x8*)(kp+6656);
}
__device__ __forceinline__ void kload2(bf16x8*kf,lds_cptr kp,int j){ kf[2*j]=*(const __attribute__((address_space(3))) bf16x8*)(kp+j*2048); kf[2*j+1]=*(const __attribute__((address_space(3))) bf16x8*)(kp+j*2048+512); }
__device__ __forceinline__ s16x4 vtr(lds_cptr p){ return __builtin_bit_cast(s16x4,__builtin_amdgcn_ds_read_tr16_b64_v4i16((__attribute__((address_space(3))) v4i16_t*)p)); }
__device__ __forceinline__ float rowmax(const f32x16&p0,const f32x16&p1){
  float a=max3f(p0[0],p0[1],p1[0]),b=max3f(p0[2],p0[3],p1[1]);a=max3f(a,p1[2],p1[3]);
  #pragma unroll
  for(int r=4;r<16;r+=4){a=max3f(a,p0[r],p0[r+1]);b=max3f(b,p0[r+2],p0[r+3]);a=max3f(a,p1[r],p1[r+1]);b=max3f(b,p1[r+2],p1[r+3]);}
  const float m=max2f(a,b);
  auto rr=__builtin_amdgcn_permlane32_swap(__float_as_uint(m),__float_as_uint(m),false,false);
  return max2f(__uint_as_float(rr[0]),__uint_as_float(rr[1]));
}
__device__ __forceinline__ void pv(f32x16*o,int vb,bf16x8 pa0,bf16x8 pa1,bf16x8 pa2,bf16x8 pa3){
  #pragma unroll
  for(int d0=0;d0<2;++d0){s16x4 lo[4],hi[4];
    #pragma unroll
    for(int ks=0;ks<4;++ks){
      asm volatile("ds_read_b64_tr_b16 %0,%1 offset:%c2":"=&v"(lo[ks]):"v"(vb),"i"(d0*4096+ks*1024):"memory");
      asm volatile("ds_read_b64_tr_b16 %0,%1 offset:%c2":"=&v"(hi[ks]):"v"(vb),"i"(d0*4096+ks*1024+512):"memory");}
    asm volatile("s_waitcnt lgkmcnt(0)":::"memory");SBAR();
    #define PK(k) (bf16x8){lo[k][0],lo[k][1],lo[k][2],lo[k][3],hi[k][0],hi[k][1],hi[k][2],hi[k][3]}
    o[d0]=__builtin_amdgcn_mfma_f32_32x32x16_bf16(pa0,PK(0),o[d0],0,0,0);
    o[d0]=__builtin_amdgcn_mfma_f32_32x32x16_bf16(pa1,PK(1),o[d0],0,0,0);
    o[d0]=__builtin_amdgcn_mfma_f32_32x32x16_bf16(pa2,PK(2),o[d0],0,0,0);
    o[d0]=__builtin_amdgcn_mfma_f32_32x32x16_bf16(pa3,PK(3),o[d0],0,0,0);
    #undef PK
  }
}

#ifndef ATTN_STORE16
#define ATTN_STORE16(p,v) (*(u32x4*)(p)=(v))
#endif
template<int THRL> __device__ __forceinline__ void attn_unit(int b,int h,int qb,const bf16*Q,const bf16*__restrict__ K,const bf16*__restrict__ V,bf16*O,const float*__restrict__ KBg,const float skip_thr,char*shm){
  int tid_=threadIdx.x; asm volatile("":"+v"(tid_)); const int tid=tid_,lane=tid&63,r32=lane&31,hi=lane>>5; const int wid=__builtin_amdgcn_readfirstlane(tid>>6);
  const long rowbase=(long)b*SEQ; const int q0=qb*QB;
  const bf16*Qw=Q+(rowbase+q0+wid*QBLK)*DM+h*D;
  const int NTF=(q0+QB)/KVBLK; int t0=0;
  { const float*kbg=KBg+(long)(b*NHEAD+h)*SEQ; const float kq=kbg[q0]; bool sk=false; if(lane<NTF-4) sk=(kq-kbg[64*lane+63])>skip_thr;
    const unsigned long long mk=__ballot(sk); t0=(mk==~0ull)?64:__builtin_ctzll(~mk); t0&=~1; if(t0>NTF-4)t0=NTF-4; t0=__builtin_amdgcn_readfirstlane(t0); }
  const bf16*Kh=K+(rowbase+(long)t0*KVBLK)*DM+h*D,*Vh=V+(rowbase+(long)t0*KVBLK)*DM+h*D;
  const lds_cptr shm3=(lds_cptr)shm;
  const unsigned lds0=(unsigned)(uintptr_t)shm;
  float*wsf=(float*)(shm+LDS_WS)+wid*64;
  const bf16*ksrc=Kh+(long)lane*DM+wid*8;
  const bf16*vsrc=Vh+(long)(16*(wid&3)+(lane>>2))*DM+(wid>>2)*32+(lane&3)*8;
  const unsigned kdst=lds0+LDS_K+wid*1024, vdst=lds0+LDS_V+wid*1024;
  #define DMA_K(t,slot) glds16(ksrc+(long)(t)*KVBLK*DM,(unsigned)__builtin_amdgcn_readfirstlane(kdst+(slot)))
  #define DMA_V(t,slot) glds16(vsrc+(long)(t)*KVBLK*DM,(unsigned)__builtin_amdgcn_readfirstlane(vdst+(slot)))
  const int vb0=(int)(lds0+LDS_V)+((lane>>4)&1)*32+(lane&3)*8+(4*hi+((lane&15)>>2))*64;
  const char*Kbase=shm+LDS_K; bf16x8 kf[8];
  const lds_cptr kp0=shm3+LDS_K+hi*1024+r32*16; const lds_cptr vp0=shm3+LDS_V+((lane>>4)&1)*32+(lane&3)*8+(4*hi+((lane&15)>>2))*64;
  const int NT=NTF-t0;
  DMA_K(0,0);DMA_V(0,0);DMA_K(1,SLOTB);
  typedef __attribute__((address_space(3))) float* lds_fptr; typedef float f32x4_t __attribute__((ext_vector_type(4)));
  const lds_fptr kbL=(lds_fptr)(shm3+LDS_KBIAS);
  { const float*kbsrc=KBg+(long)(b*NHEAD+h)*SEQ+64*t0; int i0_=4*tid; asm volatile("":"+v"(i0_));   for(int i=i0_;i<64*NT;i+=4*NW*64) *(__attribute__((address_space(3))) f32x4_t*)(kbL+i)=*(const f32x4_t*)(kbsrc+i); }
  #define KBLOAD(P0,P1,t) do{ int h4_=4*hi; asm volatile("":"+v"(h4_));   const lds_fptr kq_=kbL+64*(t)+h4_; _Pragma("unroll") for(int i_=0;i_<4;++i_){ const f32x4_t a_=*(const __attribute__((address_space(3))) f32x4_t*)(kq_+8*i_); const f32x4_t b_=*(const __attribute__((address_space(3))) f32x4_t*)(kq_+32+8*i_); \
      P0[4*i_]=a_[0];P0[4*i_+1]=a_[1];P0[4*i_+2]=a_[2];P0[4*i_+3]=a_[3]; P1[4*i_]=b_[0];P1[4*i_+1]=b_[1];P1[4*i_+2]=b_[2];P1[4*i_+3]=b_[3]; } }while(0)
  bf16x8 qr[4];
  #pragma unroll
  for(int d0=0;d0<4;++d0)qr[d0]=*reinterpret_cast<const bf16x8*>(&Qw[(long)r32*DM+d0*16+hi*8]);
  float mhat=0.f,l_reg=0.f;f32x16 o[2];o[0]=f32x16{};o[1]=f32x16{};
  const int qrel=wid*QBLK+r32;
  #define CMASK(P0,P1,t) do{int jb_=(t)-(NT-4); if(jb_>=0)cmask(P0,P1,jb_,qrel,hi);}while(0)
  bool resc=false;
  #define START(P0,P1) do{ const float rm=rowmax(P0,P1); resc=false; \
    { const float dl=rm; mhat=fadd_s(mhat,dl); \
      _Pragma("unroll") for(int r=0;r<16;++r){P0[r]=fsub_s(P0[r],dl);P1[r]=fsub_s(P1[r],dl);} } \
    _Pragma("unroll") for(int r=0;r<16;++r)P0[r]=__builtin_amdgcn_exp2f(P0[r]); }while(0)
  #define RESC() do{ if(resc){ asm volatile("s_waitcnt lgkmcnt(0)":::"memory"); \
      _Pragma("unroll") for(int d_=0;d_<2;++d_) _Pragma("unroll") for(int r=0;r<16;++r)o[d_][r]*=wsf[crow(r,hi)]; } }while(0)
  f32x16 pA0,pA1,pB0,pB1;
  int sl_prev=0,sl_cur=0,sl_next=SLOTB;
  #define ROT() do{sl_prev=sl_cur;sl_cur=sl_next;sl_next=(sl_next==(NSLOT-1)*SLOTB)?0:sl_next+SLOTB;}while(0)
  DMA_K(2,2*SLOTB);
  WAIT_BAR(3);
  KBLOAD(pA0,pA1,0);
  qkt(pA0,pA1,Kbase,qr,r32,hi);asm volatile("s_nop 15\n\ts_nop 7":"+v"(pA0),"+v"(pA1));CMASK(pA0,pA1,0);
  START(pA0,pA1);
  KBLOAD(pB0,pB1,1);
  _Pragma("unroll") for(int r=0;r<16;++r){pB0[r]-=mhat;pB1[r]-=mhat;}
  _Pragma("unroll") for(int r=0;r<16;++r)pA1[r]=__builtin_amdgcn_exp2f(pA1[r]);
  WAIT_BAR(0);
  DMA_K(3,0);DMA_V(1,SLOTB);
  ROT();
  kload8(kf,kp0+sl_cur);
  WAIT_BAR(2);
  s16x4 vlo[8],vhi[8]; u32x4 pw0,pw1,pw2,pw3;
  #define PKW(P,B) cvtpk_s(P[B],P[B+1])
  #define PAF(k) __builtin_bit_cast(bf16x8,pw##k)
  #define VFR(i) (bf16x8){vlo[i][0],vlo[i][1],vlo[i][2],vlo[i][3],vhi[i][0],vhi[i][1],vhi[i][2],vhi[i][3]}
  #define PIN(x) asm volatile("":"+v"(x))
  #define MX3(a,b,c) __builtin_fmaxf(__builtin_fmaxf((a),(b)),(c))
  #define GAPA(MF,A0,A1,A2,A3,W0,W1,PW) do{ MF; sacc+=A0; sacc+=A1; sacc+=A2; sacc+=A3; PIN(sacc); W0; W1; PIN(PW); SBAR(); }while(0)
  #define EX(v) __builtin_amdgcn_exp2f(v)
  #define GAPB(MF,X,B) do{ MF; X[B]=EX(X[B]); X[B+1]=EX(X[B+1]); X[B+2]=EX(X[B+2]); X[B+3]=EX(X[B+3]); PIN(X); SBAR(); }while(0)
  #define VRD(i) do{ vlo[i]=vtr(vp_+(((i)>>2)*4096+((i)&3)*1024)); vhi[i]=vtr(vp_+(((i)>>2)*4096+((i)&3)*1024+512)); }while(0)
  #define KRD(G,j) do{ if(G){ kload2(kf,kp0+sl_next,j); SBAR(); } }while(0)
  #define NB(G,Y,B) do{ if(G){ Y[B]-=mhat; Y[B+1]-=mhat; Y[B+2]-=mhat; Y[B+3]-=mhat; PIN(Y); SBAR(); } }while(0)
  #define STEP(C0,C1,P0,P1,t,GK,GV,GL,GN) do{ SBAR(); \
    const lds_cptr vp_=vp0+sl_prev; \
    VRD(0); SBAR(); float sacc=(P0[0]+P0[1]); \
    GAPA(C0=__builtin_amdgcn_mfma_f32_32x32x16_bf16(kf[0],qr[0],C0,0,0,0), P0[2],P0[3],P0[4],P0[5],     pw0[0]=PKW(P0,0), pw0[1]=PKW(P0,2), pw0); \
    VRD(4); SBAR(); GAPA(C1=__builtin_amdgcn_mfma_f32_32x32x16_bf16(kf[1],qr[0],C1,0,0,0), P0[6],P0[7],P0[8],P0[9],     pw0[2]=PKW(P0,4), pw0[3]=PKW(P0,6), pw0); \
    VRD(1); SBAR(); GAPA(C0=__builtin_amdgcn_mfma_f32_32x32x16_bf16(kf[2],qr[1],C0,0,0,0),   P0[10],P0[11],P0[12],P0[13], pw1[0]=PKW(P0,8), pw1[1]=PKW(P0,10), pw1); \
    VRD(5); SBAR(); GAPA(C1=__builtin_amdgcn_mfma_f32_32x32x16_bf16(kf[3],qr[1],C1,0,0,0),   P0[14],P0[15],P1[0],P1[1],   pw1[2]=PKW(P0,12),pw1[3]=PKW(P0,14), pw1); \
    VRD(2); SBAR(); GAPA(C0=__builtin_amdgcn_mfma_f32_32x32x16_bf16(kf[4],qr[2],C0,0,0,0),   P1[2],P1[3],P1[4],P1[5],     pw2[0]=PKW(P1,0), pw2[1]=PKW(P1,2), pw2); \
    VRD(6); SBAR(); GAPA(C1=__builtin_amdgcn_mfma_f32_32x32x16_bf16(kf[5],qr[2],C1,0,0,0),   P1[6],P1[7],P1[8],P1[9],     pw2[2]=PKW(P1,4), pw2[3]=PKW(P1,6), pw2); \
    VRD(3); SBAR(); GAPA(C0=__builtin_amdgcn_mfma_f32_32x32x16_bf16(kf[6],qr[3],C0,0,0,0),   P1[10],P1[11],P1[12],P1[13], pw3[0]=PKW(P1,8), pw3[1]=PKW(P1,10), pw3); \
    VRD(7); SBAR(); GAPA(C1=__builtin_amdgcn_mfma_f32_32x32x16_bf16(kf[7],qr[3],C1,0,0,0),   P1[14],P1[15],0.f,0.f,       pw3[2]=PKW(P1,12),pw3[3]=PKW(P1,14), pw3); \
    l_reg+=sacc; \
    if(GK){DMA_K((t)+3,sl_cur);} if(GV){DMA_V((t)+1,sl_next);} \
    CMASK(C0,C1,t); \
    { float a=MX3(C0[0],C0[1],C1[0]),b=MX3(C0[2],C0[3],C1[1]); a=MX3(a,C1[2],C1[3]); \
      _Pragma("unroll") for(int r=4;r<16;r+=4){a=MX3(a,C0[r],C0[r+1]);b=MX3(b,C0[r+2],C0[r+3]);a=MX3(a,C1[r],C1[r+1]);b=MX3(b,C1[r+2],C1[r+3]);} \
      float rm=__builtin_fmaxf(a,b); { auto rr=__builtin_amdgcn_permlane32_swap(__float_as_uint(rm),__float_as_uint(rm),false,false); rm=__builtin_fmaxf(__uint_as_float(rr[0]),__uint_as_float(rr[1])); } \
      resc=false; \
      if(__builtin_expect(__any(rm>(float)THRL),0)){ const float dl=__builtin_fmaxf(rm,0.f); mhat+=dl; \
        _Pragma("unroll") for(int r=0;r<16;++r){C0[r]-=dl;C1[r]-=dl;} \
        const float f=__builtin_amdgcn_exp2f(-dl); l_reg*=f; if(hi==0)wsf[r32]=f; resc=true; } } \
    if(GN){ KBLOAD(P0,P1,(t)+1); } \
    SBAR(); \
    GAPB(o[0]=__builtin_amdgcn_mfma_f32_32x32x16_bf16(PAF(0),VFR(0),o[0],0,0,0), C0,0); NB(GN,P0,0); \
    GAPB(o[1]=__builtin_amdgcn_mfma_f32_32x32x16_bf16(PAF(0),VFR(4),o[1],0,0,0), C0,4); NB(GN,P0,4); \
    KRD(GL,0); GAPB(o[0]=__builtin_amdgcn_mfma_f32_32x32x16_bf16(PAF(1),VFR(1),o[0],0,0,0), C0,8); NB(GN,P0,8); \
    KRD(GL,1); GAPB(o[1]=__builtin_amdgcn_mfma_f32_32x32x16_bf16(PAF(1),VFR(5),o[1],0,0,0), C0,12); NB(GN,P0,12); \
    KRD(GL,2); GAPB(o[0]=__builtin_amdgcn_mfma_f32_32x32x16_bf16(PAF(2),VFR(2),o[0],0,0,0), C1,0); NB(GN,P1,0); \
    KRD(GL,3); GAPB(o[1]=__builtin_amdgcn_mfma_f32_32x32x16_bf16(PAF(2),VFR(6),o[1],0,0,0), C1,4); NB(GN,P1,4); \
    GAPB(o[0]=__builtin_amdgcn_mfma_f32_32x32x16_bf16(PAF(3),VFR(3),o[0],0,0,0), C1,8); NB(GN,P1,8); \
    GAPB(o[1]=__builtin_amdgcn_mfma_f32_32x32x16_bf16(PAF(3),VFR(7),o[1],0,0,0), C1,12); NB(GN,P1,12); \
    }while(0)
  int t=1;
  #undef CMASK
  #define CMASK(P0,P1,t) do{}while(0)
  for(;t+5<NT;t+=2){
    STEP(pB0,pB1,pA0,pA1,t,true,true,true,true);     WAIT_BAR(2); RESC(); ROT();
    STEP(pA0,pA1,pB0,pB1,t+1,true,true,true,true);   WAIT_BAR(2); RESC(); ROT();
  }
  #undef CMASK
  #define CMASK(P0,P1,t) do{int jb_=(t)-(NT-4); if(jb_>=0)cmask(P0,P1,jb_,qrel,hi);}while(0)
  #define ENDW(tt) do{ if((tt)+3<NT){WAIT_BAR(2);} else if((tt)+2<NT){WAIT_BAR(1);} else {WAIT_BAR(0);} }while(0)
  for(;t+1<NT;t+=2){
    STEP(pB0,pB1,pA0,pA1,t,(t+3<NT),(t+1<NT),(t+1<NT),(t+1<NT));       ENDW(t);   RESC(); ROT();
    STEP(pA0,pA1,pB0,pB1,t+1,(t+4<NT),(t+2<NT),(t+2<NT),(t+2<NT));     ENDW(t+1); RESC(); ROT();
  }
  STEP(pB0,pB1,pA0,pA1,NT-1,false,false,false,false); RESC();
  { float sacc=pB0[0]+pB0[1]; _Pragma("unroll") for(int r=2;r<16;++r)sacc+=pB0[r]; _Pragma("unroll") for(int r=0;r<16;++r)sacc+=pB1[r]; l_reg+=sacc;
    pw0=(u32x4){PKW(pB0,0),PKW(pB0,2),PKW(pB0,4),PKW(pB0,6)};pw1=(u32x4){PKW(pB0,8),PKW(pB0,10),PKW(pB0,12),PKW(pB0,14)};pw2=(u32x4){PKW(pB1,0),PKW(pB1,2),PKW(pB1,4),PKW(pB1,6)};pw3=(u32x4){PKW(pB1,8),PKW(pB1,10),PKW(pB1,12),PKW(pB1,14)};
    SBAR(); pv(o,vb0+sl_cur,PAF(0),PAF(1),PAF(2),PAF(3)); }
  #undef PKW
  #undef PAF
  #undef VFR
  #undef PIN
  #undef MX3
  #undef GAPA
  #undef GAPB
  #undef EX
  #undef VRD
  #undef KRD
  #undef NB
  #undef KBLOAD
  #undef STEP
  #undef ENDW
  {auto rr=__builtin_amdgcn_permlane32_swap(__float_as_uint(l_reg),__float_as_uint(l_reg),false,false);l_reg=__uint_as_float(rr[0])+__uint_as_float(rr[1]);}
  if(hi==0)wsf[32+r32]=l_reg;asm volatile("s_waitcnt lgkmcnt(0)":::"memory");
  float rli[16];
  #pragma unroll
  for(int r=0;r<16;++r)rli[r]=__builtin_amdgcn_rcpf(wsf[32+crow(r,hi)]);
  bf16*Ow=O+(rowbase+q0+wid*QBLK)*DM+h*D;
  { bf16*stg=(bf16*)(shm+LDS_OST)+wid*2048;
    #pragma unroll
    for(int r=0;r<16;++r){const int orow=crow(r,hi);
      #pragma unroll
      for(int d0=0;d0<2;++d0)stg[orow*64+d0*32+r32]=__float2bfloat16(o[d0][r]*rli[r]);}
    asm volatile("s_waitcnt lgkmcnt(0)":::"memory");
    #pragma unroll
    for(int i=0;i<4;++i){const int row=i*8+(lane>>3),ch=lane&7; const u32x4 v=*(const u32x4*)(stg+row*64+ch*8); ATTN_STORE16(Ow+(long)row*DM+ch*8,v);} }
  asm volatile("s_waitcnt lgkmcnt(0)\n\ts_barrier":::"memory");
  #undef DMA_K
  #undef DMA_V
  #undef CMASK
  #undef START
  #undef RESC
  #undef ROT
}
constexpr int ATTN_LDS_BYTES=LDS_BYTES;
struct AttnTensors { const bf16* Q; const bf16* K; const bf16* V; bf16* O; const float* KB; const float* qg; const float* kg; };
struct AttnUnit { int bh; int qb; };
struct StaticOrder {
  int vcu;
  __device__ __forceinline__ explicit StaticOrder(int grid,int block):vcu((block%8)*(grid/8)+block/8){}
  __device__ __forceinline__ bool next(int i,AttnUnit&u)const{ if(i>=4)return false; const int s=vcu&3; u.bh=vcu>>2; u.qb=(i==0)?s:(i==1)?7-s:(i==2)?8+s:15-s; return true; }
  __device__ __forceinline__ void a_ready(const AttnUnit&)const{}
  __device__ __forceinline__ void done(const AttnUnit&)const{}
};
__device__ __forceinline__ int attn_ticket(unsigned*ctr,unsigned myx){
  for(unsigned k=0;k<8;++k){ const unsigned q=(myx+k)&7u; const unsigned m=atomicAdd(ctr+64*q,1u); if(m<128u) return (int)(q*128u+m); }
  return -1;
}
template<class Sched,int THRL=60> __device__ __forceinline__ void attn_phase(char*lds,const AttnTensors&T,const Sched&S,unsigned*ctr,volatile __attribute__((address_space(3))) unsigned*slot,unsigned myx){
  float thr; { const int l=threadIdx.x&63; float a=fabsf(T.qg[l]),c=fabsf(T.kg[l]);
    for(int o=1;o<64;o<<=1){a=fmaxf(a,__shfl_xor(a,o));c=fmaxf(c,__shfl_xor(c,o));}
    thr=2.0f*(1.05f*a*c*64.0f*C2)+40.0f; }
  if(threadIdx.x==0) slot[0]=(unsigned)attn_ticket(ctr,myx);
  __syncthreads();
  int n=(int)slot[0];
  while(n>=0){
    int pre=-1; if(threadIdx.x==0) pre=attn_ticket(ctr,myx);
    const int m=n&127, bh=8*(n>>7)+(m&7);
    attn_unit<THRL>(bh/NHEAD,bh%NHEAD,(NQB-1)-(m>>3),T.Q,T.K,T.V,T.O,T.KB,thr,lds);
    if(threadIdx.x==0) slot[0]=(unsigned)pre;
    __syncthreads();
    n=(int)slot[0];
  }
}
#undef SBAR
#undef WAIT_BAR
}

constexpr int NWAVES = 8;
constexpr int BATCH = 4, SEQ = 4096, D = 1024, H = 16, HD = 64, FF = 4096;
constexpr int M = BATCH * SEQ;
constexpr int NQKV = 3 * D, WIN_LD = 3 * D + H;
constexpr int NG = 64, NP = 64, NC = 16, LCH = 16, NCHUNK = M / LCH  , KA = LCH * NC + 2 * NP  ;

constexpr size_t MiB = 1u << 20;
constexpr size_t WS_CTL = 0;
constexpr size_t WS_BAR = 256 * 1024;
constexpr size_t WS_LAMT = 3 * MiB;
constexpr size_t WS_LF = 1 * MiB, WS_KB = 2 * MiB;
constexpr size_t WS_WQKV = 4 * MiB, WS_WO = 10 * MiB, WS_W1A = 12 * MiB, WS_W2A = 20 * MiB, WS_W1B = 28 * MiB, WS_W2B = 36 * MiB, WS_WSSM = 44 * MiB, WS_WGLU = 46 * MiB;
constexpr size_t WS_BT3 = 50 * MiB, WS_WT1 = 62 * MiB;
constexpr size_t WS_XN = 70 * MiB;
constexpr size_t WS_QO = 102 * MiB, WS_K = 134 * MiB, WS_V = 166 * MiB;
constexpr size_t WS_O = 198 * MiB;
constexpr size_t WS_H = 102 * MiB;
constexpr size_t WS_AALL = 102 * MiB, WS_SBUF = 150 * MiB, WS_Z = 182 * MiB;
constexpr size_t WS_END = 230 * MiB;

constexpr int RING_OFF = 0, RING_BYTES = 131072;
constexpr int XCH_OFF = RING_BYTES;
constexpr int MISC_OFF = XCH_OFF + 8192;
constexpr int LDS_BYTES = 147456;

#define GAS __attribute__((address_space(1)))
#define LAS __attribute__((address_space(3)))
typedef unsigned short bf16;
typedef unsigned v4u __attribute__((ext_vector_type(4)));
typedef float f32x4 __attribute__((ext_vector_type(4)));
#define LDS_WAIT() asm volatile("s_waitcnt lgkmcnt(0)" ::: "memory")
__device__ __forceinline__ unsigned f2bf(float f) { unsigned u = __builtin_bit_cast(unsigned, f); return (u + 0x7fffu + ((u >> 16) & 1u)) >> 16; }
__device__ __forceinline__ unsigned pk2(float lo, float hi) { return f2bf(lo) | (f2bf(hi) << 16); }
template <int CTRL> __device__ __forceinline__ float dppf(float v) { return __uint_as_float((unsigned)__builtin_amdgcn_update_dpp(0, (int)__float_as_uint(v), CTRL, 0xF, 0xF, false)); }
__device__ __forceinline__ float xor16f(float v, int lane) { auto a = __builtin_amdgcn_permlane16_swap(__float_as_uint(v), __float_as_uint(v), false, false); return __uint_as_float((lane & 16) ? a[0] : a[1]); }
__device__ __forceinline__ float xor32f(float v, int lane) { auto a = __builtin_amdgcn_permlane32_swap(__float_as_uint(v), __float_as_uint(v), false, false); return __uint_as_float((lane & 32) ? a[0] : a[1]); }
__device__ __forceinline__ float wave_sum(float v) {
    v += dppf<0xB1>(v); v += dppf<0x4E>(v); v += dppf<0x141>(v); v += dppf<0x140>(v);
    { auto a = __builtin_amdgcn_permlane16_swap(__float_as_uint(v), __float_as_uint(v), false, false); v = __uint_as_float(a[0]) + __uint_as_float(a[1]); }
    { auto a = __builtin_amdgcn_permlane32_swap(__float_as_uint(v), __float_as_uint(v), false, false); v = __uint_as_float(a[0]) + __uint_as_float(a[1]); }
    return v;
}
__device__ __forceinline__ void sincos_d(double a, double& s, double& c) {
    const double k = rint(a * 0.63661977236758134308);
    double r = fma(-k, 1.57079632679489655800e+00, a); r = fma(-k, 6.12323399573676603587e-17, r);
    const int q = ((int)k) & 3;
    const double r2 = r * r;
    const double sp = r * (1.0 + r2 * (-1.0 / 6 + r2 * (1.0 / 120 + r2 * (-1.0 / 5040 + r2 * (1.0 / 362880 + r2 * (-1.0 / 39916800 + r2 * (1.0 / 6227020800.0)))))));
    const double cp = 1.0 + r2 * (-0.5 + r2 * (1.0 / 24 + r2 * (-1.0 / 720 + r2 * (1.0 / 40320 + r2 * (-1.0 / 3628800 + r2 * (1.0 / 479001600.0 + r2 * (-1.0 / 87178291200.0)))))));
    s = (q == 0) ? sp : (q == 1) ? cp : (q == 2) ? -sp : -cp;
    c = (q == 0) ? cp : (q == 1) ? -sp : (q == 2) ? -cp : sp;
}

#define XB_TMO      128
#define XB_XCNT(j)  (256  + 64 * (j))
#define XB_XSUB(j)  (1280 + 64 * (j))
#define XB_XGEN(j)  (2304 + 64 * (j))
#define XB_TOP      3328
#define XB_TOPGEN   3392
#define XCD_BAR_WORDS 3456
#define XB_SPIN_CAP (1u << 18)

__device__ __forceinline__ unsigned xb_ld(unsigned* p)              { return __hip_atomic_load(p, __ATOMIC_RELAXED, __HIP_MEMORY_SCOPE_AGENT); }
__device__ __forceinline__ unsigned xb_add(unsigned* p, unsigned v) { return __hip_atomic_fetch_add(p, v, __ATOMIC_RELAXED, __HIP_MEMORY_SCOPE_AGENT); }
__device__ __forceinline__ unsigned xb_xcc_id() { return (unsigned)__builtin_amdgcn_s_getreg((3 << 11) | 20) & 0xFu; }
#define XB_SPIN(cond, bar) do { unsigned _sp = 0; while (cond) { __builtin_amdgcn_s_sleep(1); \
    if ((++_sp & 255u) == 0u) { if (xb_ld(&(bar)[XB_TMO])) break; if (_sp > XB_SPIN_CAP) { atomicAdd(&(bar)[XB_TMO], 1u); break; } } } } while (0)

struct XcdBarrier {
    unsigned* bar; unsigned x;
    volatile LAS unsigned* st;
};

__device__ __forceinline__ XcdBarrier xcd_barrier_post(unsigned* bar, volatile LAS unsigned* st) {
    XcdBarrier b; b.bar = bar; b.x = xb_xcc_id(); b.st = st;
    if (threadIdx.x == 0) (void)xb_add(&bar[XB_XCNT(b.x)], 1u);
    return b;
}
__device__ __forceinline__ void xcd_barrier_complete(unsigned* bar, unsigned x, unsigned& nloc, unsigned& nx) {
    const unsigned G = gridDim.x * gridDim.y * gridDim.z;
    unsigned sum, cnt, mine, sp = 0u;
    for (;;) {
        sum = 0u; cnt = 0u; mine = 0u;
#pragma unroll
        for (unsigned j = 0; j < 16; ++j) { const unsigned c = xb_ld(&bar[XB_XCNT(j)]); sum += c; cnt += (c > 0u) ? 1u : 0u; mine = (j == x) ? c : mine; }
        if (sum == G) break;
        __builtin_amdgcn_s_sleep(1);
        if ((++sp & 255u) == 0u) { if (xb_ld(&bar[XB_TMO])) break; if (sp > XB_SPIN_CAP) { atomicAdd(&bar[XB_TMO], 1u); break; } }
    }
    nloc = mine > 0u ? mine : 1u; nx = cnt > 0u ? cnt : 1u;
}

__device__ __forceinline__ void xcd_barrier(const XcdBarrier& b) {
    asm volatile("s_waitcnt vmcnt(0)" ::: "memory");
    __syncthreads();
    if (threadIdx.x == 0) {
        unsigned* bar = b.bar;
        __builtin_amdgcn_s_waitcnt(0);
        unsigned nloc = b.st[0], nx = b.st[1];
        if (nloc == 0u) { xcd_barrier_complete(bar, b.x, nloc, nx); b.st[0] = nloc; b.st[1] = nx; }
        const unsigned old = xb_add(&bar[XB_XSUB(b.x)], 1u);
        const unsigned gen = old / nloc;
        if (old + 1u == (gen + 1u) * nloc) {
            __builtin_amdgcn_fence(__ATOMIC_RELEASE, "agent");
            asm volatile("s_waitcnt vmcnt(0)" ::: "memory");
            const unsigned og = xb_add(&bar[XB_TOP], 1u);
            const unsigned tg = og / nx;
            if (og + 1u == (tg + 1u) * nx) xb_add(&bar[XB_TOPGEN], 1u);
            else XB_SPIN(xb_ld(&bar[XB_TOPGEN]) == tg, bar);
            __builtin_amdgcn_fence(__ATOMIC_ACQUIRE, "agent");
            xb_add(&bar[XB_XGEN(b.x)], 1u);
            asm volatile("s_waitcnt vmcnt(0)" ::: "memory");
        } else {
            XB_SPIN(xb_ld(&bar[XB_XGEN(b.x)]) == gen, bar);
            __builtin_amdgcn_fence(__ATOMIC_ACQUIRE, "agent");
            asm volatile("s_waitcnt vmcnt(0)" ::: "memory");
        }
    }
    __syncthreads();
}

struct Args { const float* in[20]; float* out; unsigned char* ws; int ph_lo, ph_hi; };

typedef const __attribute__((address_space(4))) Args* KArgs;
__device__ __forceinline__ KArgs kargs() { KArgs p = (KArgs)__builtin_amdgcn_kernarg_segment_ptr(); asm volatile("" : "+s"(p)); return p; }
__device__ __forceinline__ void p0_transpose_item(const float* W, int ldw, int K, int ncols, bf16* WT, LAS float* scr, int item, int lane, const float* gk, int glu) {
    const int nblk = ncols / 32, kb = item / nblk, nb = item % nblk, k0 = 64 * kb, n0 = 32 * nb;
    int src0 = n0;
    if (glu == 1) src0 = ((n0 >> 7) & 1) * 1024 + 128 * (n0 >> 8) + (n0 & 127);
    if (glu == 2) src0 = (n0 & ~255) + 64 * ((n0 >> 5) & 3) + 32 * ((n0 >> 7) & 1);
#pragma unroll 8
    for (int i = 0; i < 32; ++i) { const int kk = 2 * i + (lane >> 5); const float g = gk ? gk[k0 + kk] : 1.0f; scr[kk * 33 + (lane & 31)] = __builtin_nontemporal_load(W + (size_t)(k0 + kk) * ldw + src0 + (lane & 31)) * g; }
    LDS_WAIT(); asm volatile("" ::: "memory");
    const int c = lane & 7;
#pragma unroll
    for (int j = 0; j < 4; ++j) { const int n = (lane >> 3) + 8 * j; const LAS float* s = scr + (8 * c) * 33 + n;
        v4u o; o.x = pk2(s[0 * 33], s[1 * 33]); o.y = pk2(s[2 * 33], s[3 * 33]); o.z = pk2(s[4 * 33], s[5 * 33]); o.w = pk2(s[6 * 33], s[7 * 33]);
        *(GAS v4u*)(WT + (size_t)(n0 + n) * K + k0 + 8 * c) = o; }
    LDS_WAIT(); asm volatile("" ::: "memory");
}

__device__ __forceinline__ void ssm_setup(LAS unsigned char* lds, int tid, unsigned* ctr, volatile LAS unsigned* slot) {
    KArgs a = kargs();
    const float* a_re = a->in[9]; const float* a_im = a->in[10]; const float* b_re = a->in[11]; const float* b_im = a->in[12];
    const float* c_re = a->in[13]; const float* c_im = a->in[14]; const float* log_dt = a->in[15];
    bf16* BT3 = (bf16*)(a->ws + WS_BT3); bf16* WT1 = (bf16*)(a->ws + WS_WT1);
    LAS float* lamp = (LAS float*)lds;
    LAS float* bbt = lamp + 17 * 64 * 2;
    LAS float* cct = bbt + 64 * 16 * 2;
    LAS float* Kt = cct + 16 * 64 * 2;
    for (;;) {
        if (tid == 0) slot[0] = atomicAdd(ctr, 1u);
        __syncthreads();
        const int w = (int)slot[0];
        if (w >= 4 * NG) break;
        const int g = w >> 2, q = w & 3;
        {
            LAS double* ld = (LAS double*)(Kt);
            if (tid < 64) { const int p = tid; const double dt = exp((double)log_dt[g]), are = (double)a_re[g * 64 + p], aim = (double)a_im[g * 64 + p];
                double sn, cs; sincos_d(dt * aim, sn, cs); const double mag = exp(dt * are); const double lr = mag * cs, li = mag * sn;
                const double nr = lr - 1.0, ni = li, den = are * are + aim * aim;
                ld[p * 4] = lr; ld[p * 4 + 1] = li; ld[p * 4 + 2] = (nr * are + ni * aim) / den; ld[p * 4 + 3] = (ni * are - nr * aim) / den;
                if (q == 0) { double pr = lr, pi = li; f32x4 o;
#pragma unroll 1
                    for (int sq = 0; sq < 9; ++sq) { if (sq == 4) { o.x = (float)pr; o.y = (float)pi; } const double t = pr * pr - pi * pi; pi = 2.0 * pr * pi; pr = t; }
                    o.z = (float)pr; o.w = (float)pi; *(f32x4*)((float*)(a->ws + WS_LAMT) + (size_t)(g * 64 + p) * 4) = o; } }
            __syncthreads();
#pragma unroll 1
            for (int idx = tid; idx < 17 * 64; idx += 512) { const int tau = idx >> 6, p = idx & 63; double br = ld[p * 4], bi = ld[p * 4 + 1], rr = 1.0, ri = 0.0;
#pragma unroll
                for (int bit = 0; bit < 5; ++bit) { if ((tau >> bit) & 1) { const double t = rr * br - ri * bi; ri = rr * bi + ri * br; rr = t; } const double t2 = br * br - bi * bi; bi = 2.0 * br * bi; br = t2; }
                lamp[idx * 2] = (float)rr; lamp[idx * 2 + 1] = (float)ri; }
#pragma unroll 1
            for (int idx = tid; idx < 64 * 16; idx += 512) { const int p = idx >> 4; const double sr = ld[p * 4 + 2], si = ld[p * 4 + 3];
                const double br = (double)b_re[g * 1024 + idx], bi = (double)b_im[g * 1024 + idx];
                bbt[idx * 2] = (float)(sr * br - si * bi); bbt[idx * 2 + 1] = (float)(sr * bi + si * br); }
        }
        for (int i = tid; i < 1024; i += 512) { cct[i * 2] = c_re[g * 1024 + i]; cct[i * 2 + 1] = c_im[g * 1024 + i]; }
        __syncthreads();
        {
            const int tau = tid >> 5, cp = (tid >> 1) & 15, c0 = (tid & 1) * 8; float sacc[8];
#pragma unroll
            for (int e = 0; e < 8; ++e) sacc[e] = 0.f;
#pragma unroll 2
            for (int p = 0; p < 64; ++p) { const float cr = cct[(cp * 64 + p) * 2], ci = cct[(cp * 64 + p) * 2 + 1], lr = lamp[(tau * 64 + p) * 2], li = lamp[(tau * 64 + p) * 2 + 1];
                const float dr = cr * lr - ci * li, di = cr * li + ci * lr;
                const LAS f32x4* bp = (const LAS f32x4*)(bbt + (p * 16 + c0) * 2);
#pragma unroll
                for (int e4 = 0; e4 < 4; ++e4) { const f32x4 b4 = bp[e4]; sacc[2 * e4] += dr * b4.x - di * b4.y; sacc[2 * e4 + 1] += dr * b4.z - di * b4.w; } }
#pragma unroll
            for (int e = 0; e < 8; ++e) Kt[tau * 256 + cp * 16 + c0 + e] = sacc[e] + ((tau == 0 && c0 + e == cp) ? a->in[16][16 * g + cp] : 0.f);
        }
        __syncthreads();
#pragma unroll 1
        for (int r = 0; r < 6; ++r) { const int pc = tid + 512 * r, rr = pc / 48, k8 = (pc % 48) * 8, n = 64 * q + rr, j = n >> 4, cp = n & 15; float v[8];
            if (k8 < 256) { const int s = k8 >> 4, c0 = k8 & 15;
#pragma unroll
                for (int e = 0; e < 8; ++e) v[e] = (j >= s) ? Kt[(j - s) * 256 + cp * 16 + c0 + e] : 0.f;
            } else { const int im = (k8 - 256) >> 6, p0 = (k8 - 256) & 63;
#pragma unroll
                for (int e = 0; e < 8; ++e) { const int p = p0 + e; const float cr = cct[(cp * 64 + p) * 2], ci = cct[(cp * 64 + p) * 2 + 1], lr = lamp[((j + 1) * 64 + p) * 2], li = lamp[((j + 1) * 64 + p) * 2 + 1];
                    v[e] = im ? -(cr * li + ci * lr) : (cr * lr - ci * li); } }
            v4u o; o.x = pk2(v[0], v[1]); o.y = pk2(v[2], v[3]); o.z = pk2(v[4], v[5]); o.w = pk2(v[6], v[7]);
            *(GAS v4u*)(BT3 + (size_t)(g * 256 + n) * KA + k8) = o; }
#pragma unroll 1
        for (int r = 0; r < 4; ++r) { const int pc = tid + 512 * r, rr = pc >> 5, k8 = (pc & 31) * 8, n = 64 * q + rr; float v[8];
            if (n < 128) { const int p = n & 63, im = n >> 6, s = k8 >> 4, c0 = k8 & 15; const float lr = lamp[((15 - s) * 64 + p) * 2], li = lamp[((15 - s) * 64 + p) * 2 + 1];
#pragma unroll
                for (int e = 0; e < 8; ++e) { const float br = bbt[(p * 16 + c0 + e) * 2], bi = bbt[(p * 16 + c0 + e) * 2 + 1]; v[e] = im ? (lr * bi + li * br) : (lr * br - li * bi); }
            } else {
#pragma unroll
                for (int e = 0; e < 8; ++e) v[e] = 0.f; }
            v4u o; o.x = pk2(v[0], v[1]); o.y = pk2(v[2], v[3]); o.z = pk2(v[4], v[5]); o.w = pk2(v[6], v[7]);
            *(GAS v4u*)(WT1 + (size_t)(g * 256 + n) * 256 + k8) = o; }
        __syncthreads();
    }
}

__device__ __forceinline__ void p0_prologue(LAS unsigned char* lds, int tid, int lane, int wave, int vcu, int G) {
    const int gw = vcu * NWAVES + wave, NGW = G * NWAVES;
    { KArgs a = kargs(); const float* nmix = a->in[1]; const float* nmlp = a->in[2]; const float* w_in = a->in[3]; unsigned char* ws = a->ws;
    LAS float* scr = (LAS float*)(lds + RING_OFF + wave * 16384);
    constexpr int I_QKV = (D / 64) * (NQKV / 32), I_O = (D / 64) * (D / 32), I_1 = (D / 64) * (FF / 32), I_2 = (FF / 64) * (D / 32), I_G = (D / 64) * (2 * D / 32);
    constexpr int NITEMS = I_QKV + I_O + 2 * I_1 + 2 * I_2 + I_O + I_G;
    for (int it = gw; it < NITEMS; it += NGW) {
        int r = it;
        if (r < I_1) { p0_transpose_item(a->in[18] + (size_t)D * FF, FF, D, FF, (bf16*)(ws + WS_W1B), scr, r, lane, nmlp + D, 0); continue; } r -= I_1;
        if (r < I_2) { p0_transpose_item(a->in[19] + (size_t)FF * D, D, FF, D, (bf16*)(ws + WS_W2B), scr, r, lane, nullptr, 0); continue; } r -= I_2;
        if (r < I_G) { p0_transpose_item(a->in[17], 2 * D, D, 2 * D, (bf16*)(ws + WS_WGLU), scr, r, lane, nullptr, 1); continue; } r -= I_G;
        if (r < I_O) { p0_transpose_item(a->in[8], D, D, D, (bf16*)(ws + WS_WSSM), scr, r, lane, nmix + D, 0); continue; } r -= I_O;
        if (r < I_2) { p0_transpose_item(a->in[19], D, FF, D, (bf16*)(ws + WS_W2A), scr, r, lane, nullptr, 0); continue; } r -= I_2;
        if (r < I_1) { p0_transpose_item(a->in[18], FF, D, FF, (bf16*)(ws + WS_W1A), scr, r, lane, nmlp, 0); continue; } r -= I_1;
        if (r < I_O) { p0_transpose_item(a->in[7], D, D, D, (bf16*)(ws + WS_WO), scr, r, lane, nullptr, 0); continue; } r -= I_O;
        p0_transpose_item(w_in, WIN_LD, D, NQKV, (bf16*)(ws + WS_WQKV), scr, r, lane, nullptr, 2);
    }
    }
    KArgs a = kargs(); const float* x = a->in[0]; const float* nmix = a->in[1]; const float* w_in = a->in[3]; const float* b_f = a->in[4]; unsigned char* ws = a->ws;
    { float* rs = (float*)(ws + WS_CTL); for (int i = blockIdx.x * 512 + tid; i < 3 * M; i += G * 512) rs[i] = 0.f; }
    __syncthreads();
    LAS float* wfT = (LAS float*)(lds + RING_OFF);
    for (int i = tid; i < D * H; i += 512) { const int k = i >> 4, h = i & 15; wfT[h * D + k] = w_in[(size_t)k * WIN_LD + NQKV + h]; }
    __syncthreads();
    bf16* XN = (bf16*)(ws + WS_XN); float* LF = (float*)(ws + WS_LF);
    for (int m = gw; m < M; m += NGW) {
        const GAS f32x4* xr = (const GAS f32x4*)(x + (size_t)m * D) + lane;
        f32x4 v[4]; float s = 0.f;
#pragma unroll
        for (int j = 0; j < 4; ++j) { v[j] = __builtin_nontemporal_load(xr + 64 * j); s += (v[j].x * v[j].x + v[j].y * v[j].y) + (v[j].z * v[j].z + v[j].w * v[j].w); }
        const float ssx = wave_sum(s); const float rs = 1.0f / sqrtf(ssx * (1.f / D) + 1e-6f);
        if (lane == 0) ((float*)(ws + WS_CTL))[3 * M + m] = ssx;
        GAS unsigned long long* o8 = (GAS unsigned long long*)(XN + (size_t)m * D) + lane;
#pragma unroll
        for (int j = 0; j < 4; ++j) { const f32x4 g4 = *(const f32x4*)(nmix + 256 * j + 4 * lane); v[j] = v[j] * rs * g4;
            o8[64 * j] = (unsigned long long)pk2(v[j].x, v[j].y) | ((unsigned long long)pk2(v[j].z, v[j].w) << 32); }
        float acc[16];
#pragma unroll
        for (int h = 0; h < 16; ++h) { float t = 0.f; if ((h & 3) == 0) asm volatile("" ::: "memory");
#pragma unroll
            for (int j = 0; j < 4; ++j) { const f32x4 w4 = *(const LAS f32x4*)(wfT + h * D + 256 * j + 4 * lane); t += (v[j].x * w4.x + v[j].y * w4.y) + (v[j].z * w4.z + v[j].w * w4.w); }
            acc[h] = t; }
#pragma unroll
        for (int i = 0; i < 8; ++i) { const bool hi = (lane & 32) != 0; const float send = hi ? acc[i] : acc[i + 8], keep = hi ? acc[i + 8] : acc[i]; acc[i] = keep + xor32f(send, lane); }
#pragma unroll
        for (int i = 0; i < 4; ++i) { const bool hi = (lane & 16) != 0; const float send = hi ? acc[i] : acc[i + 4], keep = hi ? acc[i + 4] : acc[i]; acc[i] = keep + xor16f(send, lane); }
#pragma unroll
        for (int i = 0; i < 2; ++i) { const bool hi = (lane & 8) != 0; const float send = hi ? acc[i] : acc[i + 2], keep = hi ? acc[i + 2] : acc[i]; acc[i] = keep + dppf<0x128>(send); }
        { const bool hi = (lane & 4) != 0; const float send = hi ? acc[0] : acc[1], keep = hi ? acc[1] : acc[0]; acc[0] = keep + __shfl_xor(send, 4); }
        float f = acc[0]; f += dppf<0x4E>(f); f += dppf<0xB1>(f);
        const int hh = lane >> 2;
        const float z = f + b_f[hh];
        const float lf = fminf(z, 0.f) - log1pf(expf(-fabsf(z)));
        if ((lane & 3) == 0) LF[(size_t)((m >> 12) * 16 + hh) * SEQ + (m & (SEQ - 1))] = lf;
    }
}

__device__ __forceinline__ void cumsum_phase(LAS unsigned char* lds, int tid, int lane, int wave) {
    KArgs a = kargs();
    const float* LF = (const float*)(a->ws + WS_LF); float* KB = (float*)(a->ws + WS_KB);
    LAS float* wsum = (LAS float*)(lds + MISC_OFF);
    for (int bh = blockIdx.x; bh < BATCH * H; bh += gridDim.x) {
        const float* src = LF + (size_t)bh * SEQ + 8 * tid;
        const f32x4 a0 = *(const f32x4*)src, a1 = *(const f32x4*)(src + 4);
        float p[8]; p[0] = a0.x; p[1] = p[0] + a0.y; p[2] = p[1] + a0.z; p[3] = p[2] + a0.w; p[4] = p[3] + a1.x; p[5] = p[4] + a1.y; p[6] = p[5] + a1.z; p[7] = p[6] + a1.w;
        float incl = p[7];
#pragma unroll
        for (int o = 1; o < 64; o <<= 1) { const float t = __shfl_up(incl, o); if (lane >= o) incl += t; }
        if (lane == 63) wsum[wave] = incl;
        __syncthreads();
        float off = incl - p[7];
        for (int w = 0; w < wave; ++w) off += wsum[w];
        f32x4 o0, o1;
        o0.x = -(p[0] + off) * 1.4426950408889634f; o0.y = -(p[1] + off) * 1.4426950408889634f; o0.z = -(p[2] + off) * 1.4426950408889634f; o0.w = -(p[3] + off) * 1.4426950408889634f;
        o1.x = -(p[4] + off) * 1.4426950408889634f; o1.y = -(p[5] + off) * 1.4426950408889634f; o1.z = -(p[6] + off) * 1.4426950408889634f; o1.w = -(p[7] + off) * 1.4426950408889634f;
        float* dst = KB + (size_t)bh * SEQ + 8 * tid;
        *(f32x4*)dst = o0; *(f32x4*)(dst + 4) = o1;
        __syncthreads();
    }
}

template <bool FROM_LDS> __device__ __forceinline__ void scan_phase(LAS unsigned char* lds, int lane, int wave, int vcu) {
    KArgs a = kargs();
    const float* SB = (const float*)(a->ws + WS_SBUF); bf16* AA = (bf16*)(a->ws + WS_AALL);
    LAS float* est = (LAS float*)(lds + (FROM_LDS ? 256 * pg8::SL_PITCH * 4 : RING_OFF));
    const LAS float* SL = (const LAS float*)(lds + RING_OFF);
    for (int w = vcu; w < NG * BATCH; w += gridDim.x) {
        const int g = w >> 2, b = w & 3, p = lane;
        const f32x4 lt = *(const f32x4*)((const float*)(a->ws + WS_LAMT) + (size_t)(g * 64 + p) * 4);
        const float l16r = lt.x, l16i = lt.y, l512r = lt.z, l512i = lt.w;
        const size_t row0 = (size_t)g * 1024 + b * 256 + 32 * wave;
        float sr[32], si[32];
#pragma unroll
        for (int i = 0; i < 32; ++i) { if (FROM_LDS) { sr[i] = SL[(32 * wave + i) * pg8::SL_PITCH + p]; si[i] = SL[(32 * wave + i) * pg8::SL_PITCH + 64 + p]; } else { sr[i] = SB[(row0 + i) * 128 + p]; si[i] = SB[(row0 + i) * 128 + 64 + p]; } }
        float xr = 0.f, xi = 0.f;
#pragma unroll
        for (int i = 0; i < 32; ++i) { const float nr = l16r * xr - l16i * xi + sr[i], ni = l16r * xi + l16i * xr + si[i]; xr = nr; xi = ni; sr[i] = xr; si[i] = xi; }
        est[(wave * 64 + p) * 2] = xr; est[(wave * 64 + p) * 2 + 1] = xi;
        __syncthreads();
        float pr = 0.f, pi = 0.f;
        for (int v = 0; v < wave; ++v) { const float er = est[(v * 64 + p) * 2], ei = est[(v * 64 + p) * 2 + 1]; const float nr = l512r * pr - l512i * pi + er, ni = l512r * pi + l512i * pr + ei; pr = nr; pi = ni; }
        float qr = 0.f, qi = 0.f;
#pragma unroll
        for (int i = 0; i < 32; ++i) { bf16* dst = AA + (row0 + i) * KA + 256 + p;
            dst[0] = (bf16)f2bf(qr + pr); dst[64] = (bf16)f2bf(qi + pi);
            qr = sr[i]; qi = si[i];
            const float nr = l16r * pr - l16i * pi, ni = l16r * pi + l16i * pr; pr = nr; pi = ni; }
        __syncthreads();
    }
}

__global__ void __launch_bounds__(NWAVES * 64, 2) fwd_megakernel(Args args) {
    extern __shared__ __attribute__((aligned(16))) unsigned char lds_raw[];
    cg::grid_group grid = cg::this_grid();
    LAS unsigned char* lds = (LAS unsigned char*)lds_raw;
    const int tid = threadIdx.x, lane = tid & 63, wave = __builtin_amdgcn_readfirstlane(tid >> 6);
    const int G = gridDim.x; const int bx = blockIdx.x; const int vcu = (G % 8 == 0) ? (bx % 8) * (G / 8) + bx / 8 : bx;
    const int lo = kargs()->ph_lo, hi = kargs()->ph_hi;
#define ws (kargs()->ws)
#define AIN(k) (kargs()->in[k])
#define AOUT (kargs()->out)
#ifndef ONLY
#define ONLY -1
#endif
#define IN(k) ((ONLY < 0 || ONLY == (k)) && lo <= (k) && (k) < hi)
#define WG_SEAM() do { asm volatile("s_waitcnt vmcnt(0) lgkmcnt(0)" ::: "memory"); __syncthreads(); if (wave == 0) { __builtin_amdgcn_fence(__ATOMIC_ACQUIRE, "agent"); asm volatile("s_waitcnt vmcnt(0)" ::: "memory"); } __syncthreads(); } while (0)
#define SEAM(k) do { if (IN(k) && IN((k) + 1)) { xcd_barrier(xbar); } } while (0)
#define rowss ((float*)(ws + WS_CTL))
#define XN ((bf16*)(ws + WS_XN))
#define HB ((bf16*)(ws + WS_H))

    if (tid < 32) ((LAS unsigned*)(lds + MISC_OFF))[tid] = 0u;
    if (bx == 0) { unsigned* bw = (unsigned*)(ws + WS_BAR); for (int i = tid; i < XCD_BAR_WORDS; i += NWAVES * 64) bw[i] = 0u; if (tid < 9) bw[4096 + 64 * tid] = 0u; }
    if (IN(0)) { p0_prologue(lds, tid, lane, wave, vcu, G); }
    __threadfence(); grid.sync();
    XcdBarrier xbar = xcd_barrier_post((unsigned*)(ws + WS_BAR), (volatile LAS unsigned*)(lds + MISC_OFF) + 8);
    if (IN(1)) cumsum_phase(lds, tid, lane, wave);
    if (IN(1)) {
        pg8::Gemm g{XN, (const bf16*)(ws + WS_WQKV), M, NQKV, D, D, D}; pg8::StaticOrder S; S.init(M, NQKV, G, bx);
        { LAS float* gl = (LAS float*)(lds + MISC_OFF + 1024); if (tid < 64) gl[tid] = AIN(5)[tid] * attn_body::C2; else if (tid < 128) gl[tid] = AIN(6)[tid - 64]; __syncthreads(); }
        pg8::EpiQKV E{(bf16*)(ws + WS_QO), (size_t)(WS_K - WS_QO) / 2, (PG8_LAS const float*)(lds + MISC_OFF + 1024)};
        pg8::gemm_phase(lds + RING_OFF, g, S, E);
    }
    SEAM(1);
    if (IN(2)) {
        const attn_body::AttnTensors AT{(const attn_body::bf16*)(ws + WS_QO), (const attn_body::bf16*)(ws + WS_K), (const attn_body::bf16*)(ws + WS_V), (attn_body::bf16*)(ws + WS_O), (const float*)(ws + WS_KB), AIN(5), AIN(6)};
        const attn_body::StaticOrder S(G, bx);
        attn_body::attn_phase<attn_body::StaticOrder>((char*)lds_raw + RING_OFF, AT, S, (unsigned*)(ws + WS_BAR) + 4096, (volatile LAS unsigned*)(lds + MISC_OFF) + 16, xbar.x);
        ssm_setup(lds, tid, (unsigned*)(ws + WS_BAR) + 4096 + 64 * 8, (volatile LAS unsigned*)(lds + MISC_OFF) + 18);
    }
    SEAM(2);
    if (IN(3)) {
        pg8::Gemm g{(const bf16*)(ws + WS_O), (const bf16*)(ws + WS_WO), M, D, D, D, D}; pg8::StaticOrder S; S.init(M, D, G, bx);
        pg8::EpiResid E{nullptr, XN, nullptr, XN, rowss, rowss + 3 * M, AIN(1), nullptr};
        pg8::gemm_phase(lds + RING_OFF, g, S, E);
    }
    SEAM(3);
    if (IN(4)) {
        pg8::Gemm g{XN, (const bf16*)(ws + WS_W1A), M, FF, D, D, D}; pg8::StaticOrder S; S.init(M, FF, G, bx);
        pg8::EpiSqrelu E{HB, FF};
        pg8::gemm_phase(lds + RING_OFF, g, S, E);
    }
    SEAM(4);
    if (IN(5)) {
        pg8::Gemm g{HB, (const bf16*)(ws + WS_W2A), M, D, FF, FF, FF}; pg8::StaticOrder S; S.init(M, D, G, bx);
        pg8::EpiResid E{nullptr, XN, nullptr, XN, rowss + M, nullptr, nullptr, rowss};
        pg8::gemm_phase(lds + RING_OFF, g, S, E);
    }
    SEAM(5);
    if (IN(6)) {
        pg8::Gemm g{XN, (const bf16*)(ws + WS_WSSM), M, D, D, D, D}; pg8::StaticOrder S; S.init(M, D, G, bx);
        pg8::EpiU E{(bf16*)(ws + WS_AALL), rowss + M};
        pg8::gemm_phase(lds + RING_OFF, g, S, E);
    }
    SEAM(6);
    if (G == NG * BATCH) {
        if (IN(7)) {
            pg8::Gemm g{(const bf16*)(ws + WS_AALL), (const bf16*)(ws + WS_WT1), NG * 1024, 256, 256, KA, 256}; pg8::BatchOrder S; S.init(NG * 4, G, vcu);
            pg8::EpiSLds E{(PG8_LAS float*)(lds + RING_OFF)};
            pg8::gemm_phase(lds + RING_OFF, g, S, E);
        }
        __syncthreads();
        if (IN(8)) scan_phase<true>(lds, lane, wave, vcu);
        WG_SEAM();
    } else {
        if (IN(7)) {
            pg8::Gemm g{(const bf16*)(ws + WS_AALL), (const bf16*)(ws + WS_WT1), NG * 1024, 256, 256, KA, 256}; pg8::BatchOrder S; S.init(NG * 4, G, vcu);
            pg8::EpiS E{(float*)(ws + WS_SBUF)};
            pg8::gemm_phase(lds + RING_OFF, g, S, E);
        }
        SEAM(7);
        if (IN(8)) scan_phase<false>(lds, lane, wave, vcu);
        SEAM(8);
    }
    if (IN(9)) {
        pg8::Gemm g{(const bf16*)(ws + WS_AALL), (const bf16*)(ws + WS_BT3), NG * 1024, 256, KA, KA, KA}; pg8::BatchOrder S; S.init(NG * 4, G, vcu);
        pg8::EpiY E{(bf16*)(ws + WS_Z)};
        pg8::gemm_phase(lds + RING_OFF, g, S, E);
    }
    SEAM(9);
    if (IN(10)) {
        pg8::Gemm g{(const bf16*)(ws + WS_Z), (const bf16*)(ws + WS_WGLU), M, 2 * D, D, D, D}; pg8::StaticOrder S; S.init(M, 2 * D, G, bx);
        pg8::EpiGlu E{XN, rowss + 2 * M};
        pg8::gemm_phase(lds + RING_OFF, g, S, E);
    }
    SEAM(10);
    if (IN(11)) {
        pg8::Gemm g{XN, (const bf16*)(ws + WS_W1B), M, FF, D, D, D}; pg8::StaticOrder S; S.init(M, FF, G, bx);
        pg8::EpiSqrelu E{HB, FF};
        pg8::gemm_phase(lds + RING_OFF, g, S, E);
    }
    SEAM(11);
    if (IN(12)) {
        pg8::Gemm g{HB, (const bf16*)(ws + WS_W2B), M, D, FF, FF, FF}; pg8::StaticOrder S; S.init(M, D, G, bx);
        pg8::EpiResid E{nullptr, XN, AOUT, nullptr, nullptr, nullptr, nullptr, rowss + 2 * M};
        pg8::gemm_phase(lds + RING_OFF, g, S, E);
    }
#undef IN
#undef SEAM
#undef ws
#undef AIN
#undef AOUT
#undef rowss
#undef XN
#undef HB
}

extern "C" void kernel_launch(void* const* d_in, const int* in_sizes, int n_in, void* d_out, int out_size, void* d_ws, size_t ws_size, hipStream_t stream) {
    static int grid = 0;
    if (grid == 0) {
        if (n_in != 20 || in_sizes[0] != M * D || out_size != M * D || ws_size < WS_END) { fprintf(stderr, "kernel_launch: unexpected shapes (n_in %d, in0 %d, out %d, ws %zu)\n", n_in, n_in > 0 ? in_sizes[0] : -1, out_size, ws_size); grid = -1; return; }
        int dev = 0, cus = 0, per_cu = 0;
        if (hipGetDevice(&dev) != hipSuccess || hipDeviceGetAttribute(&cus, hipDeviceAttributeMultiprocessorCount, dev) != hipSuccess) { grid = -1; return; }
        if (hipFuncSetAttribute((const void*)fwd_megakernel, hipFuncAttributeMaxDynamicSharedMemorySize, LDS_BYTES) != hipSuccess) { fprintf(stderr, "kernel_launch: hipFuncSetAttribute failed\n"); grid = -1; return; }
        if (hipOccupancyMaxActiveBlocksPerMultiprocessor(&per_cu, (const void*)fwd_megakernel, NWAVES * 64, LDS_BYTES) != hipSuccess || per_cu < 1) { fprintf(stderr, "kernel_launch: occupancy query reports %d workgroups per CU\n", per_cu); (void)hipGetLastError(); per_cu = 1; }
        grid = cus;
        if (grid != 256) fprintf(stderr, "kernel_launch: %d CUs; the attention unit order expects 256\n", grid);
    }
    if (grid < 0) return;
    Args a{};
    for (int i = 0; i < 20; ++i) a.in[i] = (const float*)d_in[i];
    a.out = (float*)d_out; a.ws = (unsigned char*)d_ws; a.ph_lo = 0; a.ph_hi = 13;
    void* params[] = {&a};
    const hipError_t le = hipLaunchCooperativeKernel((const void*)fwd_megakernel, dim3(grid), dim3(NWAVES * 64), params, LDS_BYTES, stream);
    if (le != hipSuccess) fprintf(stderr, "kernel_launch: cooperative launch failed: %s (grid %d)\n", hipGetErrorName(le), grid);
}
```

```cpp
#include <hip/hip_runtime.h>
#include <hip/hip_cooperative_groups.h>
#include <hip/hip_bf16.h>
#include <cstdio>
#include <cstdint>
#include <cmath>
namespace cg = cooperative_groups;

namespace pg8 {
#define PG8_LAS __attribute__((address_space(3)))
typedef unsigned short bf16_t;
typedef short bf16x8 __attribute__((ext_vector_type(8)));
typedef float f32x4 __attribute__((ext_vector_type(4)));
typedef unsigned u32x4 __attribute__((ext_vector_type(4)));
constexpr int BM = 256, BK = 64, HALF = 128, HTB = HALF * BK * 2  , STAGE_BYTES = 8 * HTB, NXCD = 8, WGM = 8;

__host__ __device__ __forceinline__ int lds_byte(int r, int c) { const int st = (r >> 4) * 2 + (c >> 5), rr = r & 15, cc = c & 31, ob = rr * 64 + cc * 2; return st * 1024 + (ob ^ (((ob >> 9) & 1) << 5)); }
__host__ __device__ __forceinline__ void stage_rc(int b, int& R, int& C) { const int st = b / 1024, sb = b % 1024, swz = sb ^ (((sb >> 9) & 1) << 5); R = (st >> 1) * 16 + swz / 64; C = (st & 1) * 32 + (swz % 64) / 2; }
__host__ __device__ __forceinline__ int perm32(int rho) { const int n = rho >> 4, i = rho & 15; return 8 * (i >> 2) + 4 * n + (i & 3); }

struct Unit { int pm, pn; };
struct Gemm { const bf16_t* A; const bf16_t* Bt; int M, N, K, lda, ldb; };

struct StaticOrder {
    int nM, nN, nwg, G, c;
    __host__ __device__ void init(int M, int N, int G_, int c_) { nM = M / BM; nN = N / BM; nwg = nM * nN; G = G_; c = c_; }
    __host__ __device__ bool next(int i, Unit& u) const {
        const long L = (long)i * G + c; if (L >= nwg) return false;
        int wgid = (int)L; { const int q = nwg / NXCD, r = nwg % NXCD, xcd = wgid % NXCD, off = wgid / NXCD; wgid = (xcd < r ? xcd * (q + 1) : r * (q + 1) + (xcd - r) * q) + off; }
        const int nig = WGM * nN, gid = wgid / nig, fm = gid * WGM, gsz = (nM - fm) < WGM ? (nM - fm) : WGM;
        u.pm = fm + ((wgid % nig) % gsz); u.pn = (wgid % nig) / gsz; return true;
    }
};
struct BatchOrder {
    int n, G, c;
    __host__ __device__ void init(int n_, int G_, int c_) { n = n_; G = G_; c = c_; }
    __host__ __device__ bool next(int i, Unit& u) const { const long L = (long)i * G + c; if (L >= n) return false; u.pm = (int)L; u.pn = (int)(L >> 2); return true; }
};

__device__ __forceinline__ unsigned cvt_pk_bf16(float lo, float hi) { unsigned r; asm volatile("v_cvt_pk_bf16_f32 %0, %1, %2" : "=v"(r) : "v"(lo), "v"(hi)); return r; }
__device__ __forceinline__ u32x4 pack8(const f32x4 v0, const f32x4 v1) { u32x4 w; w.x = cvt_pk_bf16(v0[0], v0[1]); w.y = cvt_pk_bf16(v0[2], v0[3]); w.z = cvt_pk_bf16(v1[0], v1[1]); w.w = cvt_pk_bf16(v1[2], v1[3]); return w; }
__device__ __forceinline__ float fq_sum(float s) {
    auto a = __builtin_amdgcn_permlane16_swap(__float_as_uint(s), __float_as_uint(s), false, false); s = __uint_as_float(a[0]) + __uint_as_float(a[1]);
    auto b = __builtin_amdgcn_permlane32_swap(__float_as_uint(s), __float_as_uint(s), false, false); return __uint_as_float(b[0]) + __uint_as_float(b[1]); }
__device__ __forceinline__ float bf2f(unsigned short h) { return __uint_as_float(((unsigned)h) << 16); }
__device__ __forceinline__ float sq4(const f32x4 x) { return (x[0] * x[0] + x[1] * x[1]) + (x[2] * x[2] + x[3] * x[3]); }
__device__ __forceinline__ float sigmoid_f(float x) { return __builtin_amdgcn_rcpf(1.0f + __builtin_amdgcn_exp2f(-1.4426950408889634f * x)); }
__device__ __forceinline__ float gelu_tanh_f(float y) { const float a = y * (1.0f + 0.044715f * y * y) * (2.0f * 0.7978845608028654f); return y * sigmoid_f(a); }
constexpr float RMS_EPS = 1e-6f;

struct EpiQKV {
    static constexpr bool PERM = true, AFTER_DRAIN = false;
    bf16_t* Q; size_t kv_stride; PG8_LAS const float* gl;
    __device__ __forceinline__ void operator()(const f32x4 (&acc)[2][2][4][2], const Unit& u, int wr, int wc, int fr, int fq) const {
        const int t = u.pn >> 2;
        bf16_t* base = Q + (size_t)t * kv_stride;
        int row0 = u.pm * BM + wr * 64 + fr, col0 = (u.pn & 3) * BM + wc * 64 + 8 * fq;
        asm volatile("" : "+v"(row0), "+v"(col0));
        f32x4 g[2][2];
#pragma unroll
        for (int bj = 0; bj < 2; ++bj)
#pragma unroll
            for (int n = 0; n < 2; ++n) g[bj][n] = (f32x4){1.f, 1.f, 1.f, 1.f};
        if (t < 2) { PG8_LAS const float* gs = gl + 64 * t + 8 * fq;
#pragma unroll
            for (int bj = 0; bj < 2; ++bj)
#pragma unroll
                for (int n = 0; n < 2; ++n) g[bj][n] = *(PG8_LAS const f32x4*)(gs + 32 * bj + 4 * n); }
#pragma unroll
        for (int ai = 0; ai < 2; ++ai)
#pragma unroll
            for (int m = 0; m < 4; ++m) { bf16_t* rowp = base + (size_t)(row0 + ai * HALF + m * 16) * 1024 + col0;
                float r = 1.f;
                if (t < 2) { float s = (sq4(acc[ai][0][m][0]) + sq4(acc[ai][0][m][1])) + (sq4(acc[ai][1][m][0]) + sq4(acc[ai][1][m][1]));
                    s = fq_sum(s); r = __builtin_amdgcn_rsqf(s * (1.0f / 64.0f) + RMS_EPS); }
#pragma unroll
                for (int bj = 0; bj < 2; ++bj) *(u32x4*)(rowp + bj * 32) = pack8(acc[ai][bj][m][0] * r * g[bj][0], acc[ai][bj][m][1] * r * g[bj][1]); }
    }
};

__device__ __forceinline__ void unpack8(const u32x4 w, f32x4& v0, f32x4& v1) {
    v0[0] = __uint_as_float(w.x << 16); v0[1] = __uint_as_float(w.x & 0xffff0000u); v0[2] = __uint_as_float(w.y << 16); v0[3] = __uint_as_float(w.y & 0xffff0000u);
    v1[0] = __uint_as_float(w.z << 16); v1[1] = __uint_as_float(w.z & 0xffff0000u); v1[2] = __uint_as_float(w.w << 16); v1[3] = __uint_as_float(w.w & 0xffff0000u); }
struct EpiResid {
    static constexpr bool PERM = true, AFTER_DRAIN = false;
    const float* basef; const bf16_t* baseb; float* out; bf16_t* xb; float* rowss; const float* unss; const float* ung; const float* accss;
    __device__ __forceinline__ void operator()(const f32x4 (&acc)[2][2][4][2], const Unit& u, int wr, int wc, int fr, int fq) const {
        const int row0 = u.pm * BM + wr * 64 + fr, col0 = u.pn * BM + wc * 32 + 8 * fq;
        f32x4 ginv[2][2];
#pragma unroll
        for (int bj = 0; bj < 2; ++bj)
#pragma unroll
            for (int n = 0; n < 2; ++n) { ginv[bj][n] = (f32x4){1.f, 1.f, 1.f, 1.f}; if (unss) { const f32x4 gg = *(const f32x4*)(ung + col0 + bj * HALF + 4 * n);
#pragma unroll
                for (int i = 0; i < 4; ++i) ginv[bj][n][i] = __builtin_amdgcn_rcpf(gg[i]); } }
#pragma unroll
        for (int ai = 0; ai < 2; ++ai)
#pragma unroll
            for (int m = 0; m < 4; ++m) { const int row = row0 + ai * HALF + m * 16; const size_t off = (size_t)row * 1024 + col0; float sq = 0.f;
                const float asc = accss ? __builtin_amdgcn_rcpf(accss[row] * (1.0f / 1024.0f) + RMS_EPS) : 1.0f;
#pragma unroll
                for (int bj = 0; bj < 2; ++bj) {
                    f32x4 b0, b1;
                    if (basef) { b0 = *(const f32x4*)(basef + off + bj * HALF); b1 = *(const f32x4*)(basef + off + bj * HALF + 4); }
                    else { unpack8(*(const u32x4*)(baseb + off + bj * HALF), b0, b1);
                        if (unss) { const float ri = __builtin_amdgcn_sqrtf(unss[row] * (1.0f / 1024.0f) + RMS_EPS); b0 = b0 * ri * ginv[bj][0]; b1 = b1 * ri * ginv[bj][1]; } }
                    const f32x4 v0 = acc[ai][bj][m][0] * asc + b0, v1 = acc[ai][bj][m][1] * asc + b1;
                    if (out) { __builtin_nontemporal_store(v0, (f32x4*)(out + off + bj * HALF)); __builtin_nontemporal_store(v1, (f32x4*)(out + off + bj * HALF + 4)); }
                    if (xb) *(u32x4*)(xb + off + bj * HALF) = pack8(v0, v1);
                    sq += sq4(v0) + sq4(v1); }
                if (rowss) { sq = fq_sum(sq); if (fq == 0) atomicAdd(rowss + row, sq); } }
    }
};
struct EpiGlu {
    static constexpr bool PERM = true, AFTER_DRAIN = false;
    bf16_t* xb; float* rowss;
    __device__ __forceinline__ void operator()(const f32x4 (&acc)[2][2][4][2], const Unit& u, int wr, int wc, int fr, int fq) const {
        const int row0 = u.pm * BM + wr * 64 + fr, col0 = u.pn * HALF + wc * 32 + 8 * fq;
#pragma unroll
        for (int ai = 0; ai < 2; ++ai)
#pragma unroll
            for (int m = 0; m < 4; ++m) { const int row = row0 + ai * HALF + m * 16; const size_t off = (size_t)row * 1024 + col0;
                f32x4 v[2]; unpack8(*(const u32x4*)(xb + off), v[0], v[1]);
#pragma unroll
                for (int n = 0; n < 2; ++n) { const f32x4 val = acc[ai][0][m][n], gt = acc[ai][1][m][n];
#pragma unroll
                    for (int i = 0; i < 4; ++i) v[n][i] += val[i] * sigmoid_f(gt[i]); }
                *(u32x4*)(xb + off) = pack8(v[0], v[1]);
                float sq = sq4(v[0]) + sq4(v[1]);
                sq = fq_sum(sq); if (fq == 0) atomicAdd(rowss + row, sq); }
    }
};
struct EpiSqrelu {
    static constexpr bool PERM = true, AFTER_DRAIN = false;
    bf16_t* O; int ldc;
    __device__ __forceinline__ void operator()(const f32x4 (&acc)[2][2][4][2], const Unit& u, int wr, int wc, int fr, int fq) const {
        const int row0 = u.pm * BM + wr * 64 + fr, col0 = u.pn * BM + wc * 32 + 8 * fq;
#pragma unroll
        for (int ai = 0; ai < 2; ++ai)
#pragma unroll
            for (int m = 0; m < 4; ++m) { const int row = row0 + ai * HALF + m * 16;
                bf16_t* rowp = O + (size_t)row * ldc + col0;
#pragma unroll
                for (int bj = 0; bj < 2; ++bj) { f32x4 v0 = acc[ai][bj][m][0], v1 = acc[ai][bj][m][1];
#pragma unroll
                    for (int i = 0; i < 4; ++i) { const float a = fmaxf(v0[i], 0.f), b = fmaxf(v1[i], 0.f); v0[i] = a * a; v1[i] = b * b; }
                    *(u32x4*)(rowp + bj * HALF) = pack8(v0, v1); } }
    }
};
struct EpiU {
    static constexpr bool PERM = true, AFTER_DRAIN = false;
    bf16_t* AA; const float* rowss;
    __device__ __forceinline__ void operator()(const f32x4 (&acc)[2][2][4][2], const Unit& u, int wr, int wc, int fr, int fq) const {
        const int row0 = u.pm * BM + wr * 64 + fr, col0 = u.pn * BM + wc * 32 + 8 * fq;
#pragma unroll
        for (int ai = 0; ai < 2; ++ai)
#pragma unroll
            for (int m = 0; m < 4; ++m) { const int row = row0 + ai * HALF + m * 16; const float rs = __builtin_amdgcn_rsqf(rowss[row] * (1.0f / 1024.0f) + RMS_EPS);
                const int kc = row >> 4, s = row & 15;
#pragma unroll
                for (int bj = 0; bj < 2; ++bj) { const int n = col0 + bj * HALF, g = n >> 4, c0 = n & 15;
                    *(u32x4*)(AA + ((size_t)(g * 1024 + kc) * 384 + s * 16 + c0)) = pack8(acc[ai][bj][m][0] * rs, acc[ai][bj][m][1] * rs); } }
    }
};
struct EpiS {
    static constexpr bool PERM = true, AFTER_DRAIN = false;
    float* S;
    __device__ __forceinline__ void operator()(const f32x4 (&acc)[2][2][4][2], const Unit& u, int wr, int wc, int fr, int fq) const {
        const int row0 = u.pm * BM + wr * 64 + fr, col0 = wc * 32 + 8 * fq;
#pragma unroll
        for (int ai = 0; ai < 2; ++ai)
#pragma unroll
            for (int m = 0; m < 4; ++m) { float* p = S + (size_t)(row0 + ai * HALF + m * 16) * 128 + col0;
                *(f32x4*)p = acc[ai][0][m][0]; *(f32x4*)(p + 4) = acc[ai][0][m][1]; }
    }
};
constexpr int SL_PITCH = 132;
struct EpiSLds {
    static constexpr bool PERM = true, AFTER_DRAIN = true;
    PG8_LAS float* SL;
    __device__ __forceinline__ void operator()(const f32x4 (&acc)[2][2][4][2], const Unit& u, int wr, int wc, int fr, int fq) const {
        const int row0 = wr * 64 + fr, col0 = wc * 32 + 8 * fq;
#pragma unroll
        for (int ai = 0; ai < 2; ++ai)
#pragma unroll
            for (int m = 0; m < 4; ++m) { PG8_LAS float* p = SL + (row0 + ai * HALF + m * 16) * SL_PITCH + col0;
                *(PG8_LAS f32x4*)p = acc[ai][0][m][0]; *(PG8_LAS f32x4*)(p + 4) = acc[ai][0][m][1]; }
    }
};
struct EpiY {
    static constexpr bool PERM = true, AFTER_DRAIN = false;
    bf16_t* Z;
    __device__ __forceinline__ void operator()(const f32x4 (&acc)[2][2][4][2], const Unit& u, int wr, int wc, int fr, int fq) const {
        int row0 = u.pm * BM + wr * 64 + fr, n0 = wc * 32 + 8 * fq; const int g = u.pn;
        asm volatile("" : "+v"(row0), "+v"(n0));
#pragma unroll
        for (int ai = 0; ai < 2; ++ai)
#pragma unroll
            for (int m = 0; m < 4; ++m) { const int row = row0 + ai * HALF + m * 16, kc = row & 1023;
#pragma unroll
                for (int bj = 0; bj < 2; ++bj) { const int n = n0 + bj * HALF, j = n >> 4, c0 = n & 15, ch = 16 * g + c0;
                    f32x4 v0 = acc[ai][bj][m][0], v1 = acc[ai][bj][m][1];
#pragma unroll
                    for (int i = 0; i < 4; ++i) { v0[i] = gelu_tanh_f(v0[i]); v1[i] = gelu_tanh_f(v1[i]); }
                    *(u32x4*)(Z + (size_t)(kc * 16 + j) * 1024 + ch) = pack8(v0, v1); } }
    }
};

template <class Epi, class Sched>
__device__ __forceinline__ void gemm_phase(PG8_LAS unsigned char* lds, const Gemm g, const Sched& S, const Epi& E) {
    int tid_ = threadIdx.x; asm volatile("" : "+v"(tid_));
    const int tid = tid_, wid = __builtin_amdgcn_readfirstlane(tid >> 6), lane = tid & 63, wr = wid >> 2, wc = wid & 3, fr = lane & 15, fq = lane >> 4;
    const int K = g.K, nt = K / BK;
    unsigned voffA[2], voffB[2];
#pragma unroll
    for (int i = 0; i < 2; ++i) { int R, C; stage_rc(tid * 16 + i * 8192, R, C); const int Rb = Epi::PERM ? ((R & ~31) + perm32(R & 31)) : R;
        voffA[i] = (unsigned)(R * g.lda + C) * 2u; voffB[i] = (unsigned)(Rb * g.ldb + C) * 2u; }
    const size_t kstep = (size_t)(BK * 2);
    const size_t hA = (size_t)HALF * g.lda * 2, hB = (size_t)HALF * g.ldb * 2;
    const size_t tA = 2 * hA, tB = 2 * hB;
    const unsigned ldsw = (unsigned)wid * 1024u;
    const int aoff = lds_byte(wr * 64 + fr, fq * 8), boff = lds_byte(wc * 32 + fr, fq * 8);
#define PG8_SA(b, h) (((b) * 2 + (h)) * HTB)
#define PG8_SB(b, h) ((4 + (b) * 2 + (h)) * HTB)
#define PG8_STAGE(bufoff, gbase, voff) do { _Pragma("unroll") for (int _i = 0; _i < 2; ++_i) \
        __builtin_amdgcn_global_load_lds((const unsigned*)((const char*)(gbase) + (voff)[_i]), (PG8_LAS unsigned*)(lds + (bufoff) + ldsw + _i * 8192), 16, 0, 0); } while (0)
#define PG8_LDA(dst, b, h) do { _Pragma("unroll") for (int m = 0; m < 4; ++m) _Pragma("unroll") for (int k = 0; k < 2; ++k) dst[m][k] = *(const PG8_LAS bf16x8*)(lds + PG8_SA(b, h) + aoff + m * 2048 + k * 1024); } while (0)
#define PG8_LDB(dst, b, h) do { _Pragma("unroll") for (int n = 0; n < 2; ++n) _Pragma("unroll") for (int k = 0; k < 2; ++k) dst[n][k] = *(const PG8_LAS bf16x8*)(lds + PG8_SB(b, h) + boff + n * 2048 + k * 1024); } while (0)
#define PG8_MMA(ai, bj, At, Bt) do { __builtin_amdgcn_s_setprio(1); _Pragma("unroll") for (int m = 0; m < 4; ++m) _Pragma("unroll") for (int n = 0; n < 2; ++n) _Pragma("unroll") for (int k = 0; k < 2; ++k) \
        acc[ai][bj][m][n] = __builtin_amdgcn_mfma_f32_16x16x32_bf16(Bt[n][k], At[m][k], acc[ai][bj][m][n], 0, 0, 0); __builtin_amdgcn_s_setprio(0); } while (0)
#define PG8_WAIT_V(n) asm volatile("s_waitcnt vmcnt(" #n ")" ::: "memory")
#define PG8_WAIT_L(n) asm volatile("s_waitcnt lgkmcnt(" #n ")" ::: "memory")
#define PG8_BAR __builtin_amdgcn_s_barrier()
#define PG8_SCHED __builtin_amdgcn_sched_barrier(0)
    Unit cur, nxt; int ui = 0;
    if (!S.next(0, cur)) return;
    f32x4 acc[2][2][4][2];
#pragma unroll
    for (int a = 0; a < 2; ++a)
#pragma unroll
        for (int b = 0; b < 2; ++b)
#pragma unroll
            for (int m = 0; m < 4; ++m)
#pragma unroll
                for (int n = 0; n < 2; ++n) acc[a][b][m][n] = (f32x4){0.f, 0.f, 0.f, 0.f};
    bf16x8 At[4][2], B0[2][2], B1[2][2];
    const char* cA = (const char*)g.A + (size_t)cur.pm * tA; const char* cB = (const char*)g.Bt + (size_t)cur.pn * tB;
    PG8_STAGE(PG8_SB(0, 0), cB, voffB); PG8_STAGE(PG8_SB(0, 1), cB + hB, voffB); PG8_STAGE(PG8_SA(0, 0), cA, voffA); PG8_STAGE(PG8_SA(0, 1), cA + hA, voffA);
    if (wr == 1) PG8_BAR;
    PG8_WAIT_V(2); PG8_BAR;
    PG8_STAGE(PG8_SB(1, 0), cB + kstep, voffB); PG8_STAGE(PG8_SA(1, 0), cA + kstep, voffA); PG8_STAGE(PG8_SB(1, 1), cB + hB + kstep, voffB);
    PG8_WAIT_V(6); PG8_BAR;
    for (;;) {
        const bool has_next = S.next(ui + 1, nxt);
        const char* nA = has_next ? (const char*)g.A + (size_t)nxt.pm * tA : cA; const char* nB = has_next ? (const char*)g.Bt + (size_t)nxt.pn * tB : cB;
        for (int t = 0; t < nt; t += 2) {
            const bool last = (t == nt - 2);
            const char* a1 = cA + (size_t)(t + 1) * kstep;
            const char* a2 = last ? nA : cA + (size_t)(t + 2) * kstep; const char* b2 = last ? nB : cB + (size_t)(t + 2) * kstep;
            const char* a3 = a2 + kstep; const char* b3 = b2 + kstep;
            PG8_LDB(B0, 0, 0); PG8_LDB(B1, 0, 1); PG8_SCHED; PG8_LDA(At, 0, 0); PG8_STAGE(PG8_SA(1, 1), a1 + hA, voffA);
            PG8_WAIT_V(8); PG8_WAIT_L(0); PG8_BAR; PG8_MMA(0, 0, At, B0); PG8_MMA(0, 1, At, B1); PG8_BAR; PG8_SCHED;
            PG8_LDA(At, 0, 1); PG8_STAGE(PG8_SB(0, 0), b2, voffB); PG8_STAGE(PG8_SB(0, 1), b2 + hB, voffB); PG8_STAGE(PG8_SA(0, 0), a2, voffA);
            PG8_WAIT_V(8); PG8_WAIT_L(0); PG8_BAR; PG8_MMA(1, 0, At, B0); PG8_MMA(1, 1, At, B1); PG8_BAR; PG8_SCHED;
            PG8_LDB(B0, 1, 0); PG8_LDB(B1, 1, 1); PG8_SCHED; PG8_LDA(At, 1, 0); PG8_STAGE(PG8_SA(0, 1), a2 + hA, voffA);
            PG8_WAIT_V(8); PG8_WAIT_L(0); PG8_BAR; PG8_MMA(0, 0, At, B0); PG8_MMA(0, 1, At, B1); PG8_BAR; PG8_SCHED;
            PG8_LDA(At, 1, 1); PG8_STAGE(PG8_SB(1, 0), b3, voffB); PG8_STAGE(PG8_SB(1, 1), b3 + hB, voffB); PG8_STAGE(PG8_SA(1, 0), a3, voffA);
            PG8_WAIT_V(8); PG8_WAIT_L(0); PG8_BAR; PG8_MMA(1, 0, At, B0); PG8_MMA(1, 1, At, B1); PG8_BAR; PG8_SCHED;
        }
        if (wr == 0) PG8_BAR;
        if constexpr (!Epi::AFTER_DRAIN) E(acc, cur, wr, wc, fr, fq);
        if (!has_next) break;
#pragma unroll
        for (int a = 0; a < 2; ++a)
#pragma unroll
            for (int b = 0; b < 2; ++b)
#pragma unroll
                for (int m = 0; m < 4; ++m)
#pragma unroll
                    for (int n = 0; n < 2; ++n) acc[a][b][m][n] = (f32x4){0.f, 0.f, 0.f, 0.f};
        cur = nxt; cA = nA; cB = nB; ++ui;
        if (wr == 1) PG8_BAR;
    }
    PG8_WAIT_V(0);
    PG8_BAR;
    if constexpr (Epi::AFTER_DRAIN) E(acc, cur, wr, wc, fr, fq);
#undef PG8_SA
#undef PG8_SB
#undef PG8_STAGE
#undef PG8_LDA
#undef PG8_LDB
#undef PG8_MMA
#undef PG8_WAIT_V
#undef PG8_WAIT_L
#undef PG8_BAR
#undef PG8_SCHED
}
}

#include <hip/hip_bf16.h>
#include <cmath>
namespace attn_body {
using bf16=__hip_bfloat16;
using bf16x8=__attribute__((ext_vector_type(8)))short;
using s16x4=__attribute__((ext_vector_type(4)))short;
using f32x16=__attribute__((ext_vector_type(16)))float;
using u32x4=__attribute__((ext_vector_type(4)))unsigned;
constexpr int BATCH=4,NHEAD=16,SEQ=4096,D=64,DM=NHEAD*D;
constexpr int NW=8,QBLK=32,QB=QBLK*NW,KVBLK=64,NQB=SEQ/QB;
constexpr int ATTN_PITCH=DM, ATTN_UNIT_ROWS=QB;
__device__ __forceinline__ int crow(int r,int hi){return (r&3)+8*(r>>2)+4*hi;}
#define SBAR() __builtin_amdgcn_sched_barrier(0)
__device__ __forceinline__ void cmask(f32x16&p0,f32x16&p1,int jb,int qrel,int hi){
  const float NEG=-INFINITY; int kb=64*jb+4*hi;
  #pragma unroll
  for(int r=0;r<16;++r){int kv=kb+(r&3)+8*(r>>2); if(kv>qrel)p0[r]=NEG; if(kv+32>qrel)p1[r]=NEG;}
}

constexpr int NSLOT=3, SLOTB=8192;
constexpr int LDS_K=0, LDS_V=NSLOT*SLOTB, LDS_WS=2*NSLOT*SLOTB, LDS_OST=LDS_WS+NW*64*4, LDS_KBIAS=LDS_OST+NW*4096, LDS_BYTES=LDS_KBIAS+(SEQ+64)*4;
constexpr float C2=0.125f*1.4426950408889634f;
__device__ __forceinline__ void glds16(const void*gsrc,unsigned lds_dst){unsigned keep;
  asm volatile("s_mov_b32 %0, m0\n\ts_mov_b32 m0, %2\n\ts_nop 0\n\tglobal_load_lds_dwordx4 %1, off\n\ts_mov_b32 m0, %0":"=&s"(keep):"v"(gsrc),"s"(lds_dst):"memory");}
__device__ __forceinline__ float max3f(float a,float b,float c){float r;asm("v_max3_f32 %0, %1, %2, %3":"=v"(r):"v"(a),"v"(b),"v"(c));return r;}
__device__ __forceinline__ float max2f(float a,float b){float r;asm("v_max_f32_e32 %0, %1, %2":"=v"(r):"v"(a),"v"(b));return r;}
__device__ __forceinline__ float fadd_s(float a,float b){float r;asm("v_add_f32_e32 %0, %1, %2":"=v"(r):"v"(a),"v"(b));return r;}
__device__ __forceinline__ float fsub_s(float a,float b){float r;asm("v_sub_f32_e32 %0, %1, %2":"=v"(r):"v"(a),"v"(b));return r;}
typedef float f32x2_t __attribute__((ext_vector_type(2))); typedef __bf16 bf16x2_t __attribute__((ext_vector_type(2)));
__device__ __forceinline__ unsigned cvtpk_s(float lo,float hi){f32x2_t v={lo,hi};bf16x2_t b=__builtin_convertvector(v,bf16x2_t);return __builtin_bit_cast(unsigned,b);}
#define WAIT_BAR(N) asm volatile("s_waitcnt vmcnt(" #N ") lgkmcnt(0)\n\ts_barrier":::"memory")

__device__ __forceinline__ void qkt(f32x16&p0,f32x16&p1,const char*Kslot,const bf16x8*qr,int r32,int hi){
  const char*kb=Kslot+hi*1024+r32*16;
  #pragma unroll
  for(int d0=0;d0<4;++d0){
    const bf16x8 b0=*reinterpret_cast<const bf16x8*>(kb+d0*2048);
    const bf16x8 b1=*reinterpret_cast<const bf16x8*>(kb+d0*2048+512);
    {p0=__builtin_amdgcn_mfma_f32_32x32x16_bf16(b0,qr[d0],p0,0,0,0);p1=__builtin_amdgcn_mfma_f32_32x32x16_bf16(b1,qr[d0],p1,0,0,0);}}
}
typedef __attribute__((address_space(3))) const char* lds_cptr;
typedef short v4i16_t __attribute__((ext_vector_type(4)));
__device__ __forceinline__ void kload8(bf16x8*kf,lds_cptr kp){
  kf[0]=*(const __attribute__((address_space(3))) bf16x8*)(kp);      kf[1]=*(const __attribute__((address_space(3))) bf16x8*)(kp+512);
  kf[2]=*(const __attribute__((address_space(3))) bf16x8*)(kp+2048); kf[3]=*(const __attribute__((address_space(3))) bf16x8*)(kp+2560);
  kf[4]=*(const __attribute__((address_space(3))) bf16x8*)(kp+4096); kf[5]=*(const __attribute__((address_space(3))) bf16x8*)(kp+4608);
  kf[6]=*(const __attribute__((address_space(3))) bf16x8*)(kp+6144); kf[7]=*(const __attribute__((address_space(3))) bf16x8*)(kp+6656);
}
__device__ __forceinline__ void kload2(bf16x8*kf,lds_cptr kp,int j){ kf[2*j]=*(const __attribute__((address_space(3))) bf16x8*)(kp+j*2048); kf[2*j+1]=*(const __attribute__((address_space(3))) bf16x8*)(kp+j*2048+512); }
__device__ __forceinline__ s16x4 vtr(lds_cptr p){ return __builtin_bit_cast(s16x4,__builtin_amdgcn_ds_read_tr16_b64_v4i16((__attribute__((address_space(3))) v4i16_t*)p)); }
__device__ __forceinline__ float rowmax(const f32x16&p0,const f32x16&p1){
  float a=max3f(p0[0],p0[1],p1[0]),b=max3f(p0[2],p0[3],p1[1]);a=max3f(a,p1[2],p1[3]);
  #pragma unroll
  for(int r=4;r<16;r+=4){a=max3f(a,p0[r],p0[r+1]);b=max3f(b,p0[r+2],p0[r+3]);a=max3f(a,p1[r],p1[r+1]);b=max3f(b,p1[r+2],p1[r+3]);}
  const float m=max2f(a,b);
  auto rr=__builtin_amdgcn_permlane32_swap(__float_as_uint(m),__float_as_uint(m),false,false);
  return max2f(__uint_as_float(rr[0]),__uint_as_float(rr[1]));
}
__device__ __forceinline__ void pv(f32x16*o,int vb,bf16x8 pa0,bf16x8 pa1,bf16x8 pa2,bf16x8 pa3){
  #pragma unroll
  for(int d0=0;d0<2;++d0){s16x4 lo[4],hi[4];
    #pragma unroll
    for(int ks=0;ks<4;++ks){
      asm volatile("ds_read_b64_tr_b16 %0,%1 offset:%c2":"=&v"(lo[ks]):"v"(vb),"i"(d0*4096+ks*1024):"memory");
      asm volatile("ds_read_b64_tr_b16 %0,%1 offset:%c2":"=&v"(hi[ks]):"v"(vb),"i"(d0*4096+ks*1024+512):"memory");}
    asm volatile("s_waitcnt lgkmcnt(0)":::"memory");SBAR();
    #define PK(k) (bf16x8){lo[k][0],lo[k][1],lo[k][2],lo[k][3],hi[k][0],hi[k][1],hi[k][2],hi[k][3]}
    o[d0]=__builtin_amdgcn_mfma_f32_32x32x16_bf16(pa0,PK(0),o[d0],0,0,0);
    o[d0]=__builtin_amdgcn_mfma_f32_32x32x16_bf16(pa1,PK(1),o[d0],0,0,0);
    o[d0]=__builtin_amdgcn_mfma_f32_32x32x16_bf16(pa2,PK(2),o[d0],0,0,0);
    o[d0]=__builtin_amdgcn_mfma_f32_32x32x16_bf16(pa3,PK(3),o[d0],0,0,0);
    #undef PK
  }
}

#ifndef ATTN_STORE16
#define ATTN_STORE16(p,v) (*(u32x4*)(p)=(v))
#endif
template<int THRL> __device__ __forceinline__ void attn_unit(int b,int h,int qb,const bf16*Q,const bf16*__restrict__ K,const bf16*__restrict__ V,bf16*O,const float*__restrict__ KBg,const float skip_thr,char*shm){
  int tid_=threadIdx.x; asm volatile("":"+v"(tid_)); const int tid=tid_,lane=tid&63,r32=lane&31,hi=lane>>5; const int wid=__builtin_amdgcn_readfirstlane(tid>>6);
  const long rowbase=(long)b*SEQ; const int q0=qb*QB;
  const bf16*Qw=Q+(rowbase+q0+wid*QBLK)*DM+h*D;
  const int NTF=(q0+QB)/KVBLK; int t0=0;
  { const float*kbg=KBg+(long)(b*NHEAD+h)*SEQ; const float kq=kbg[q0]; bool sk=false; if(lane<NTF-4) sk=(kq-kbg[64*lane+63])>skip_thr;
    const unsigned long long mk=__ballot(sk); t0=(mk==~0ull)?64:__builtin_ctzll(~mk); t0&=~1; if(t0>NTF-4)t0=NTF-4; t0=__builtin_amdgcn_readfirstlane(t0); }
  const bf16*Kh=K+(rowbase+(long)t0*KVBLK)*DM+h*D,*Vh=V+(rowbase+(long)t0*KVBLK)*DM+h*D;
  const lds_cptr shm3=(lds_cptr)shm;
  const unsigned lds0=(unsigned)(uintptr_t)shm;
  float*wsf=(float*)(shm+LDS_WS)+wid*64;
  const bf16*ksrc=Kh+(long)lane*DM+wid*8;
  const bf16*vsrc=Vh+(long)(16*(wid&3)+(lane>>2))*DM+(wid>>2)*32+(lane&3)*8;
  const unsigned kdst=lds0+LDS_K+wid*1024, vdst=lds0+LDS_V+wid*1024;
  #define DMA_K(t,slot) glds16(ksrc+(long)(t)*KVBLK*DM,(unsigned)__builtin_amdgcn_readfirstlane(kdst+(slot)))
  #define DMA_V(t,slot) glds16(vsrc+(long)(t)*KVBLK*DM,(unsigned)__builtin_amdgcn_readfirstlane(vdst+(slot)))
  const int vb0=(int)(lds0+LDS_V)+((lane>>4)&1)*32+(lane&3)*8+(4*hi+((lane&15)>>2))*64;
  const char*Kbase=shm+LDS_K; bf16x8 kf[8];
  const lds_cptr kp0=shm3+LDS_K+hi*1024+r32*16; const lds_cptr vp0=shm3+LDS_V+((lane>>4)&1)*32+(lane&3)*8+(4*hi+((lane&15)>>2))*64;
  const int NT=NTF-t0;
  DMA_K(0,0);DMA_V(0,0);DMA_K(1,SLOTB);
  typedef __attribute__((address_space(3))) float* lds_fptr; typedef float f32x4_t __attribute__((ext_vector_type(4)));
  const lds_fptr kbL=(lds_fptr)(shm3+LDS_KBIAS);
  { const float*kbsrc=KBg+(long)(b*NHEAD+h)*SEQ+64*t0; int i0_=4*tid; asm volatile("":"+v"(i0_));   for(int i=i0_;i<64*NT;i+=4*NW*64) *(__attribute__((address_space(3))) f32x4_t*)(kbL+i)=*(const f32x4_t*)(kbsrc+i); }
  #define KBLOAD(P0,P1,t) do{ int h4_=4*hi; asm volatile("":"+v"(h4_));   const lds_fptr kq_=kbL+64*(t)+h4_; _Pragma("unroll") for(int i_=0;i_<4;++i_){ const f32x4_t a_=*(const __attribute__((address_space(3))) f32x4_t*)(kq_+8*i_); const f32x4_t b_=*(const __attribute__((address_space(3))) f32x4_t*)(kq_+32+8*i_); \
      P0[4*i_]=a_[0];P0[4*i_+1]=a_[1];P0[4*i_+2]=a_[2];P0[4*i_+3]=a_[3]; P1[4*i_]=b_[0];P1[4*i_+1]=b_[1];P1[4*i_+2]=b_[2];P1[4*i_+3]=b_[3]; } }while(0)
  bf16x8 qr[4];
  #pragma unroll
  for(int d0=0;d0<4;++d0)qr[d0]=*reinterpret_cast<const bf16x8*>(&Qw[(long)r32*DM+d0*16+hi*8]);
  float mhat=0.f,l_reg=0.f;f32x16 o[2];o[0]=f32x16{};o[1]=f32x16{};
  const int qrel=wid*QBLK+r32;
  #define CMASK(P0,P1,t) do{int jb_=(t)-(NT-4); if(jb_>=0)cmask(P0,P1,jb_,qrel,hi);}while(0)
  bool resc=false;
  #define START(P0,P1) do{ const float rm=rowmax(P0,P1); resc=false; \
    { const float dl=rm; mhat=fadd_s(mhat,dl); \
      _Pragma("unroll") for(int r=0;r<16;++r){P0[r]=fsub_s(P0[r],dl);P1[r]=fsub_s(P1[r],dl);} } \
    _Pragma("unroll") for(int r=0;r<16;++r)P0[r]=__builtin_amdgcn_exp2f(P0[r]); }while(0)
  #define RESC() do{ if(resc){ asm volatile("s_waitcnt lgkmcnt(0)":::"memory"); \
      _Pragma("unroll") for(int d_=0;d_<2;++d_) _Pragma("unroll") for(int r=0;r<16;++r)o[d_][r]*=wsf[crow(r,hi)]; } }while(0)
  f32x16 pA0,pA1,pB0,pB1;
  int sl_prev=0,sl_cur=0,sl_next=SLOTB;
  #define ROT() do{sl_prev=sl_cur;sl_cur=sl_next;sl_next=(sl_next==(NSLOT-1)*SLOTB)?0:sl_next+SLOTB;}while(0)
  DMA_K(2,2*SLOTB);
  WAIT_BAR(3);
  KBLOAD(pA0,pA1,0);
  qkt(pA0,pA1,Kbase,qr,r32,hi);asm volatile("s_nop 15\n\ts_nop 7":"+v"(pA0),"+v"(pA1));CMASK(pA0,pA1,0);
  START(pA0,pA1);
  KBLOAD(pB0,pB1,1);
  _Pragma("unroll") for(int r=0;r<16;++r){pB0[r]-=mhat;pB1[r]-=mhat;}
  _Pragma("unroll") for(int r=0;r<16;++r)pA1[r]=__builtin_amdgcn_exp2f(pA1[r]);
  WAIT_BAR(0);
  DMA_K(3,0);DMA_V(1,SLOTB);
  ROT();
  kload8(kf,kp0+sl_cur);
  WAIT_BAR(2);
  s16x4 vlo[8],vhi[8]; u32x4 pw0,pw1,pw2,pw3;
  #define PKW(P,B) cvtpk_s(P[B],P[B+1])
  #define PAF(k) __builtin_bit_cast(bf16x8,pw##k)
  #define VFR(i) (bf16x8){vlo[i][0],vlo[i][1],vlo[i][2],vlo[i][3],vhi[i][0],vhi[i][1],vhi[i][2],vhi[i][3]}
  #define PIN(x) asm volatile("":"+v"(x))
  #define MX3(a,b,c) __builtin_fmaxf(__builtin_fmaxf((a),(b)),(c))
  #define GAPA(MF,A0,A1,A2,A3,W0,W1,PW) do{ MF; sacc+=A0; sacc+=A1; sacc+=A2; sacc+=A3; PIN(sacc); W0; W1; PIN(PW); SBAR(); }while(0)
  #define EX(v) __builtin_amdgcn_exp2f(v)
  #define GAPB(MF,X,B) do{ MF; X[B]=EX(X[B]); X[B+1]=EX(X[B+1]); X[B+2]=EX(X[B+2]); X[B+3]=EX(X[B+3]); PIN(X); SBAR(); }while(0)
  #define VRD(i) do{ vlo[i]=vtr(vp_+(((i)>>2)*4096+((i)&3)*1024)); vhi[i]=vtr(vp_+(((i)>>2)*4096+((i)&3)*1024+512)); }while(0)
  #define KRD(G,j) do{ if(G){ kload2(kf,kp0+sl_next,j); SBAR(); } }while(0)
  #define NB(G,Y,B) do{ if(G){ Y[B]-=mhat; Y[B+1]-=mhat; Y[B+2]-=mhat; Y[B+3]-=mhat; PIN(Y); SBAR(); } }while(0)
  #define STEP(C0,C1,P0,P1,t,GK,GV,GL,GN) do{ SBAR(); \
    const lds_cptr vp_=vp0+sl_prev; \
    VRD(0); SBAR(); float sacc=(P0[0]+P0[1]); \
    GAPA(C0=__builtin_amdgcn_mfma_f32_32x32x16_bf16(kf[0],qr[0],C0,0,0,0), P0[2],P0[3],P0[4],P0[5],     pw0[0]=PKW(P0,0), pw0[1]=PKW(P0,2), pw0); \
    VRD(4); SBAR(); GAPA(C1=__builtin_amdgcn_mfma_f32_32x32x16_bf16(kf[1],qr[0],C1,0,0,0), P0[6],P0[7],P0[8],P0[9],     pw0[2]=PKW(P0,4), pw0[3]=PKW(P0,6), pw0); \
    VRD(1); SBAR(); GAPA(C0=__builtin_amdgcn_mfma_f32_32x32x16_bf16(kf[2],qr[1],C0,0,0,0),   P0[10],P0[11],P0[12],P0[13], pw1[0]=PKW(P0,8), pw1[1]=PKW(P0,10), pw1); \
    VRD(5); SBAR(); GAPA(C1=__builtin_amdgcn_mfma_f32_32x32x16_bf16(kf[3],qr[1],C1,0,0,0),   P0[14],P0[15],P1[0],P1[1],   pw1[2]=PKW(P0,12),pw1[3]=PKW(P0,14), pw1); \
    VRD(2); SBAR(); GAPA(C0=__builtin_amdgcn_mfma_f32_32x32x16_bf16(kf[4],qr[2],C0,0,0,0),   P1[2],P1[3],P1[4],P1[5],     pw2[0]=PKW(P1,0), pw2[1]=PKW(P1,2), pw2); \
    VRD(6); SBAR(); GAPA(C1=__builtin_amdgcn_mfma_f32_32x32x16_bf16(kf[5],qr[2],C1,0,0,0),   P1[6],P1[7],P1[8],P1[9],     pw2[2]=PKW(P1,4), pw2[3]=PKW(P1,6), pw2); \
    VRD(3); SBAR(); GAPA(C0=__builtin_amdgcn_mfma_f32_32x32x16_bf16(kf[6],qr[3],C0,0,0,0),   P1[10],P1[11],P1[12],P1[13], pw3[0]=PKW(P1,8), pw3[1]=PKW(P1,10), pw3); \
    VRD(7); SBAR(); GAPA(C1=__builtin_amdgcn_mfma_f32_32x32x16_bf16(kf[7],qr[3],C1,0,0,0),   P1[14],P1[15],0.f,0.f,       pw3[2]=PKW(P1,12),pw3[3]=PKW(P1,14), pw3); \
    l_reg+=sacc; \
    if(GK){DMA_K((t)+3,sl_cur);} if(GV){DMA_V((t)+1,sl_next);} \
    CMASK(C0,C1,t); \
    { float a=MX3(C0[0],C0[1],C1[0]),b=MX3(C0[2],C0[3],C1[1]); a=MX3(a,C1[2],C1[3]); \
      _Pragma("unroll") for(int r=4;r<16;r+=4){a=MX3(a,C0[r],C0[r+1]);b=MX3(b,C0[r+2],C0[r+3]);a=MX3(a,C1[r],C1[r+1]);b=MX3(b,C1[r+2],C1[r+3]);} \
      float rm=__builtin_fmaxf(a,b); { auto rr=__builtin_amdgcn_permlane32_swap(__float_as_uint(rm),__float_as_uint(rm),false,false); rm=__builtin_fmaxf(__uint_as_float(rr[0]),__uint_as_float(rr[1])); } \
      resc=false; \
      if(__builtin_expect(__any(rm>(float)THRL),0)){ const float dl=__builtin_fmaxf(rm,0.f); mhat+=dl; \
        _Pragma("unroll") for(int r=0;r<16;++r){C0[r]-=dl;C1[r]-=dl;} \
        const float f=__builtin_amdgcn_exp2f(-dl); l_reg*=f; if(hi==0)wsf[r32]=f; resc=true; } } \
    if(GN){ KBLOAD(P0,P1,(t)+1); } \
    SBAR(); \
    GAPB(o[0]=__builtin_amdgcn_mfma_f32_32x32x16_bf16(PAF(0),VFR(0),o[0],0,0,0), C0,0); NB(GN,P0,0); \
    GAPB(o[1]=__builtin_amdgcn_mfma_f32_32x32x16_bf16(PAF(0),VFR(4),o[1],0,0,0), C0,4); NB(GN,P0,4); \
    KRD(GL,0); GAPB(o[0]=__builtin_amdgcn_mfma_f32_32x32x16_bf16(PAF(1),VFR(1),o[0],0,0,0), C0,8); NB(GN,P0,8); \
    KRD(GL,1); GAPB(o[1]=__builtin_amdgcn_mfma_f32_32x32x16_bf16(PAF(1),VFR(5),o[1],0,0,0), C0,12); NB(GN,P0,12); \
    KRD(GL,2); GAPB(o[0]=__builtin_amdgcn_mfma_f32_32x32x16_bf16(PAF(2),VFR(2),o[0],0,0,0), C1,0); NB(GN,P1,0); \
    KRD(GL,3); GAPB(o[1]=__builtin_amdgcn_mfma_f32_32x32x16_bf16(PAF(2),VFR(6),o[1],0,0,0), C1,4); NB(GN,P1,4); \
    GAPB(o[0]=__builtin_amdgcn_mfma_f32_32x32x16_bf16(PAF(3),VFR(3),o[0],0,0,0), C1,8); NB(GN,P1,8); \
    GAPB(o[1]=__builtin_amdgcn_mfma_f32_32x32x16_bf16(PAF(3),VFR(7),o[1],0,0,0), C1,12); NB(GN,P1,12); \
    }while(0)
  int t=1;
  #undef CMASK
  #define CMASK(P0,P1,t) do{}while(0)
  for(;t+5<NT;t+=2){
    STEP(pB0,pB1,pA0,pA1,t,true,true,true,true);     WAIT_BAR(2); RESC(); ROT();
    STEP(pA0,pA1,pB0,pB1,t+1,true,true,true,true);   WAIT_BAR(2); RESC(); ROT();
  }
  #undef CMASK
  #define CMASK(P0,P1,t) do{int jb_=(t)-(NT-4); if(jb_>=0)cmask(P0,P1,jb_,qrel,hi);}while(0)
  #define ENDW(tt) do{ if((tt)+3<NT){WAIT_BAR(2);} else if((tt)+2<NT){WAIT_BAR(1);} else {WAIT_BAR(0);} }while(0)
  for(;t+1<NT;t+=2){
    STEP(pB0,pB1,pA0,pA1,t,(t+3<NT),(t+1<NT),(t+1<NT),(t+1<NT));       ENDW(t);   RESC(); ROT();
    STEP(pA0,pA1,pB0,pB1,t+1,(t+4<NT),(t+2<NT),(t+2<NT),(t+2<NT));     ENDW(t+1); RESC(); ROT();
  }
  STEP(pB0,pB1,pA0,pA1,NT-1,false,false,false,false); RESC();
  { float sacc=pB0[0]+pB0[1]; _Pragma("unroll") for(int r=2;r<16;++r)sacc+=pB0[r]; _Pragma("unroll") for(int r=0;r<16;++r)sacc+=pB1[r]; l_reg+=sacc;
    pw0=(u32x4){PKW(pB0,0),PKW(pB0,2),PKW(pB0,4),PKW(pB0,6)};pw1=(u32x4){PKW(pB0,8),PKW(pB0,10),PKW(pB0,12),PKW(pB0,14)};pw2=(u32x4){PKW(pB1,0),PKW(pB1,2),PKW(pB1,4),PKW(pB1,6)};pw3=(u32x4){PKW(pB1,8),PKW(pB1,10),PKW(pB1,12),PKW(pB1,14)};
    SBAR(); pv(o,vb0+sl_cur,PAF(0),PAF(1),PAF(2),PAF(3)); }
  #undef PKW
  #undef PAF
  #undef VFR
  #undef PIN
  #undef MX3
  #undef GAPA
  #undef GAPB
  #undef EX
  #undef VRD
  #undef KRD
  #undef NB
  #undef KBLOAD
  #undef STEP
  #undef ENDW
  {auto rr=__builtin_amdgcn_permlane32_swap(__float_as_uint(l_reg),__float_as_uint(l_reg),false,false);l_reg=__uint_as_float(rr[0])+__uint_as_float(rr[1]);}
  if(hi==0)wsf[32+r32]=l_reg;asm volatile("s_waitcnt lgkmcnt(0)":::"memory");
  float rli[16];
  #pragma unroll
  for(int r=0;r<16;++r)rli[r]=__builtin_amdgcn_rcpf(wsf[32+crow(r,hi)]);
  bf16*Ow=O+(rowbase+q0+wid*QBLK)*DM+h*D;
  { bf16*stg=(bf16*)(shm+LDS_OST)+wid*2048;
    #pragma unroll
    for(int r=0;r<16;++r){const int orow=crow(r,hi);
      #pragma unroll
      for(int d0=0;d0<2;++d0)stg[orow*64+d0*32+r32]=__float2bfloat16(o[d0][r]*rli[r]);}
    asm volatile("s_waitcnt lgkmcnt(0)":::"memory");
    #pragma unroll
    for(int i=0;i<4;++i){const int row=i*8+(lane>>3),ch=lane&7; const u32x4 v=*(const u32x4*)(stg+row*64+ch*8); ATTN_STORE16(Ow+(long)row*DM+ch*8,v);} }
  asm volatile("s_waitcnt lgkmcnt(0)\n\ts_barrier":::"memory");
  #undef DMA_K
  #undef DMA_V
  #undef CMASK
  #undef START
  #undef RESC
  #undef ROT
}
constexpr int ATTN_LDS_BYTES=LDS_BYTES;
struct AttnTensors { const bf16* Q; const bf16* K; const bf16* V; bf16* O; const float* KB; const float* qg; const float* kg; };
struct AttnUnit { int bh; int qb; };
struct StaticOrder {
  int vcu;
  __device__ __forceinline__ explicit StaticOrder(int grid,int block):vcu((block%8)*(grid/8)+block/8){}
  __device__ __forceinline__ bool next(int i,AttnUnit&u)const{ if(i>=4)return false; const int s=vcu&3; u.bh=vcu>>2; u.qb=(i==0)?s:(i==1)?7-s:(i==2)?8+s:15-s; return true; }
  __device__ __forceinline__ void a_ready(const AttnUnit&)const{}
  __device__ __forceinline__ void done(const AttnUnit&)const{}
};
__device__ __forceinline__ int attn_ticket(unsigned*ctr,unsigned myx){
  for(unsigned k=0;k<8;++k){ const unsigned q=(myx+k)&7u; const unsigned m=atomicAdd(ctr+64*q,1u); if(m<128u) return (int)(q*128u+m); }
  return -1;
}
template<class Sched,int THRL=60> __device__ __forceinline__ void attn_phase(char*lds,const AttnTensors&T,const Sched&S,unsigned*ctr,volatile __attribute__((address_space(3))) unsigned*slot,unsigned myx){
  float thr; { const int l=threadIdx.x&63; float a=fabsf(T.qg[l]),c=fabsf(T.kg[l]);
    for(int o=1;o<64;o<<=1){a=fmaxf(a,__shfl_xor(a,o));c=fmaxf(c,__shfl_xor(c,o));}
    thr=2.0f*(1.05f*a*c*64.0f*C2)+40.0f; }
  if(threadIdx.x==0) slot[0]=(unsigned)attn_ticket(ctr,myx);
  __syncthreads();
  int n=(int)slot[0];
  while(n>=0){
    int pre=-1; if(threadIdx.x==0) pre=attn_ticket(ctr,myx);
    const int m=n&127, bh=8*(n>>7)+(m&7);
    attn_unit<THRL>(bh/NHEAD,bh%NHEAD,(NQB-1)-(m>>3),T.Q,T.K,T.V,T.O,T.KB,thr,lds);
    if(threadIdx.x==0) slot[0]=(unsigned)pre;
    __syncthreads();
    n=(int)slot[0];
  }
}
#undef SBAR
#undef WAIT_BAR
}

constexpr int NWAVES = 8;
constexpr int BATCH = 4, SEQ = 4096, D = 1024, H = 16, HD = 64, FF = 4096;
constexpr int M = BATCH * SEQ;
constexpr int NQKV = 3 * D, WIN_LD = 3 * D + H;
constexpr int NG = 64, NP = 64, NC = 16, LCH = 16, NCHUNK = M / LCH  , KA = LCH * NC + 2 * NP  ;

constexpr size_t MiB = 1u << 20;
constexpr size_t WS_CTL = 0;
constexpr size_t WS_BAR = 256 * 1024;
constexpr size_t WS_LAMT = 3 * MiB;
constexpr size_t WS_LF = 1 * MiB, WS_KB = 2 * MiB;
constexpr size_t WS_WQKV = 4 * MiB, WS_WO = 10 * MiB, WS_W1A = 12 * MiB, WS_W2A = 20 * MiB, WS_W1B = 28 * MiB, WS_W2B = 36 * MiB, WS_WSSM = 44 * MiB, WS_WGLU = 46 * MiB;
constexpr size_t WS_BT3 = 50 * MiB, WS_WT1 = 62 * MiB;
constexpr size_t WS_XN = 70 * MiB;
constexpr size_t WS_QO = 102 * MiB, WS_K = 134 * MiB, WS_V = 166 * MiB;
constexpr size_t WS_O = 198 * MiB;
constexpr size_t WS_H = 102 * MiB;
constexpr size_t WS_AALL = 102 * MiB, WS_SBUF = 150 * MiB, WS_Z = 182 * MiB;
constexpr size_t WS_END = 230 * MiB;

constexpr int RING_OFF = 0, RING_BYTES = 131072;
constexpr int XCH_OFF = RING_BYTES;
constexpr int MISC_OFF = XCH_OFF + 8192;
constexpr int LDS_BYTES = 147456;

#define GAS __attribute__((address_space(1)))
#define LAS __attribute__((address_space(3)))
typedef unsigned short bf16;
typedef unsigned v4u __attribute__((ext_vector_type(4)));
typedef float f32x4 __attribute__((ext_vector_type(4)));
#define LDS_WAIT() asm volatile("s_waitcnt lgkmcnt(0)" ::: "memory")
__device__ __forceinline__ unsigned f2bf(float f) { unsigned u = __builtin_bit_cast(unsigned, f); return (u + 0x7fffu + ((u >> 16) & 1u)) >> 16; }
__device__ __forceinline__ unsigned pk2(float lo, float hi) { unsigned r; asm("v_cvt_pk_bf16_f32 %0, %1, %2" : "=v"(r) : "v"(lo), "v"(hi)); return r; }
__device__ __forceinline__ float wave_sum(float v) {
#pragma unroll
    for (int o = 1; o < 64; o <<= 1) v += __shfl_xor(v, o);
    return v;
}
__device__ __forceinline__ void sincos_d(double a, double& s, double& c) {
    const double k = rint(a * 0.63661977236758134308);
    double r = fma(-k, 1.57079632679489655800e+00, a); r = fma(-k, 6.12323399573676603587e-17, r);
    const int q = ((int)k) & 3;
    const double r2 = r * r;
    const double sp = r * (1.0 + r2 * (-1.0 / 6 + r2 * (1.0 / 120 + r2 * (-1.0 / 5040 + r2 * (1.0 / 362880 + r2 * (-1.0 / 39916800 + r2 * (1.0 / 6227020800.0)))))));
    const double cp = 1.0 + r2 * (-0.5 + r2 * (1.0 / 24 + r2 * (-1.0 / 720 + r2 * (1.0 / 40320 + r2 * (-1.0 / 3628800 + r2 * (1.0 / 479001600.0 + r2 * (-1.0 / 87178291200.0)))))));
    s = (q == 0) ? sp : (q == 1) ? cp : (q == 2) ? -sp : -cp;
    c = (q == 0) ? cp : (q == 1) ? -sp : (q == 2) ? -cp : sp;
}

#define XB_TMO      128
#define XB_XCNT(j)  (256  + 64 * (j))
#define XB_XSUB(j)  (1280 + 64 * (j))
#define XB_XGEN(j)  (2304 + 64 * (j))
#define XB_TOP      3328
#define XB_TOPGEN   3392
#define XCD_BAR_WORDS 3456
#define XB_SPIN_CAP (1u << 18)

__device__ __forceinline__ unsigned xb_ld(unsigned* p)              { return __hip_atomic_load(p, __ATOMIC_RELAXED, __HIP_MEMORY_SCOPE_AGENT); }
__device__ __forceinline__ unsigned xb_add(unsigned* p, unsigned v) { return __hip_atomic_fetch_add(p, v, __ATOMIC_RELAXED, __HIP_MEMORY_SCOPE_AGENT); }
__device__ __forceinline__ unsigned xb_xcc_id() { return (unsigned)__builtin_amdgcn_s_getreg((3 << 11) | 20) & 0xFu; }
#define XB_SPIN(cond, bar) do { unsigned _sp = 0; while (cond) { __builtin_amdgcn_s_sleep(1); \
    if ((++_sp & 255u) == 0u) { if (xb_ld(&(bar)[XB_TMO])) break; if (_sp > XB_SPIN_CAP) { atomicAdd(&(bar)[XB_TMO], 1u); break; } } } } while (0)

struct XcdBarrier {
    unsigned* bar; unsigned x;
    volatile LAS unsigned* st;
};

__device__ __forceinline__ XcdBarrier xcd_barrier_post(unsigned* bar, volatile LAS unsigned* st) {
    XcdBarrier b; b.bar = bar; b.x = xb_xcc_id(); b.st = st;
    if (threadIdx.x == 0) (void)xb_add(&bar[XB_XCNT(b.x)], 1u);
    return b;
}
__device__ __forceinline__ void xcd_barrier_complete(unsigned* bar, unsigned x, unsigned& nloc, unsigned& nx) {
    const unsigned G = gridDim.x * gridDim.y * gridDim.z;
    unsigned sum, cnt, mine, sp = 0u;
    for (;;) {
        sum = 0u; cnt = 0u; mine = 0u;
#pragma unroll
        for (unsigned j = 0; j < 16; ++j) { const unsigned c = xb_ld(&bar[XB_XCNT(j)]); sum += c; cnt += (c > 0u) ? 1u : 0u; mine = (j == x) ? c : mine; }
        if (sum == G) break;
        __builtin_amdgcn_s_sleep(1);
        if ((++sp & 255u) == 0u) { if (xb_ld(&bar[XB_TMO])) break; if (sp > XB_SPIN_CAP) { atomicAdd(&bar[XB_TMO], 1u); break; } }
    }
    nloc = mine > 0u ? mine : 1u; nx = cnt > 0u ? cnt : 1u;
}

__device__ __forceinline__ void xcd_barrier(const XcdBarrier& b) {
    asm volatile("s_waitcnt vmcnt(0)" ::: "memory");
    __syncthreads();
    if (threadIdx.x == 0) {
        unsigned* bar = b.bar;
        __builtin_amdgcn_s_waitcnt(0);
        unsigned nloc = b.st[0], nx = b.st[1];
        if (nloc == 0u) { xcd_barrier_complete(bar, b.x, nloc, nx); b.st[0] = nloc; b.st[1] = nx; }
        const unsigned old = xb_add(&bar[XB_XSUB(b.x)], 1u);
        const unsigned gen = old / nloc;
        if (old + 1u == (gen + 1u) * nloc) {
            __builtin_amdgcn_fence(__ATOMIC_RELEASE, "agent");
            asm volatile("s_waitcnt vmcnt(0)" ::: "memory");
            const unsigned og = xb_add(&bar[XB_TOP], 1u);
            const unsigned tg = og / nx;
            if (og + 1u == (tg + 1u) * nx) xb_add(&bar[XB_TOPGEN], 1u);
            else XB_SPIN(xb_ld(&bar[XB_TOPGEN]) == tg, bar);
            __builtin_amdgcn_fence(__ATOMIC_ACQUIRE, "agent");
            xb_add(&bar[XB_XGEN(b.x)], 1u);
            asm volatile("s_waitcnt vmcnt(0)" ::: "memory");
        } else {
            XB_SPIN(xb_ld(&bar[XB_XGEN(b.x)]) == gen, bar);
            __builtin_amdgcn_fence(__ATOMIC_ACQUIRE, "agent");
            asm volatile("s_waitcnt vmcnt(0)" ::: "memory");
        }
    }
    __syncthreads();
}

struct Args { const float* in[20]; float* out; unsigned char* ws; int ph_lo, ph_hi; };

typedef const __attribute__((address_space(4))) Args* KArgs;
__device__ __forceinline__ KArgs kargs() { KArgs p = (KArgs)__builtin_amdgcn_kernarg_segment_ptr(); asm volatile("" : "+s"(p)); return p; }
__device__ __forceinline__ void p0_transpose_item(const float* W, int ldw, int K, int ncols, bf16* WT, LAS float* scr, int item, int lane, const float* gk, int glu) {
    const int nblk = ncols / 32, kb = item / nblk, nb = item % nblk, k0 = 64 * kb, n0 = 32 * nb;
    int src0 = n0;
    if (glu == 1) src0 = ((n0 >> 7) & 1) * 1024 + 128 * (n0 >> 8) + (n0 & 127);
    if (glu == 2) src0 = (n0 & ~255) + 64 * ((n0 >> 5) & 3) + 32 * ((n0 >> 7) & 1);
#pragma unroll 8
    for (int i = 0; i < 32; ++i) { const int kk = 2 * i + (lane >> 5); const float g = gk ? gk[k0 + kk] : 1.0f; scr[kk * 33 + (lane & 31)] = __builtin_nontemporal_load(W + (size_t)(k0 + kk) * ldw + src0 + (lane & 31)) * g; }
    LDS_WAIT(); asm volatile("" ::: "memory");
    const int c = lane & 7;
#pragma unroll
    for (int j = 0; j < 4; ++j) { const int n = (lane >> 3) + 8 * j; const LAS float* s = scr + (8 * c) * 33 + n;
        v4u o; o.x = pk2(s[0 * 33], s[1 * 33]); o.y = pk2(s[2 * 33], s[3 * 33]); o.z = pk2(s[4 * 33], s[5 * 33]); o.w = pk2(s[6 * 33], s[7 * 33]);
        *(GAS v4u*)(WT + (size_t)(n0 + n) * K + k0 + 8 * c) = o; }
    LDS_WAIT(); asm volatile("" ::: "memory");
}

__device__ __forceinline__ void ssm_setup(LAS unsigned char* lds, int tid, unsigned* ctr, volatile LAS unsigned* slot) {
    KArgs a = kargs();
    const float* a_re = a->in[9]; const float* a_im = a->in[10]; const float* b_re = a->in[11]; const float* b_im = a->in[12];
    const float* c_re = a->in[13]; const float* c_im = a->in[14]; const float* log_dt = a->in[15];
    bf16* BT3 = (bf16*)(a->ws + WS_BT3); bf16* WT1 = (bf16*)(a->ws + WS_WT1);
    LAS float* lamp = (LAS float*)lds;
    LAS float* bbt = lamp + 17 * 64 * 2;
    LAS float* cct = bbt + 64 * 16 * 2;
    LAS float* Kt = cct + 16 * 64 * 2;
    for (;;) {
        if (tid == 0) slot[0] = atomicAdd(ctr, 1u);
        __syncthreads();
        const int w = (int)slot[0];
        if (w >= 4 * NG) break;
        const int g = w >> 2, q = w & 3;
        {
            LAS double* ld = (LAS double*)(Kt);
            if (tid < 64) { const int p = tid; const double dt = exp((double)log_dt[g]), are = (double)a_re[g * 64 + p], aim = (double)a_im[g * 64 + p];
                double sn, cs; sincos_d(dt * aim, sn, cs); const double mag = exp(dt * are); const double lr = mag * cs, li = mag * sn;
                const double nr = lr - 1.0, ni = li, den = are * are + aim * aim;
                ld[p * 4] = lr; ld[p * 4 + 1] = li; ld[p * 4 + 2] = (nr * are + ni * aim) / den; ld[p * 4 + 3] = (ni * are - nr * aim) / den;
                if (q == 0) { double pr = lr, pi = li; f32x4 o;
#pragma unroll 1
                    for (int sq = 0; sq < 9; ++sq) { if (sq == 4) { o.x = (float)pr; o.y = (float)pi; } const double t = pr * pr - pi * pi; pi = 2.0 * pr * pi; pr = t; }
                    o.z = (float)pr; o.w = (float)pi; *(f32x4*)((float*)(a->ws + WS_LAMT) + (size_t)(g * 64 + p) * 4) = o; } }
            __syncthreads();
#pragma unroll 1
            for (int idx = tid; idx < 17 * 64; idx += 512) { const int tau = idx >> 6, p = idx & 63; double br = ld[p * 4], bi = ld[p * 4 + 1], rr = 1.0, ri = 0.0;
#pragma unroll
                for (int bit = 0; bit < 5; ++bit) { if ((tau >> bit) & 1) { const double t = rr * br - ri * bi; ri = rr * bi + ri * br; rr = t; } const double t2 = br * br - bi * bi; bi = 2.0 * br * bi; br = t2; }
                lamp[idx * 2] = (float)rr; lamp[idx * 2 + 1] = (float)ri; }
#pragma unroll 1
            for (int idx = tid; idx < 64 * 16; idx += 512) { const int p = idx >> 4; const double sr = ld[p * 4 + 2], si = ld[p * 4 + 3];
                const double br = (double)b_re[g * 1024 + idx], bi = (double)b_im[g * 1024 + idx];
                bbt[idx * 2] = (float)(sr * br - si * bi); bbt[idx * 2 + 1] = (float)(sr * bi + si * br); }
        }
        for (int i = tid; i < 1024; i += 512) { cct[i * 2] = c_re[g * 1024 + i]; cct[i * 2 + 1] = c_im[g * 1024 + i]; }
        __syncthreads();
        {
            const int tau = tid >> 5, cp = (tid >> 1) & 15, c0 = (tid & 1) * 8; float sacc[8];
#pragma unroll
            for (int e = 0; e < 8; ++e) sacc[e] = 0.f;
#pragma unroll 2
            for (int p = 0; p < 64; ++p) { const float cr = cct[(cp * 64 + p) * 2], ci = cct[(cp * 64 + p) * 2 + 1], lr = lamp[(tau * 64 + p) * 2], li = lamp[(tau * 64 + p) * 2 + 1];
                const float dr = cr * lr - ci * li, di = cr * li + ci * lr;
                const LAS f32x4* bp = (const LAS f32x4*)(bbt + (p * 16 + c0) * 2);
#pragma unroll
                for (int e4 = 0; e4 < 4; ++e4) { const f32x4 b4 = bp[e4]; sacc[2 * e4] += dr * b4.x - di * b4.y; sacc[2 * e4 + 1] += dr * b4.z - di * b4.w; } }
#pragma unroll
            for (int e = 0; e < 8; ++e) Kt[tau * 256 + cp * 16 + c0 + e] = sacc[e] + ((tau == 0 && c0 + e == cp) ? a->in[16][16 * g + cp] : 0.f);
        }
        __syncthreads();
#pragma unroll 1
        for (int r = 0; r < 6; ++r) { const int pc = tid + 512 * r, rr = pc / 48, k8 = (pc % 48) * 8, n = 64 * q + rr, j = n >> 4, cp = n & 15; float v[8];
            if (k8 < 256) { const int s = k8 >> 4, c0 = k8 & 15;
#pragma unroll
                for (int e = 0; e < 8; ++e) v[e] = (j >= s) ? Kt[(j - s) * 256 + cp * 16 + c0 + e] : 0.f;
            } else { const int im = (k8 - 256) >> 6, p0 = (k8 - 256) & 63;
#pragma unroll
                for (int e = 0; e < 8; ++e) { const int p = p0 + e; const float cr = cct[(cp * 64 + p) * 2], ci = cct[(cp * 64 + p) * 2 + 1], lr = lamp[((j + 1) * 64 + p) * 2], li = lamp[((j + 1) * 64 + p) * 2 + 1];
                    v[e] = im ? -(cr * li + ci * lr) : (cr * lr - ci * li); } }
            v4u o; o.x = pk2(v[0], v[1]); o.y = pk2(v[2], v[3]); o.z = pk2(v[4], v[5]); o.w = pk2(v[6], v[7]);
            *(GAS v4u*)(BT3 + (size_t)(g * 256 + n) * KA + k8) = o; }
#pragma unroll 1
        for (int r = 0; r < 4; ++r) { const int pc = tid + 512 * r, rr = pc >> 5, k8 = (pc & 31) * 8, n = 64 * q + rr; float v[8];
            if (n < 128) { const int p = n & 63, im = n >> 6, s = k8 >> 4, c0 = k8 & 15; const float lr = lamp[((15 - s) * 64 + p) * 2], li = lamp[((15 - s) * 64 + p) * 2 + 1];
#pragma unroll
                for (int e = 0; e < 8; ++e) { const float br = bbt[(p * 16 + c0 + e) * 2], bi = bbt[(p * 16 + c0 + e) * 2 + 1]; v[e] = im ? (lr * bi + li * br) : (lr * br - li * bi); }
            } else {
#pragma unroll
                for (int e = 0; e < 8; ++e) v[e] = 0.f; }
            v4u o; o.x = pk2(v[0], v[1]); o.y = pk2(v[2], v[3]); o.z = pk2(v[4], v[5]); o.w = pk2(v[6], v[7]);
            *(GAS v4u*)(WT1 + (size_t)(g * 256 + n) * 256 + k8) = o; }
        __syncthreads();
    }
}

__device__ __forceinline__ void p0_prologue(LAS unsigned char* lds, int tid, int lane, int wave, int vcu, int G) {
    const int gw = vcu * NWAVES + wave, NGW = G * NWAVES;
    { KArgs a = kargs(); const float* nmix = a->in[1]; const float* nmlp = a->in[2]; const float* w_in = a->in[3]; unsigned char* ws = a->ws;
    LAS float* scr = (LAS float*)(lds + RING_OFF + wave * 16384);
    constexpr int I_QKV = (D / 64) * (NQKV / 32), I_O = (D / 64) * (D / 32), I_1 = (D / 64) * (FF / 32), I_2 = (FF / 64) * (D / 32), I_G = (D / 64) * (2 * D / 32);
    constexpr int NITEMS = I_QKV + I_O + 2 * I_1 + 2 * I_2 + I_O + I_G;
    for (int it = gw; it < NITEMS; it += NGW) {
        int r = it;
        if (r < I_1) { p0_transpose_item(a->in[18] + (size_t)D * FF, FF, D, FF, (bf16*)(ws + WS_W1B), scr, r, lane, nmlp + D, 0); continue; } r -= I_1;
        if (r < I_2) { p0_transpose_item(a->in[19] + (size_t)FF * D, D, FF, D, (bf16*)(ws + WS_W2B), scr, r, lane, nullptr, 0); continue; } r -= I_2;
        if (r < I_G) { p0_transpose_item(a->in[17], 2 * D, D, 2 * D, (bf16*)(ws + WS_WGLU), scr, r, lane, nullptr, 1); continue; } r -= I_G;
        if (r < I_O) { p0_transpose_item(a->in[8], D, D, D, (bf16*)(ws + WS_WSSM), scr, r, lane, nmix + D, 0); continue; } r -= I_O;
        if (r < I_2) { p0_transpose_item(a->in[19], D, FF, D, (bf16*)(ws + WS_W2A), scr, r, lane, nullptr, 0); continue; } r -= I_2;
        if (r < I_1) { p0_transpose_item(a->in[18], FF, D, FF, (bf16*)(ws + WS_W1A), scr, r, lane, nmlp, 0); continue; } r -= I_1;
        if (r < I_O) { p0_transpose_item(a->in[7], D, D, D, (bf16*)(ws + WS_WO), scr, r, lane, nullptr, 0); continue; } r -= I_O;
        p0_transpose_item(w_in, WIN_LD, D, NQKV, (bf16*)(ws + WS_WQKV), scr, r, lane, nullptr, 2);
    }
    }
    KArgs a = kargs(); const float* x = a->in[0]; const float* nmix = a->in[1]; const float* w_in = a->in[3]; const float* b_f = a->in[4]; unsigned char* ws = a->ws;
    { float* rs = (float*)(ws + WS_CTL); for (int i = blockIdx.x * 512 + tid; i < 3 * M; i += G * 512) rs[i] = 0.f; }
    __syncthreads();
    LAS float* wfT = (LAS float*)(lds + RING_OFF);
    for (int i = tid; i < D * H; i += 512) { const int k = i >> 4, h = i & 15; wfT[h * D + k] = w_in[(size_t)k * WIN_LD + NQKV + h]; }
    __syncthreads();
    bf16* XN = (bf16*)(ws + WS_XN); float* LF = (float*)(ws + WS_LF);
    for (int m = gw; m < M; m += NGW) {
        const GAS f32x4* xr = (const GAS f32x4*)(x + (size_t)m * D) + lane;
        f32x4 v[4]; float s = 0.f;
#pragma unroll
        for (int j = 0; j < 4; ++j) { v[j] = __builtin_nontemporal_load(xr + 64 * j); s += (v[j].x * v[j].x + v[j].y * v[j].y) + (v[j].z * v[j].z + v[j].w * v[j].w); }
        const float ssx = wave_sum(s); const float rs = 1.0f / sqrtf(ssx * (1.f / D) + 1e-6f);
        if (lane == 0) ((float*)(ws + WS_CTL))[3 * M + m] = ssx;
        GAS unsigned long long* o8 = (GAS unsigned long long*)(XN + (size_t)m * D) + lane;
#pragma unroll
        for (int j = 0; j < 4; ++j) { const f32x4 g4 = *(const f32x4*)(nmix + 256 * j + 4 * lane); v[j] = v[j] * rs * g4;
            o8[64 * j] = (unsigned long long)pk2(v[j].x, v[j].y) | ((unsigned long long)pk2(v[j].z, v[j].w) << 32); }
        float acc[16];
#pragma unroll
        for (int h = 0; h < 16; ++h) { float t = 0.f; if ((h & 3) == 0) asm volatile("" ::: "memory");
#pragma unroll
            for (int j = 0; j < 4; ++j) { const f32x4 w4 = *(const LAS f32x4*)(wfT + h * D + 256 * j + 4 * lane); t += (v[j].x * w4.x + v[j].y * w4.y) + (v[j].z * w4.z + v[j].w * w4.w); }
            acc[h] = t; }
#pragma unroll
        for (int i = 0; i < 8; ++i) { const bool hi = (lane & 32) != 0; const float send = hi ? acc[i] : acc[i + 8], keep = hi ? acc[i + 8] : acc[i]; acc[i] = keep + __shfl_xor(send, 32); }
#pragma unroll
        for (int i = 0; i < 4; ++i) { const bool hi = (lane & 16) != 0; const float send = hi ? acc[i] : acc[i + 4], keep = hi ? acc[i + 4] : acc[i]; acc[i] = keep + __shfl_xor(send, 16); }
#pragma unroll
        for (int i = 0; i < 2; ++i) { const bool hi = (lane & 8) != 0; const float send = hi ? acc[i] : acc[i + 2], keep = hi ? acc[i + 2] : acc[i]; acc[i] = keep + __shfl_xor(send, 8); }
        { const bool hi = (lane & 4) != 0; const float send = hi ? acc[0] : acc[1], keep = hi ? acc[1] : acc[0]; acc[0] = keep + __shfl_xor(send, 4); }
        float f = acc[0]; f += __shfl_xor(f, 2); f += __shfl_xor(f, 1);
        const int hh = lane >> 2;
        const float z = f + b_f[hh];
        const float lf = fminf(z, 0.f) - log1pf(expf(-fabsf(z)));
        if ((lane & 3) == 0) LF[(size_t)((m >> 12) * 16 + hh) * SEQ + (m & (SEQ - 1))] = lf;
    }
}

__device__ __forceinline__ void cumsum_phase(LAS unsigned char* lds, int tid, int lane, int wave) {
    KArgs a = kargs();
    const float* LF = (const float*)(a->ws + WS_LF); float* KB = (float*)(a->ws + WS_KB);
    LAS float* wsum = (LAS float*)(lds + MISC_OFF);
    for (int bh = blockIdx.x; bh < BATCH * H; bh += gridDim.x) {
        const float* src = LF + (size_t)bh * SEQ + 8 * tid;
        const f32x4 a0 = *(const f32x4*)src, a1 = *(const f32x4*)(src + 4);
        float p[8]; p[0] = a0.x; p[1] = p[0] + a0.y; p[2] = p[1] + a0.z; p[3] = p[2] + a0.w; p[4] = p[3] + a1.x; p[5] = p[4] + a1.y; p[6] = p[5] + a1.z; p[7] = p[6] + a1.w;
        float incl = p[7];
#pragma unroll
        for (int o = 1; o < 64; o <<= 1) { const float t = __shfl_up(incl, o); if (lane >= o) incl += t; }
        if (lane == 63) wsum[wave] = incl;
        __syncthreads();
        float off = incl - p[7];
        for (int w = 0; w < wave; ++w) off += wsum[w];
        f32x4 o0, o1;
        o0.x = -(p[0] + off) * 1.4426950408889634f; o0.y = -(p[1] + off) * 1.4426950408889634f; o0.z = -(p[2] + off) * 1.4426950408889634f; o0.w = -(p[3] + off) * 1.4426950408889634f;
        o1.x = -(p[4] + off) * 1.4426950408889634f; o1.y = -(p[5] + off) * 1.4426950408889634f; o1.z = -(p[6] + off) * 1.4426950408889634f; o1.w = -(p[7] + off) * 1.4426950408889634f;
        float* dst = KB + (size_t)bh * SEQ + 8 * tid;
        *(f32x4*)dst = o0; *(f32x4*)(dst + 4) = o1;
        __syncthreads();
    }
}

template <bool FROM_LDS> __device__ __forceinline__ void scan_phase(LAS unsigned char* lds, int lane, int wave, int vcu) {
    KArgs a = kargs();
    const float* SB = (const float*)(a->ws + WS_SBUF); bf16* AA = (bf16*)(a->ws + WS_AALL);
    LAS float* est = (LAS float*)(lds + (FROM_LDS ? 256 * pg8::SL_PITCH * 4 : RING_OFF));
    const LAS float* SL = (const LAS float*)(lds + RING_OFF);
    for (int w = vcu; w < NG * BATCH; w += gridDim.x) {
        const int g = w >> 2, b = w & 3, p = lane;
        const f32x4 lt = *(const f32x4*)((const float*)(a->ws + WS_LAMT) + (size_t)(g * 64 + p) * 4);
        const float l16r = lt.x, l16i = lt.y, l512r = lt.z, l512i = lt.w;
        const size_t row0 = (size_t)g * 1024 + b * 256 + 32 * wave;
        float sr[32], si[32];
#pragma unroll
        for (int i = 0; i < 32; ++i) { if (FROM_LDS) { sr[i] = SL[(32 * wave + i) * pg8::SL_PITCH + p]; si[i] = SL[(32 * wave + i) * pg8::SL_PITCH + 64 + p]; } else { sr[i] = SB[(row0 + i) * 128 + p]; si[i] = SB[(row0 + i) * 128 + 64 + p]; } }
        float xr = 0.f, xi = 0.f;
#pragma unroll
        for (int i = 0; i < 32; ++i) { const float nr = l16r * xr - l16i * xi + sr[i], ni = l16r * xi + l16i * xr + si[i]; xr = nr; xi = ni; sr[i] = xr; si[i] = xi; }
        est[(wave * 64 + p) * 2] = xr; est[(wave * 64 + p) * 2 + 1] = xi;
        __syncthreads();
        float pr = 0.f, pi = 0.f;
        for (int v = 0; v < wave; ++v) { const float er = est[(v * 64 + p) * 2], ei = est[(v * 64 + p) * 2 + 1]; const float nr = l512r * pr - l512i * pi + er, ni = l512r * pi + l512i * pr + ei; pr = nr; pi = ni; }
        float qr = 0.f, qi = 0.f;
#pragma unroll
        for (int i = 0; i < 32; ++i) { bf16* dst = AA + (row0 + i) * KA + 256 + p;
            dst[0] = (bf16)f2bf(qr + pr); dst[64] = (bf16)f2bf(qi + pi);
            qr = sr[i]; qi = si[i];
            const float nr = l16r * pr - l16i * pi, ni = l16r * pi + l16i * pr; pr = nr; pi = ni; }
        __syncthreads();
    }
}

__global__ void __launch_bounds__(NWAVES * 64, 2) fwd_megakernel(Args args) {
    extern __shared__ __attribute__((aligned(16))) unsigned char lds_raw[];
    cg::grid_group grid = cg::this_grid();
    LAS unsigned char* lds = (LAS unsigned char*)lds_raw;
    const int tid = threadIdx.x, lane = tid & 63, wave = __builtin_amdgcn_readfirstlane(tid >> 6);
    const int G = gridDim.x; const int bx = blockIdx.x; const int vcu = (G % 8 == 0) ? (bx % 8) * (G / 8) + bx / 8 : bx;
    const int lo = kargs()->ph_lo, hi = kargs()->ph_hi;
#define ws (kargs()->ws)
#define AIN(k) (kargs()->in[k])
#define AOUT (kargs()->out)
#ifndef ONLY
#define ONLY -1
#endif
#define IN(k) ((ONLY < 0 || ONLY == (k)) && lo <= (k) && (k) < hi)
#define WG_SEAM() do { asm volatile("s_waitcnt vmcnt(0) lgkmcnt(0)" ::: "memory"); __syncthreads(); if (wave == 0) { __builtin_amdgcn_fence(__ATOMIC_ACQUIRE, "agent"); asm volatile("s_waitcnt vmcnt(0)" ::: "memory"); } __syncthreads(); } while (0)
#define SEAM(k) do { if (IN(k) && IN((k) + 1)) { xcd_barrier(xbar); } } while (0)
#define rowss ((float*)(ws + WS_CTL))
#define XN ((bf16*)(ws + WS_XN))
#define HB ((bf16*)(ws + WS_H))

    if (tid < 32) ((LAS unsigned*)(lds + MISC_OFF))[tid] = 0u;
    if (bx == 0) { unsigned* bw = (unsigned*)(ws + WS_BAR); for (int i = tid; i < XCD_BAR_WORDS; i += NWAVES * 64) bw[i] = 0u; if (tid < 9) bw[4096 + 64 * tid] = 0u; }
    if (IN(0)) { p0_prologue(lds, tid, lane, wave, vcu, G); }
    __threadfence(); grid.sync();
    XcdBarrier xbar = xcd_barrier_post((unsigned*)(ws + WS_BAR), (volatile LAS unsigned*)(lds + MISC_OFF) + 8);
    if (IN(1)) cumsum_phase(lds, tid, lane, wave);
    if (IN(1)) {
        pg8::Gemm g{XN, (const bf16*)(ws + WS_WQKV), M, NQKV, D, D, D}; pg8::StaticOrder S; S.init(M, NQKV, G, bx);
        { LAS float* gl = (LAS float*)(lds + MISC_OFF + 1024); if (tid < 64) gl[tid] = AIN(5)[tid] * attn_body::C2; else if (tid < 128) gl[tid] = AIN(6)[tid - 64]; __syncthreads(); }
        pg8::EpiQKV E{(bf16*)(ws + WS_QO), (size_t)(WS_K - WS_QO) / 2, (PG8_LAS const float*)(lds + MISC_OFF + 1024)};
        pg8::gemm_phase(lds + RING_OFF, g, S, E);
    }
    SEAM(1);
    if (IN(2)) {
        const attn_body::AttnTensors AT{(const attn_body::bf16*)(ws + WS_QO), (const attn_body::bf16*)(ws + WS_K), (const attn_body::bf16*)(ws + WS_V), (attn_body::bf16*)(ws + WS_O), (const float*)(ws + WS_KB), AIN(5), AIN(6)};
        const attn_body::StaticOrder S(G, bx);
        attn_body::attn_phase<attn_body::StaticOrder>((char*)lds_raw + RING_OFF, AT, S, (unsigned*)(ws + WS_BAR) + 4096, (volatile LAS unsigned*)(lds + MISC_OFF) + 16, xbar.x);
        ssm_setup(lds, tid, (unsigned*)(ws + WS_BAR) + 4096 + 64 * 8, (volatile LAS unsigned*)(lds + MISC_OFF) + 18);
    }
    SEAM(2);
    if (IN(3)) {
        pg8::Gemm g{(const bf16*)(ws + WS_O), (const bf16*)(ws + WS_WO), M, D, D, D, D}; pg8::StaticOrder S; S.init(M, D, G, bx);
        pg8::EpiResid E{nullptr, XN, nullptr, XN, rowss, rowss + 3 * M, AIN(1), nullptr};
        pg8::gemm_phase(lds + RING_OFF, g, S, E);
    }
    SEAM(3);
    if (IN(4)) {
        pg8::Gemm g{XN, (const bf16*)(ws + WS_W1A), M, FF, D, D, D}; pg8::StaticOrder S; S.init(M, FF, G, bx);
        pg8::EpiSqrelu E{HB, FF};
        pg8::gemm_phase(lds + RING_OFF, g, S, E);
    }
    SEAM(4);
    if (IN(5)) {
        pg8::Gemm g{HB, (const bf16*)(ws + WS_W2A), M, D, FF, FF, FF}; pg8::StaticOrder S; S.init(M, D, G, bx);
        pg8::EpiResid E{nullptr, XN, nullptr, XN, rowss + M, nullptr, nullptr, rowss};
        pg8::gemm_phase(lds + RING_OFF, g, S, E);
    }
    SEAM(5);
    if (IN(6)) {
        pg8::Gemm g{XN, (const bf16*)(ws + WS_WSSM), M, D, D, D, D}; pg8::StaticOrder S; S.init(M, D, G, bx);
        pg8::EpiU E{(bf16*)(ws + WS_AALL), rowss + M};
        pg8::gemm_phase(lds + RING_OFF, g, S, E);
    }
    SEAM(6);
    if (G == NG * BATCH) {
        if (IN(7)) {
            pg8::Gemm g{(const bf16*)(ws + WS_AALL), (const bf16*)(ws + WS_WT1), NG * 1024, 256, 256, KA, 256}; pg8::BatchOrder S; S.init(NG * 4, G, vcu);
            pg8::EpiSLds E{(PG8_LAS float*)(lds + RING_OFF)};
            pg8::gemm_phase(lds + RING_OFF, g, S, E);
        }
        __syncthreads();
        if (IN(8)) scan_phase<true>(lds, lane, wave, vcu);
        WG_SEAM();
    } else {
        if (IN(7)) {
            pg8::Gemm g{(const bf16*)(ws + WS_AALL), (const bf16*)(ws + WS_WT1), NG * 1024, 256, 256, KA, 256}; pg8::BatchOrder S; S.init(NG * 4, G, vcu);
            pg8::EpiS E{(float*)(ws + WS_SBUF)};
            pg8::gemm_phase(lds + RING_OFF, g, S, E);
        }
        SEAM(7);
        if (IN(8)) scan_phase<false>(lds, lane, wave, vcu);
        SEAM(8);
    }
    if (IN(9)) {
        pg8::Gemm g{(const bf16*)(ws + WS_AALL), (const bf16*)(ws + WS_BT3), NG * 1024, 256, KA, KA, KA}; pg8::BatchOrder S; S.init(NG * 4, G, vcu);
        pg8::EpiY E{(bf16*)(ws + WS_Z)};
        pg8::gemm_phase(lds + RING_OFF, g, S, E);
    }
    SEAM(9);
    if (IN(10)) {
        pg8::Gemm g{(const bf16*)(ws + WS_Z), (const bf16*)(ws + WS_WGLU), M, 2 * D, D, D, D}; pg8::StaticOrder S; S.init(M, 2 * D, G, bx);
        pg8::EpiGlu E{XN, rowss + 2 * M};
        pg8::gemm_phase(lds + RING_OFF, g, S, E);
    }
    SEAM(10);
    if (IN(11)) {
        pg8::Gemm g{XN, (const bf16*)(ws + WS_W1B), M, FF, D, D, D}; pg8::StaticOrder S; S.init(M, FF, G, bx);
        pg8::EpiSqrelu E{HB, FF};
        pg8::gemm_phase(lds + RING_OFF, g, S, E);
    }
    SEAM(11);
    if (IN(12)) {
        pg8::Gemm g{HB, (const bf16*)(ws + WS_W2B), M, D, FF, FF, FF}; pg8::StaticOrder S; S.init(M, D, G, bx);
        pg8::EpiResid E{nullptr, XN, AOUT, nullptr, nullptr, nullptr, nullptr, rowss + 2 * M};
        pg8::gemm_phase(lds + RING_OFF, g, S, E);
    }
#undef IN
#undef SEAM
#undef ws
#undef AIN
#undef AOUT
#undef rowss
#undef XN
#undef HB
}

extern "C" void kernel_launch(void* const* d_in, const int* in_sizes, int n_in, void* d_out, int out_size, void* d_ws, size_t ws_size, hipStream_t stream) {
    static int grid = 0;
    if (grid == 0) {
        if (n_in != 20 || in_sizes[0] != M * D || out_size != M * D || ws_size < WS_END) { fprintf(stderr, "kernel_launch: unexpected shapes (n_in %d, in0 %d, out %d, ws %zu)\n", n_in, n_in > 0 ? in_sizes[0] : -1, out_size, ws_size); grid = -1; return; }
        int dev = 0, cus = 0, per_cu = 0;
        if (hipGetDevice(&dev) != hipSuccess || hipDeviceGetAttribute(&cus, hipDeviceAttributeMultiprocessorCount, dev) != hipSuccess) { grid = -1; return; }
        if (hipFuncSetAttribute((const void*)fwd_megakernel, hipFuncAttributeMaxDynamicSharedMemorySize, LDS_BYTES) != hipSuccess) { fprintf(stderr, "kernel_launch: hipFuncSetAttribute failed\n"); grid = -1; return; }
        if (hipOccupancyMaxActiveBlocksPerMultiprocessor(&per_cu, (const void*)fwd_megakernel, NWAVES * 64, LDS_BYTES) != hipSuccess || per_cu < 1) { fprintf(stderr, "kernel_launch: occupancy query reports %d workgroups per CU\n", per_cu); (void)hipGetLastError(); per_cu = 1; }
        grid = cus;
        if (grid != 256) fprintf(stderr, "kernel_launch: %d CUs; the attention unit order expects 256\n", grid);
    }
    if (grid < 0) return;
    Args a{};
    for (int i = 0; i < 20; ++i) a.in[i] = (const float*)d_in[i];
    a.out = (float*)d_out; a.ws = (unsigned char*)d_ws; a.ph_lo = 0; a.ph_hi = 13;
    void* params[] = {&a};
    const hipError_t le = hipLaunchCooperativeKernel((const void*)fwd_megakernel, dim3(grid), dim3(NWAVES * 64), params, LDS_BYTES, stream);
    if (le != hipSuccess) fprintf(stderr, "kernel_launch: cooperative launch failed: %s (grid %d)\n", hipGetErrorName(le), grid);
}
```

```cpp
#include <hip/hip_runtime.h>
#include <hip/hip_cooperative_groups.h>
#include <hip/hip_bf16.h>
#include <cstdio>
#include <cstdint>
#include <cmath>
namespace cg = cooperative_groups;

namespace pg8 {
#define PG8_LAS __attribute__((address_space(3)))
typedef unsigned short bf16_t;
typedef short bf16x8 __attribute__((ext_vector_type(8)));
typedef float f32x4 __attribute__((ext_vector_type(4)));
typedef unsigned u32x4 __attribute__((ext_vector_type(4)));
constexpr int BM = 256, BK = 64, HALF = 128, HTB = HALF * BK * 2  , STAGE_BYTES = 8 * HTB, NXCD = 8, WGM = 8;

__host__ __device__ __forceinline__ int lds_byte(int r, int c) { const int st = (r >> 4) * 2 + (c >> 5), rr = r & 15, cc = c & 31, ob = rr * 64 + cc * 2; return st * 1024 + (ob ^ (((ob >> 9) & 1) << 5)); }
__host__ __device__ __forceinline__ void stage_rc(int b, int& R, int& C) { const int st = b / 1024, sb = b % 1024, swz = sb ^ (((sb >> 9) & 1) << 5); R = (st >> 1) * 16 + swz / 64; C = (st & 1) * 32 + (swz % 64) / 2; }
__host__ __device__ __forceinline__ int perm32(int rho) { const int n = rho >> 4, i = rho & 15; return 8 * (i >> 2) + 4 * n + (i & 3); }

struct Unit { int pm, pn; };
struct Gemm { const bf16_t* A; const bf16_t* Bt; int M, N, K, lda, ldb; };

struct StaticOrder {
    int nM, nN, nwg, G, c;
    __host__ __device__ void init(int M, int N, int G_, int c_) { nM = M / BM; nN = N / BM; nwg = nM * nN; G = G_; c = c_; }
    __host__ __device__ bool next(int i, Unit& u) const {
        const long L = (long)i * G + c; if (L >= nwg) return false;
        int wgid = (int)L; { const int q = nwg / NXCD, r = nwg % NXCD, xcd = wgid % NXCD, off = wgid / NXCD; wgid = (xcd < r ? xcd * (q + 1) : r * (q + 1) + (xcd - r) * q) + off; }
        const int nig = WGM * nN, gid = wgid / nig, fm = gid * WGM, gsz = (nM - fm) < WGM ? (nM - fm) : WGM;
        u.pm = fm + ((wgid % nig) % gsz); u.pn = (wgid % nig) / gsz; return true;
    }
};
struct BatchOrder {
    int n, G, c;
    __host__ __device__ void init(int n_, int G_, int c_) { n = n_; G = G_; c = c_; }
    __host__ __device__ bool next(int i, Unit& u) const { const long L = (long)i * G + c; if (L >= n) return false; u.pm = (int)L; u.pn = (int)(L >> 2); return true; }
};

__device__ __forceinline__ unsigned cvt_pk_bf16(float lo, float hi) { unsigned r; asm volatile("v_cvt_pk_bf16_f32 %0, %1, %2" : "=v"(r) : "v"(lo), "v"(hi)); return r; }
__device__ __forceinline__ u32x4 pack8(const f32x4 v0, const f32x4 v1) { u32x4 w; w.x = cvt_pk_bf16(v0[0], v0[1]); w.y = cvt_pk_bf16(v0[2], v0[3]); w.z = cvt_pk_bf16(v1[0], v1[1]); w.w = cvt_pk_bf16(v1[2], v1[3]); return w; }
__device__ __forceinline__ float fq_sum(float s) {
    auto a = __builtin_amdgcn_permlane16_swap(__float_as_uint(s), __float_as_uint(s), false, false); s = __uint_as_float(a[0]) + __uint_as_float(a[1]);
    auto b = __builtin_amdgcn_permlane32_swap(__float_as_uint(s), __float_as_uint(s), false, false); return __uint_as_float(b[0]) + __uint_as_float(b[1]); }
__device__ __forceinline__ float bf2f(unsigned short h) { return __uint_as_float(((unsigned)h) << 16); }
__device__ __forceinline__ float sq4(const f32x4 x) { return (x[0] * x[0] + x[1] * x[1]) + (x[2] * x[2] + x[3] * x[3]); }
__device__ __forceinline__ float sigmoid_f(float x) { return __builtin_amdgcn_rcpf(1.0f + __builtin_amdgcn_exp2f(-1.4426950408889634f * x)); }
__device__ __forceinline__ float gelu_tanh_f(float y) { const float a = y * (1.0f + 0.044715f * y * y) * (2.0f * 0.7978845608028654f); return y * sigmoid_f(a); }
constexpr float RMS_EPS = 1e-6f;

struct EpiQKV {
    static constexpr bool PERM = true, AFTER_DRAIN = false;
    bf16_t* Q; size_t kv_stride; PG8_LAS const float* gl;
    __device__ __forceinline__ void operator()(const f32x4 (&acc)[2][2][4][2], const Unit& u, int wr, int wc, int fr, int fq) const {
        const int t = u.pn >> 2;
        bf16_t* base = Q + (size_t)t * kv_stride;
        int row0 = u.pm * BM + wr * 64 + fr, col0 = (u.pn & 3) * BM + wc * 64 + 8 * fq;
        asm volatile("" : "+v"(row0), "+v"(col0));
        f32x4 g[2][2];
#pragma unroll
        for (int bj = 0; bj < 2; ++bj)
#pragma unroll
            for (int n = 0; n < 2; ++n) g[bj][n] = (f32x4){1.f, 1.f, 1.f, 1.f};
        if (t < 2) { PG8_LAS const float* gs = gl + 64 * t + 8 * fq;
#pragma unroll
            for (int bj = 0; bj < 2; ++bj)
#pragma unroll
                for (int n = 0; n < 2; ++n) g[bj][n] = *(PG8_LAS const f32x4*)(gs + 32 * bj + 4 * n); }
#pragma unroll
        for (int ai = 0; ai < 2; ++ai)
#pragma unroll
            for (int m = 0; m < 4; ++m) { bf16_t* rowp = base + (size_t)(row0 + ai * HALF + m * 16) * 1024 + col0;
                float r = 1.f;
                if (t < 2) { float s = (sq4(acc[ai][0][m][0]) + sq4(acc[ai][0][m][1])) + (sq4(acc[ai][1][m][0]) + sq4(acc[ai][1][m][1]));
                    s = fq_sum(s); r = __builtin_amdgcn_rsqf(s * (1.0f / 64.0f) + RMS_EPS); }
#pragma unroll
                for (int bj = 0; bj < 2; ++bj) *(u32x4*)(rowp + bj * 32) = pack8(acc[ai][bj][m][0] * r * g[bj][0], acc[ai][bj][m][1] * r * g[bj][1]); }
    }
};

__device__ __forceinline__ void unpack8(const u32x4 w, f32x4& v0, f32x4& v1) {
    v0[0] = __uint_as_float(w.x << 16); v0[1] = __uint_as_float(w.x & 0xffff0000u); v0[2] = __uint_as_float(w.y << 16); v0[3] = __uint_as_float(w.y & 0xffff0000u);
    v1[0] = __uint_as_float(w.z << 16); v1[1] = __uint_as_float(w.z & 0xffff0000u); v1[2] = __uint_as_float(w.w << 16); v1[3] = __uint_as_float(w.w & 0xffff0000u); }
struct EpiResid {
    static constexpr bool PERM = true, AFTER_DRAIN = false;
    const float* basef; const bf16_t* baseb; float* out; bf16_t* xb; float* rowss; const float* unss; const float* ung; const float* accss;
    __device__ __forceinline__ void operator()(const f32x4 (&acc)[2][2][4][2], const Unit& u, int wr, int wc, int fr, int fq) const {
        const int row0 = u.pm * BM + wr * 64 + fr, col0 = u.pn * BM + wc * 32 + 8 * fq;
        f32x4 ginv[2][2];
#pragma unroll
        for (int bj = 0; bj < 2; ++bj)
#pragma unroll
            for (int n = 0; n < 2; ++n) { ginv[bj][n] = (f32x4){1.f, 1.f, 1.f, 1.f}; if (unss) { const f32x4 gg = *(const f32x4*)(ung + col0 + bj * HALF + 4 * n);
#pragma unroll
                for (int i = 0; i < 4; ++i) ginv[bj][n][i] = __builtin_amdgcn_rcpf(gg[i]); } }
#pragma unroll
        for (int ai = 0; ai < 2; ++ai)
#pragma unroll
            for (int m = 0; m < 4; ++m) { const int row = row0 + ai * HALF + m * 16; const size_t off = (size_t)row * 1024 + col0; float sq = 0.f;
                const float asc = accss ? __builtin_amdgcn_rcpf(accss[row] * (1.0f / 1024.0f) + RMS_EPS) : 1.0f;
#pragma unroll
                for (int bj = 0; bj < 2; ++bj) {
                    f32x4 b0, b1;
                    if (basef) { b0 = *(const f32x4*)(basef + off + bj * HALF); b1 = *(const f32x4*)(basef + off + bj * HALF + 4); }
                    else { unpack8(*(const u32x4*)(baseb + off + bj * HALF), b0, b1);
                        if (unss) { const float ri = __builtin_amdgcn_sqrtf(unss[row] * (1.0f / 1024.0f) + RMS_EPS); b0 = b0 * ri * ginv[bj][0]; b1 = b1 * ri * ginv[bj][1]; } }
                    const f32x4 v0 = acc[ai][bj][m][0] * asc + b0, v1 = acc[ai][bj][m][1] * asc + b1;
                    if (out) { __builtin_nontemporal_store(v0, (f32x4*)(out + off + bj * HALF)); __builtin_nontemporal_store(v1, (f32x4*)(out + off + bj * HALF + 4)); }
                    if (xb) *(u32x4*)(xb + off + bj * HALF) = pack8(v0, v1);
                    sq += sq4(v0) + sq4(v1); }
                if (rowss) { sq = fq_sum(sq); if (fq == 0) atomicAdd(rowss + row, sq); } }
    }
};
struct EpiGlu {
    static constexpr bool PERM = true, AFTER_DRAIN = false;
    bf16_t* xb; float* rowss;
    __device__ __forceinline__ void operator()(const f32x4 (&acc)[2][2][4][2], const Unit& u, int wr, int wc, int fr, int fq) const {
        const int row0 = u.pm * BM + wr * 64 + fr, col0 = u.pn * HALF + wc * 32 + 8 * fq;
#pragma unroll
        for (int ai = 0; ai < 2; ++ai)
#pragma unroll
            for (int m = 0; m < 4; ++m) { const int row = row0 + ai * HALF + m * 16; const size_t off = (size_t)row * 1024 + col0;
                f32x4 v[2]; unpack8(*(const u32x4*)(xb + off), v[0], v[1]);
#pragma unroll
                for (int n = 0; n < 2; ++n) { const f32x4 val = acc[ai][0][m][n], gt = acc[ai][1][m][n];
#pragma unroll
                    for (int i = 0; i < 4; ++i) v[n][i] += val[i] * sigmoid_f(gt[i]); }
                *(u32x4*)(xb + off) = pack8(v[0], v[1]);
                float sq = sq4(v[0]) + sq4(v[1]);
                sq = fq_sum(sq); if (fq == 0) atomicAdd(rowss + row, sq); }
    }
};
struct EpiSqrelu {
    static constexpr bool PERM = true, AFTER_DRAIN = false;
    bf16_t* O; int ldc;
    __device__ __forceinline__ void operator()(const f32x4 (&acc)[2][2][4][2], const Unit& u, int wr, int wc, int fr, int fq) const {
        const int row0 = u.pm * BM + wr * 64 + fr, col0 = u.pn * BM + wc * 32 + 8 * fq;
#pragma unroll
        for (int ai = 0; ai < 2; ++ai)
#pragma unroll
            for (int m = 0; m < 4; ++m) { const int row = row0 + ai * HALF + m * 16;
                bf16_t* rowp = O + (size_t)row * ldc + col0;
#pragma unroll
                for (int bj = 0; bj < 2; ++bj) { f32x4 v0 = acc[ai][bj][m][0], v1 = acc[ai][bj][m][1];
#pragma unroll
                    for (int i = 0; i < 4; ++i) { const float a = fmaxf(v0[i], 0.f), b = fmaxf(v1[i], 0.f); v0[i] = a * a; v1[i] = b * b; }
                    *(u32x4*)(rowp + bj * HALF) = pack8(v0, v1); } }
    }
};
struct EpiU {
    static constexpr bool PERM = true, AFTER_DRAIN = false;
    bf16_t* AA; const float* rowss;
    __device__ __forceinline__ void operator()(const f32x4 (&acc)[2][2][4][2], const Unit& u, int wr, int wc, int fr, int fq) const {
        const int row0 = u.pm * BM + wr * 64 + fr, col0 = u.pn * BM + wc * 32 + 8 * fq;
#pragma unroll
        for (int ai = 0; ai < 2; ++ai)
#pragma unroll
            for (int m = 0; m < 4; ++m) { const int row = row0 + ai * HALF + m * 16; const float rs = __builtin_amdgcn_rsqf(rowss[row] * (1.0f / 1024.0f) + RMS_EPS);
                const int kc = row >> 4, s = row & 15;
#pragma unroll
                for (int bj = 0; bj < 2; ++bj) { const int n = col0 + bj * HALF, g = n >> 4, c0 = n & 15;
                    *(u32x4*)(AA + ((size_t)(g * 1024 + kc) * 384 + s * 16 + c0)) = pack8(acc[ai][bj][m][0] * rs, acc[ai][bj][m][1] * rs); } }
    }
};
struct EpiS {
    static constexpr bool PERM = true, AFTER_DRAIN = false;
    float* S;
    __device__ __forceinline__ void operator()(const f32x4 (&acc)[2][2][4][2], const Unit& u, int wr, int wc, int fr, int fq) const {
        const int row0 = u.pm * BM + wr * 64 + fr, col0 = wc * 32 + 8 * fq;
#pragma unroll
        for (int ai = 0; ai < 2; ++ai)
#pragma unroll
            for (int m = 0; m < 4; ++m) { float* p = S + (size_t)(row0 + ai * HALF + m * 16) * 128 + col0;
                *(f32x4*)p = acc[ai][0][m][0]; *(f32x4*)(p + 4) = acc[ai][0][m][1]; }
    }
};
constexpr int SL_PITCH = 132;
struct EpiSLds {
    static constexpr bool PERM = true, AFTER_DRAIN = true;
    PG8_LAS float* SL;
    __device__ __forceinline__ void operator()(const f32x4 (&acc)[2][2][4][2], const Unit& u, int wr, int wc, int fr, int fq) const {
        const int row0 = wr * 64 + fr, col0 = wc * 32 + 8 * fq;
#pragma unroll
        for (int ai = 0; ai < 2; ++ai)
#pragma unroll
            for (int m = 0; m < 4; ++m) { PG8_LAS float* p = SL + (row0 + ai * HALF + m * 16) * SL_PITCH + col0;
                *(PG8_LAS f32x4*)p = acc[ai][0][m][0]; *(PG8_LAS f32x4*)(p + 4) = acc[ai][0][m][1]; }
    }
};
struct EpiY {
    static constexpr bool PERM = true, AFTER_DRAIN = false;
    bf16_t* Z;
    __device__ __forceinline__ void operator()(const f32x4 (&acc)[2][2][4][2], const Unit& u, int wr, int wc, int fr, int fq) const {
        int row0 = u.pm * BM + wr * 64 + fr, n0 = wc * 32 + 8 * fq; const int g = u.pn;
        asm volatile("" : "+v"(row0), "+v"(n0));
#pragma unroll
        for (int ai = 0; ai < 2; ++ai)
#pragma unroll
            for (int m = 0; m < 4; ++m) { const int row = row0 + ai * HALF + m * 16, kc = row & 1023;
#pragma unroll
                for (int bj = 0; bj < 2; ++bj) { const int n = n0 + bj * HALF, j = n >> 4, c0 = n & 15, ch = 16 * g + c0;
                    f32x4 v0 = acc[ai][bj][m][0], v1 = acc[ai][bj][m][1];
#pragma unroll
                    for (int i = 0; i < 4; ++i) { v0[i] = gelu_tanh_f(v0[i]); v1[i] = gelu_tanh_f(v1[i]); }
                    *(u32x4*)(Z + (size_t)(kc * 16 + j) * 1024 + ch) = pack8(v0, v1); } }
    }
};

template <class Epi, class Sched>
__device__ __forceinline__ void gemm_phase(PG8_LAS unsigned char* lds, const Gemm g, const Sched& S, const Epi& E) {
    int tid_ = threadIdx.x; asm volatile("" : "+v"(tid_));
    const int tid = tid_, wid = __builtin_amdgcn_readfirstlane(tid >> 6), lane = tid & 63, wr = wid >> 2, wc = wid & 3, fr = lane & 15, fq = lane >> 4;
    const int K = g.K, nt = K / BK;
    unsigned voffA[2], voffB[2];
#pragma unroll
    for (int i = 0; i < 2; ++i) { int R, C; stage_rc(tid * 16 + i * 8192, R, C); const int Rb = Epi::PERM ? ((R & ~31) + perm32(R & 31)) : R;
        voffA[i] = (unsigned)(R * g.lda + C) * 2u; voffB[i] = (unsigned)(Rb * g.ldb + C) * 2u; }
    const size_t kstep = (size_t)(BK * 2);
    const size_t hA = (size_t)HALF * g.lda * 2, hB = (size_t)HALF * g.ldb * 2;
    const size_t tA = 2 * hA, tB = 2 * hB;
    const unsigned ldsw = (unsigned)wid * 1024u;
    const int aoff = lds_byte(wr * 64 + fr, fq * 8), boff = lds_byte(wc * 32 + fr, fq * 8);
#define PG8_SA(b, h) (((b) * 2 + (h)) * HTB)
#define PG8_SB(b, h) ((4 + (b) * 2 + (h)) * HTB)
#define PG8_STAGE(bufoff, gbase, voff) do { _Pragma("unroll") for (int _i = 0; _i < 2; ++_i) \
        __builtin_amdgcn_global_load_lds((const unsigned*)((const char*)(gbase) + (voff)[_i]), (PG8_LAS unsigned*)(lds + (bufoff) + ldsw + _i * 8192), 16, 0, 0); } while (0)
#define PG8_LDA(dst, b, h) do { _Pragma("unroll") for (int m = 0; m < 4; ++m) _Pragma("unroll") for (int k = 0; k < 2; ++k) dst[m][k] = *(const PG8_LAS bf16x8*)(lds + PG8_SA(b, h) + aoff + m * 2048 + k * 1024); } while (0)
#define PG8_LDB(dst, b, h) do { _Pragma("unroll") for (int n = 0; n < 2; ++n) _Pragma("unroll") for (int k = 0; k < 2; ++k) dst[n][k] = *(const PG8_LAS bf16x8*)(lds + PG8_SB(b, h) + boff + n * 2048 + k * 1024); } while (0)
#define PG8_MMA(ai, bj, At, Bt) do { __builtin_amdgcn_s_setprio(1); _Pragma("unroll") for (int m = 0; m < 4; ++m) _Pragma("unroll") for (int n = 0; n < 2; ++n) _Pragma("unroll") for (int k = 0; k < 2; ++k) \
        acc[ai][bj][m][n] = __builtin_amdgcn_mfma_f32_16x16x32_bf16(Bt[n][k], At[m][k], acc[ai][bj][m][n], 0, 0, 0); __builtin_amdgcn_s_setprio(0); } while (0)
#define PG8_WAIT_V(n) asm volatile("s_waitcnt vmcnt(" #n ")" ::: "memory")
#define PG8_WAIT_L(n) asm volatile("s_waitcnt lgkmcnt(" #n ")" ::: "memory")
#define PG8_BAR __builtin_amdgcn_s_barrier()
#define PG8_SCHED __builtin_amdgcn_sched_barrier(0)
    Unit cur, nxt; int ui = 0;
    if (!S.next(0, cur)) return;
    f32x4 acc[2][2][4][2];
#pragma unroll
    for (int a = 0; a < 2; ++a)
#pragma unroll
        for (int b = 0; b < 2; ++b)
#pragma unroll
            for (int m = 0; m < 4; ++m)
#pragma unroll
                for (int n = 0; n < 2; ++n) acc[a][b][m][n] = (f32x4){0.f, 0.f, 0.f, 0.f};
    bf16x8 At[4][2], B0[2][2], B1[2][2];
    const char* cA = (const char*)g.A + (size_t)cur.pm * tA; const char* cB = (const char*)g.Bt + (size_t)cur.pn * tB;
    PG8_STAGE(PG8_SB(0, 0), cB, voffB); PG8_STAGE(PG8_SB(0, 1), cB + hB, voffB); PG8_STAGE(PG8_SA(0, 0), cA, voffA); PG8_STAGE(PG8_SA(0, 1), cA + hA, voffA);
    if (wr == 1) PG8_BAR;
    PG8_WAIT_V(2); PG8_BAR;
    PG8_STAGE(PG8_SB(1, 0), cB + kstep, voffB); PG8_STAGE(PG8_SA(1, 0), cA + kstep, voffA); PG8_STAGE(PG8_SB(1, 1), cB + hB + kstep, voffB);
    PG8_WAIT_V(6); PG8_BAR;
    for (;;) {
        const bool has_next = S.next(ui + 1, nxt);
        const char* nA = has_next ? (const char*)g.A + (size_t)nxt.pm * tA : cA; const char* nB = has_next ? (const char*)g.Bt + (size_t)nxt.pn * tB : cB;
        for (int t = 0; t < nt; t += 2) {
            const bool last = (t == nt - 2);
            const char* a1 = cA + (size_t)(t + 1) * kstep;
            const char* a2 = last ? nA : cA + (size_t)(t + 2) * kstep; const char* b2 = last ? nB : cB + (size_t)(t + 2) * kstep;
            const char* a3 = a2 + kstep; const char* b3 = b2 + kstep;
            PG8_LDB(B0, 0, 0); PG8_LDB(B1, 0, 1); PG8_SCHED; PG8_LDA(At, 0, 0); PG8_STAGE(PG8_SA(1, 1), a1 + hA, voffA);
            PG8_WAIT_V(8); PG8_WAIT_L(0); PG8_BAR; PG8_MMA(0, 0, At, B0); PG8_MMA(0, 1, At, B1); PG8_BAR; PG8_SCHED;
            PG8_LDA(At, 0, 1); PG8_STAGE(PG8_SB(0, 0), b2, voffB); PG8_STAGE(PG8_SB(0, 1), b2 + hB, voffB); PG8_STAGE(PG8_SA(0, 0), a2, voffA);
            PG8_WAIT_V(8); PG8_WAIT_L(0); PG8_BAR; PG8_MMA(1, 0, At, B0); PG8_MMA(1, 1, At, B1); PG8_BAR; PG8_SCHED;
            PG8_LDB(B0, 1, 0); PG8_LDB(B1, 1, 1); PG8_SCHED; PG8_LDA(At, 1, 0); PG8_STAGE(PG8_SA(0, 1), a2 + hA, voffA);
            PG8_WAIT_V(8); PG8_WAIT_L(0); PG8_BAR; PG8_MMA(0, 0, At, B0); PG8_MMA(0, 1, At, B1); PG8_BAR; PG8_SCHED;
            PG8_LDA(At, 1, 1); PG8_STAGE(PG8_SB(1, 0), b3, voffB); PG8_STAGE(PG8_SB(1, 1), b3 + hB, voffB); PG8_STAGE(PG8_SA(1, 0), a3, voffA);
            PG8_WAIT_V(8); PG8_WAIT_L(0); PG8_BAR; PG8_MMA(1, 0, At, B0); PG8_MMA(1, 1, At, B1); PG8_BAR; PG8_SCHED;
        }
        if (wr == 0) PG8_BAR;
        if constexpr (!Epi::AFTER_DRAIN) E(acc, cur, wr, wc, fr, fq);
        if (!has_next) break;
#pragma unroll
        for (int a = 0; a < 2; ++a)
#pragma unroll
            for (int b = 0; b < 2; ++b)
#pragma unroll
                for (int m = 0; m < 4; ++m)
#pragma unroll
                    for (int n = 0; n < 2; ++n) acc[a][b][m][n] = (f32x4){0.f, 0.f, 0.f, 0.f};
        cur = nxt; cA = nA; cB = nB; ++ui;
        if (wr == 1) PG8_BAR;
    }
    PG8_WAIT_V(0);
    PG8_BAR;
    if constexpr (Epi::AFTER_DRAIN) E(acc, cur, wr, wc, fr, fq);
#undef PG8_SA
#undef PG8_SB
#undef PG8_STAGE
#undef PG8_LDA
#undef PG8_LDB
#undef PG8_MMA
#undef PG8_WAIT_V
#undef PG8_WAIT_L
#undef PG8_BAR
#undef PG8_SCHED
}
}

#include <hip/hip_bf16.h>
#include <cmath>
namespace attn_body {
using bf16=__hip_bfloat16;
using bf16x8=__attribute__((ext_vector_type(8)))short;
using s16x4=__attribute__((ext_vector_type(4)))short;
using f32x16=__attribute__((ext_vector_type(16)))float;
using u32x4=__attribute__((ext_vector_type(4)))unsigned;
constexpr int BATCH=4,NHEAD=16,SEQ=4096,D=64,DM=NHEAD*D;
constexpr int NW=8,QBLK=32,QB=QBLK*NW,KVBLK=64,NQB=SEQ/QB;
constexpr int ATTN_PITCH=DM, ATTN_UNIT_ROWS=QB;
__device__ __forceinline__ int crow(int r,int hi){return (r&3)+8*(r>>2)+4*hi;}
#define SBAR() __builtin_amdgcn_sched_barrier(0)
__device__ __forceinline__ void cmask(f32x16&p0,f32x16&p1,int jb,int qrel,int hi){
  const float NEG=-INFINITY; int kb=64*jb+4*hi;
  #pragma unroll
  for(int r=0;r<16;++r){int kv=kb+(r&3)+8*(r>>2); if(kv>qrel)p0[r]=NEG; if(kv+32>qrel)p1[r]=NEG;}
}

constexpr int NSLOT=3, SLOTB=8192;
constexpr int LDS_K=0, LDS_V=NSLOT*SLOTB, LDS_WS=2*NSLOT*SLOTB, LDS_OST=LDS_WS+NW*64*4, LDS_KBIAS=LDS_OST+NW*4096, LDS_BYTES=LDS_KBIAS+(SEQ+64)*4;
constexpr float C2=0.125f*1.4426950408889634f;
__device__ __forceinline__ void glds16(const void*gsrc,unsigned lds_dst){unsigned keep;
  asm volatile("s_mov_b32 %0, m0\n\ts_mov_b32 m0, %2\n\ts_nop 0\n\tglobal_load_lds_dwordx4 %1, off\n\ts_mov_b32 m0, %0":"=&s"(keep):"v"(gsrc),"s"(lds_dst):"memory");}
__device__ __forceinline__ float max3f(float a,float b,float c){float r;asm("v_max3_f32 %0, %1, %2, %3":"=v"(r):"v"(a),"v"(b),"v"(c));return r;}
__device__ __forceinline__ float max2f(float a,float b){float r;asm("v_max_f32_e32 %0, %1, %2":"=v"(r):"v"(a),"v"(b));return r;}
__device__ __forceinline__ float fadd_s(float a,float b){float r;asm("v_add_f32_e32 %0, %1, %2":"=v"(r):"v"(a),"v"(b));return r;}
__device__ __forceinline__ float fsub_s(float a,float b){float r;asm("v_sub_f32_e32 %0, %1, %2":"=v"(r):"v"(a),"v"(b));return r;}
typedef float f32x2_t __attribute__((ext_vector_type(2))); typedef __bf16 bf16x2_t __attribute__((ext_vector_type(2)));
__device__ __forceinline__ unsigned cvtpk_s(float lo,float hi){f32x2_t v={lo,hi};bf16x2_t b=__builtin_convertvector(v,bf16x2_t);return __builtin_bit_cast(unsigned,b);}
#define WAIT_BAR(N) asm volatile("s_waitcnt vmcnt(" #N ") lgkmcnt(0)\n\ts_barrier":::"memory")

__device__ __forceinline__ void qkt(f32x16&p0,f32x16&p1,const char*Kslot,const bf16x8*qr,int r32,int hi){
  const char*kb=Kslot+hi*1024+r32*16;
  #pragma unroll
  for(int d0=0;d0<4;++d0){
    const bf16x8 b0=*reinterpret_cast<const bf16x8*>(kb+d0*2048);
    const bf16x8 b1=*reinterpret_cast<const bf16x8*>(kb+d0*2048+512);
    {p0=__builtin_amdgcn_mfma_f32_32x32x16_bf16(b0,qr[d0],p0,0,0,0);p1=__builtin_amdgcn_mfma_f32_32x32x16_bf16(b1,qr[d0],p1,0,0,0);}}
}
typedef __attribute__((address_space(3))) const char* lds_cptr;
typedef short v4i16_t __attribute__((ext_vector_type(4)));
__device__ __forceinline__ void kload8(bf16x8*kf,lds_cptr kp){
  kf[0]=*(const __attribute__((address_space(3))) bf16x8*)(kp);      kf[1]=*(const __attribute__((address_space(3))) bf16x8*)(kp+512);
  kf[2]=*(const __attribute__((address_space(3))) bf16x8*)(kp+2048); kf[3]=*(const __attribute__((address_space(3))) bf16x8*)(kp+2560);
  kf[4]=*(const __attribute__((address_space(3))) bf16x8*)(kp+4096); kf[5]=*(const __attribute__((address_space(3))) bf16x8*)(kp+4608);
  kf[6]=*(const __attribute__((address_space(3))) bf16x8*)(kp+6144); kf[7]=*(const __attribute__((address_space(3))) bf16x8*)(kp+6656);
}
__device__ __forceinline__ void kload2(bf16x8*kf,lds_cptr kp,int j){ kf[2*j]=*(const __attribute__((address_space(3))) bf16x8*)(kp+j*2048); kf[2*j+1]=*(const __attribute__((address_space(3))) bf16x8*)(kp+j*2048+512); }
__device__ __forceinline__ s16x4 vtr(lds_cptr p){ return __builtin_bit_cast(s16x4,__builtin_amdgcn_ds_read_tr16_b64_v4i16((__attribute__((address_space(3))) v4i16_t*)p)); }
__device__ __forceinline__ float rowmax(const f32x16&p0,const f32x16&p1){
  float a=max3f(p0[0],p0[1],p1[0]),b=max3f(p0[2],p0[3],p1[1]);a=max3f(a,p1[2],p1[3]);
  #pragma unroll
  for(int r=4;r<16;r+=4){a=max3f(a,p0[r],p0[r+1]);b=max3f(b,p0[r+2],p0[r+3]);a=max3f(a,p1[r],p1[r+1]);b=max3f(b,p1[r+2],p1[r+3]);}
  const float m=max2f(a,b);
  auto rr=__builtin_amdgcn_permlane32_swap(__float_as_uint(m),__float_as_uint(m),false,false);
  return max2f(__uint_as_float(rr[0]),__uint_as_float(rr[1]));
}
__device__ __forceinline__ void pv(f32x16*o,int vb,bf16x8 pa0,bf16x8 pa1,bf16x8 pa2,bf16x8 pa3){
  #pragma unroll
  for(int d0=0;d0<2;++d0){s16x4 lo[4],hi[4];
    #pragma unroll
    for(int ks=0;ks<4;++ks){
      asm volatile("ds_read_b64_tr_b16 %0,%1 offset:%c2":"=&v"(lo[ks]):"v"(vb),"i"(d0*4096+ks*1024):"memory");
      asm volatile("ds_read_b64_tr_b16 %0,%1 offset:%c2":"=&v"(hi[ks]):"v"(vb),"i"(d0*4096+ks*1024+512):"memory");}
    asm volatile("s_waitcnt lgkmcnt(0)":::"memory");SBAR();
    #define PK(k) (bf16x8){lo[k][0],lo[k][1],lo[k][2],lo[k][3],hi[k][0],hi[k][1],hi[k][2],hi[k][3]}
    o[d0]=__builtin_amdgcn_mfma_f32_32x32x16_bf16(pa0,PK(0),o[d0],0,0,0);
    o[d0]=__builtin_amdgcn_mfma_f32_32x32x16_bf16(pa1,PK(1),o[d0],0,0,0);
    o[d0]=__builtin_amdgcn_mfma_f32_32x32x16_bf16(pa2,PK(2),o[d0],0,0,0);
    o[d0]=__builtin_amdgcn_mfma_f32_32x32x16_bf16(pa3,PK(3),o[d0],0,0,0);
    #undef PK
  }
}

#ifndef ATTN_STORE16
#define ATTN_STORE16(p,v) (*(u32x4*)(p)=(v))
#endif
template<int THRL> __device__ __forceinline__ void attn_unit(int b,int h,int qb,const bf16*Q,const bf16*__restrict__ K,const bf16*__restrict__ V,bf16*O,const float*__restrict__ KBg,const float skip_thr,char*shm){
  int tid_=threadIdx.x; asm volatile("":"+v"(tid_)); const int tid=tid_,lane=tid&63,r32=lane&31,hi=lane>>5; const int wid=__builtin_amdgcn_readfirstlane(tid>>6);
  const long rowbase=(long)b*SEQ; const int q0=qb*QB;
  const bf16*Qw=Q+(rowbase+q0+wid*QBLK)*DM+h*D;
  const int NTF=(q0+QB)/KVBLK; int t0=0;
  { const float*kbg=KBg+(long)(b*NHEAD+h)*SEQ; const float kq=kbg[q0]; bool sk=false; if(lane<NTF-4) sk=(kq-kbg[64*lane+63])>skip_thr;
    const unsigned long long mk=__ballot(sk); t0=(mk==~0ull)?64:__builtin_ctzll(~mk); t0&=~1; if(t0>NTF-4)t0=NTF-4; t0=__builtin_amdgcn_readfirstlane(t0); }
  const bf16*Kh=K+(rowbase+(long)t0*KVBLK)*DM+h*D,*Vh=V+(rowbase+(long)t0*KVBLK)*DM+h*D;
  const lds_cptr shm3=(lds_cptr)shm;
  const unsigned lds0=(unsigned)(uintptr_t)shm;
  float*wsf=(float*)(shm+LDS_WS)+wid*64;
  const bf16*ksrc=Kh+(long)lane*DM+wid*8;
  const bf16*vsrc=Vh+(long)(16*(wid&3)+(lane>>2))*DM+(wid>>2)*32+(lane&3)*8;
  const unsigned kdst=lds0+LDS_K+wid*1024, vdst=lds0+LDS_V+wid*1024;
  #define DMA_K(t,slot) glds16(ksrc+(long)(t)*KVBLK*DM,(unsigned)__builtin_amdgcn_readfirstlane(kdst+(slot)))
  #define DMA_V(t,slot) glds16(vsrc+(long)(t)*KVBLK*DM,(unsigned)__builtin_amdgcn_readfirstlane(vdst+(slot)))
  const int vb0=(int)(lds0+LDS_V)+((lane>>4)&1)*32+(lane&3)*8+(4*hi+((lane&15)>>2))*64;
  const char*Kbase=shm+LDS_K; bf16x8 kf[8];
  const lds_cptr kp0=shm3+LDS_K+hi*1024+r32*16; const lds_cptr vp0=shm3+LDS_V+((lane>>4)&1)*32+(lane&3)*8+(4*hi+((lane&15)>>2))*64;
  const int NT=NTF-t0;
  DMA_K(0,0);DMA_V(0,0);DMA_K(1,SLOTB);
  typedef __attribute__((address_space(3))) float* lds_fptr; typedef float f32x4_t __attribute__((ext_vector_type(4)));
  const lds_fptr kbL=(lds_fptr)(shm3+LDS_KBIAS);
  { const float*kbsrc=KBg+(long)(b*NHEAD+h)*SEQ+64*t0; int i0_=4*tid; asm volatile("":"+v"(i0_));   for(int i=i0_;i<64*NT;i+=4*NW*64) *(__attribute__((address_space(3))) f32x4_t*)(kbL+i)=*(const f32x4_t*)(kbsrc+i); }
  #define KBLOAD(P0,P1,t) do{ int h4_=4*hi; asm volatile("":"+v"(h4_));   const lds_fptr kq_=kbL+64*(t)+h4_; _Pragma("unroll") for(int i_=0;i_<4;++i_){ const f32x4_t a_=*(const __attribute__((address_space(3))) f32x4_t*)(kq_+8*i_); const f32x4_t b_=*(const __attribute__((address_space(3))) f32x4_t*)(kq_+32+8*i_); \
      P0[4*i_]=a_[0];P0[4*i_+1]=a_[1];P0[4*i_+2]=a_[2];P0[4*i_+3]=a_[3]; P1[4*i_]=b_[0];P1[4*i_+1]=b_[1];P1[4*i_+2]=b_[2];P1[4*i_+3]=b_[3]; } }while(0)
  bf16x8 qr[4];
  #pragma unroll
  for(int d0=0;d0<4;++d0)qr[d0]=*reinterpret_cast<const bf16x8*>(&Qw[(long)r32*DM+d0*16+hi*8]);
  float mhat=0.f,l_reg=0.f;f32x16 o[2];o[0]=f32x16{};o[1]=f32x16{};
  const int qrel=wid*QBLK+r32;
  #define CMASK(P0,P1,t) do{int jb_=(t)-(NT-4); if(jb_>=0)cmask(P0,P1,jb_,qrel,hi);}while(0)
  bool resc=false;
  #define START(P0,P1) do{ const float rm=rowmax(P0,P1); resc=false; \
    { const float dl=rm; mhat=fadd_s(mhat,dl); \
      _Pragma("unroll") for(int r=0;r<16;++r){P0[r]=fsub_s(P0[r],dl);P1[r]=fsub_s(P1[r],dl);} } \
    _Pragma("unroll") for(int r=0;r<16;++r)P0[r]=__builtin_amdgcn_exp2f(P0[r]); }while(0)
  #define RESC() do{ if(resc){ asm volatile("s_waitcnt lgkmcnt(0)":::"memory"); \
      _Pragma("unroll") for(int d_=0;d_<2;++d_) _Pragma("unroll") for(int r=0;r<16;++r)o[d_][r]*=wsf[crow(r,hi)]; } }while(0)
  f32x16 pA0,pA1,pB0,pB1;
  int sl_prev=0,sl_cur=0,sl_next=SLOTB;
  #define ROT() do{sl_prev=sl_cur;sl_cur=sl_next;sl_next=(sl_next==(NSLOT-1)*SLOTB)?0:sl_next+SLOTB;}while(0)
  DMA_K(2,2*SLOTB);
  WAIT_BAR(3);
  KBLOAD(pA0,pA1,0);
  qkt(pA0,pA1,Kbase,qr,r32,hi);asm volatile("s_nop 15\n\ts_nop 7":"+v"(pA0),"+v"(pA1));CMASK(pA0,pA1,0);
  START(pA0,pA1);
  KBLOAD(pB0,pB1,1);
  _Pragma("unroll") for(int r=0;r<16;++r){pB0[r]-=mhat;pB1[r]-=mhat;}
  _Pragma("unroll") for(int r=0;r<16;++r)pA1[r]=__builtin_amdgcn_exp2f(pA1[r]);
  WAIT_BAR(0);
  DMA_K(3,0);DMA_V(1,SLOTB);
  ROT();
  kload8(kf,kp0+sl_cur);
  WAIT_BAR(2);
  s16x4 vlo[8],vhi[8]; u32x4 pw0,pw1,pw2,pw3;
  #define PKW(P,B) cvtpk_s(P[B],P[B+1])
  #define PAF(k) __builtin_bit_cast(bf16x8,pw##k)
  #define VFR(i) (bf16x8){vlo[i][0],vlo[i][1],vlo[i][2],vlo[i][3],vhi[i][0],vhi[i][1],vhi[i][2],vhi[i][3]}
  #define PIN(x) asm volatile("":"+v"(x))
  #define MX3(a,b,c) __builtin_fmaxf(__builtin_fmaxf((a),(b)),(c))
  #define GAPA(MF,A0,A1,A2,A3,W0,W1,PW) do{ MF; sacc+=A0; sacc+=A1; sacc+=A2; sacc+=A3; PIN(sacc); W0; W1; PIN(PW); SBAR(); }while(0)
  #define EX(v) __builtin_amdgcn_exp2f(v)
  #define GAPB(MF,X,B) do{ MF; X[B]=EX(X[B]); X[B+1]=EX(X[B+1]); X[B+2]=EX(X[B+2]); X[B+3]=EX(X[B+3]); PIN(X); SBAR(); }while(0)
  #define VRD(i) do{ vlo[i]=vtr(vp_+(((i)>>2)*4096+((i)&3)*1024)); vhi[i]=vtr(vp_+(((i)>>2)*4096+((i)&3)*1024+512)); }while(0)
  #define KRD(G,j) do{ if(G){ kload2(kf,kp0+sl_next,j); SBAR(); } }while(0)
  #define NB(G,Y,B) do{ if(G){ Y[B]-=mhat; Y[B+1]-=mhat; Y[B+2]-=mhat; Y[B+3]-=mhat; PIN(Y); SBAR(); } }while(0)
  #define STEP(C0,C1,P0,P1,t,GK,GV,GL,GN) do{ SBAR(); \
    const lds_cptr vp_=vp0+sl_prev; \
    VRD(0); SBAR(); float sacc=(P0[0]+P0[1]); \
    GAPA(C0=__builtin_amdgcn_mfma_f32_32x32x16_bf16(kf[0],qr[0],C0,0,0,0), P0[2],P0[3],P0[4],P0[5],     pw0[0]=PKW(P0,0), pw0[1]=PKW(P0,2), pw0); \
    VRD(4); SBAR(); GAPA(C1=__builtin_amdgcn_mfma_f32_32x32x16_bf16(kf[1],qr[0],C1,0,0,0), P0[6],P0[7],P0[8],P0[9],     pw0[2]=PKW(P0,4), pw0[3]=PKW(P0,6), pw0); \
    VRD(1); SBAR(); GAPA(C0=__builtin_amdgcn_mfma_f32_32x32x16_bf16(kf[2],qr[1],C0,0,0,0),   P0[10],P0[11],P0[12],P0[13], pw1[0]=PKW(P0,8), pw1[1]=PKW(P0,10), pw1); \
    VRD(5); SBAR(); GAPA(C1=__builtin_amdgcn_mfma_f32_32x32x16_bf16(kf[3],qr[1],C1,0,0,0),   P0[14],P0[15],P1[0],P1[1],   pw1[2]=PKW(P0,12),pw1[3]=PKW(P0,14), pw1); \
    VRD(2); SBAR(); GAPA(C0=__builtin_amdgcn_mfma_f32_32x32x16_bf16(kf[4],qr[2],C0,0,0,0),   P1[2],P1[3],P1[4],P1[5],     pw2[0]=PKW(P1,0), pw2[1]=PKW(P1,2), pw2); \
    VRD(6); SBAR(); GAPA(C1=__builtin_amdgcn_mfma_f32_32x32x16_bf16(kf[5],qr[2],C1,0,0,0),   P1[6],P1[7],P1[8],P1[9],     pw2[2]=PKW(P1,4), pw2[3]=PKW(P1,6), pw2); \
    VRD(3); SBAR(); GAPA(C0=__builtin_amdgcn_mfma_f32_32x32x16_bf16(kf[6],qr[3],C0,0,0,0),   P1[10],P1[11],P1[12],P1[13], pw3[0]=PKW(P1,8), pw3[1]=PKW(P1,10), pw3); \
    VRD(7); SBAR(); GAPA(C1=__builtin_amdgcn_mfma_f32_32x32x16_bf16(kf[7],qr[3],C1,0,0,0),   P1[14],P1[15],0.f,0.f,       pw3[2]=PKW(P1,12),pw3[3]=PKW(P1,14), pw3); \
    l_reg+=sacc; \
    if(GK){DMA_K((t)+3,sl_cur);} if(GV){DMA_V((t)+1,sl_next);} \
    CMASK(C0,C1,t); \
    { float a=MX3(C0[0],C0[1],C1[0]),b=MX3(C0[2],C0[3],C1[1]); a=MX3(a,C1[2],C1[3]); \
      _Pragma("unroll") for(int r=4;r<16;r+=4){a=MX3(a,C0[r],C0[r+1]);b=MX3(b,C0[r+2],C0[r+3]);a=MX3(a,C1[r],C1[r+1]);b=MX3(b,C1[r+2],C1[r+3]);} \
      float rm=__builtin_fmaxf(a,b); { auto rr=__builtin_amdgcn_permlane32_swap(__float_as_uint(rm),__float_as_uint(rm),false,false); rm=__builtin_fmaxf(__uint_as_float(rr[0]),__uint_as_float(rr[1])); } \
      resc=false; \
      if(__builtin_expect(__any(rm>(float)THRL),0)){ const float dl=__builtin_fmaxf(rm,0.f); mhat+=dl; \
        _Pragma("unroll") for(int r=0;r<16;++r){C0[r]-=dl;C1[r]-=dl;} \
        const float f=__builtin_amdgcn_exp2f(-dl); l_reg*=f; if(hi==0)wsf[r32]=f; resc=true; } } \
    if(GN){ KBLOAD(P0,P1,(t)+1); } \
    SBAR(); \
    GAPB(o[0]=__builtin_amdgcn_mfma_f32_32x32x16_bf16(PAF(0),VFR(0),o[0],0,0,0), C0,0); NB(GN,P0,0); \
    GAPB(o[1]=__builtin_amdgcn_mfma_f32_32x32x16_bf16(PAF(0),VFR(4),o[1],0,0,0), C0,4); NB(GN,P0,4); \
    KRD(GL,0); GAPB(o[0]=__builtin_amdgcn_mfma_f32_32x32x16_bf16(PAF(1),VFR(1),o[0],0,0,0), C0,8); NB(GN,P0,8); \
    KRD(GL,1); GAPB(o[1]=__builtin_amdgcn_mfma_f32_32x32x16_bf16(PAF(1),VFR(5),o[1],0,0,0), C0,12); NB(GN,P0,12); \
    KRD(GL,2); GAPB(o[0]=__builtin_amdgcn_mfma_f32_32x32x16_bf16(PAF(2),VFR(2),o[0],0,0,0), C1,0); NB(GN,P1,0); \
    KRD(GL,3); GAPB(o[1]=__builtin_amdgcn_mfma_f32_32x32x16_bf16(PAF(2),VFR(6),o[1],0,0,0), C1,4); NB(GN,P1,4); \
    GAPB(o[0]=__builtin_amdgcn_mfma_f32_32x32x16_bf16(PAF(3),VFR(3),o[0],0,0,0), C1,8); NB(GN,P1,8); \
    GAPB(o[1]=__builtin_amdgcn_mfma_f32_32x32x16_bf16(PAF(3),VFR(7),o[1],0,0,0), C1,12); NB(GN,P1,12); \
    }while(0)
  int t=1;
  #undef CMASK
  #define CMASK(P0,P1,t) do{}while(0)
  for(;t+5<NT;t+=2){
    STEP(pB0,pB1,pA0,pA1,t,true,true,true,true);     WAIT_BAR(2); RESC(); ROT();
    STEP(pA0,pA1,pB0,pB1,t+1,true,true,true,true);   WAIT_BAR(2); RESC(); ROT();
  }
  #undef CMASK
  #define CMASK(P0,P1,t) do{int jb_=(t)-(NT-4); if(jb_>=0)cmask(P0,P1,jb_,qrel,hi);}while(0)
  #define ENDW(tt) do{ if((tt)+3<NT){WAIT_BAR(2);} else if((tt)+2<NT){WAIT_BAR(1);} else {WAIT_BAR(0);} }while(0)
  for(;t+1<NT;t+=2){
    STEP(pB0,pB1,pA0,pA1,t,(t+3<NT),(t+1<NT),(t+1<NT),(t+1<NT));       ENDW(t);   RESC(); ROT();
    STEP(pA0,pA1,pB0,pB1,t+1,(t+4<NT),(t+2<NT),(t+2<NT),(t+2<NT));     ENDW(t+1); RESC(); ROT();
  }
  STEP(pB0,pB1,pA0,pA1,NT-1,false,false,false,false); RESC();
  { float sacc=pB0[0]+pB0[1]; _Pragma("unroll") for(int r=2;r<16;++r)sacc+=pB0[r]; _Pragma("unroll") for(int r=0;r<16;++r)sacc+=pB1[r]; l_reg+=sacc;
    pw0=(u32x4){PKW(pB0,0),PKW(pB0,2),PKW(pB0,4),PKW(pB0,6)};pw1=(u32x4){PKW(pB0,8),PKW(pB0,10),PKW(pB0,12),PKW(pB0,14)};pw2=(u32x4){PKW(pB1,0),PKW(pB1,2),PKW(pB1,4),PKW(pB1,6)};pw3=(u32x4){PKW(pB1,8),PKW(pB1,10),PKW(pB1,12),PKW(pB1,14)};
    SBAR(); pv(o,vb0+sl_cur,PAF(0),PAF(1),PAF(2),PAF(3)); }
  #undef PKW
  #undef PAF
  #undef VFR
  #undef PIN
  #undef MX3
  #undef GAPA
  #undef GAPB
  #undef EX
  #undef VRD
  #undef KRD
  #undef NB
  #undef KBLOAD
  #undef STEP
  #undef ENDW
  {auto rr=__builtin_amdgcn_permlane32_swap(__float_as_uint(l_reg),__float_as_uint(l_reg),false,false);l_reg=__uint_as_float(rr[0])+__uint_as_float(rr[1]);}
  if(hi==0)wsf[32+r32]=l_reg;asm volatile("s_waitcnt lgkmcnt(0)":::"memory");
  float rli[16];
  #pragma unroll
  for(int r=0;r<16;++r)rli[r]=__builtin_amdgcn_rcpf(wsf[32+crow(r,hi)]);
  bf16*Ow=O+(rowbase+q0+wid*QBLK)*DM+h*D;
  { bf16*stg=(bf16*)(shm+LDS_OST)+wid*2048;
    #pragma unroll
    for(int r=0;r<16;++r){const int orow=crow(r,hi);
      #pragma unroll
      for(int d0=0;d0<2;++d0)stg[orow*64+d0*32+r32]=__float2bfloat16(o[d0][r]*rli[r]);}
    asm volatile("s_waitcnt lgkmcnt(0)":::"memory");
    #pragma unroll
    for(int i=0;i<4;++i){const int row=i*8+(lane>>3),ch=lane&7; const u32x4 v=*(const u32x4*)(stg+row*64+ch*8); ATTN_STORE16(Ow+(long)row*DM+ch*8,v);} }
  asm volatile("s_waitcnt lgkmcnt(0)\n\ts_barrier":::"memory");
  #undef DMA_K
  #undef DMA_V
  #undef CMASK
  #undef START
  #undef RESC
  #undef ROT
}
constexpr int ATTN_LDS_BYTES=LDS_BYTES;
struct AttnTensors { const bf16* Q; const bf16* K; const bf16* V; bf16* O; const float* KB; const float* qg; const float* kg; };
struct AttnUnit { int bh; int qb; };
struct StaticOrder {
  int vcu;
  __device__ __forceinline__ explicit StaticOrder(int grid,int block):vcu((block%8)*(grid/8)+block/8){}
  __device__ __forceinline__ bool next(int i,AttnUnit&u)const{ if(i>=4)return false; const int s=vcu&3; u.bh=vcu>>2; u.qb=(i==0)?s:(i==1)?7-s:(i==2)?8+s:15-s; return true; }
  __device__ __forceinline__ void a_ready(const AttnUnit&)const{}
  __device__ __forceinline__ void done(const AttnUnit&)const{}
};
__device__ __forceinline__ int attn_ticket(unsigned*ctr,unsigned myx){
  for(unsigned k=0;k<8;++k){ const unsigned q=(myx+k)&7u; const unsigned m=atomicAdd(ctr+64*q,1u); if(m<128u) return (int)(q*128u+m); }
  return -1;
}
template<class Sched,int THRL=60> __device__ __forceinline__ void attn_phase(char*lds,const AttnTensors&T,const Sched&S,unsigned*ctr,volatile __attribute__((address_space(3))) unsigned*slot,unsigned myx){
  float thr; { const int l=threadIdx.x&63; float a=fabsf(T.qg[l]),c=fabsf(T.kg[l]);
    for(int o=1;o<64;o<<=1){a=fmaxf(a,__shfl_xor(a,o));c=fmaxf(c,__shfl_xor(c,o));}
    thr=2.0f*(1.05f*a*c*64.0f*C2)+40.0f; }
  if(threadIdx.x==0) slot[0]=(unsigned)attn_ticket(ctr,myx);
  __syncthreads();
  int n=(int)slot[0];
  while(n>=0){
    int pre=-1; if(threadIdx.x==0) pre=attn_ticket(ctr,myx);
    const int m=n&127, bh=8*(n>>7)+(m&7);
    attn_unit<THRL>(bh/NHEAD,bh%NHEAD,(NQB-1)-(m>>3),T.Q,T.K,T.V,T.O,T.KB,thr,lds);
    if(threadIdx.x==0) slot[0]=(unsigned)pre;
    __syncthreads();
    n=(int)slot[0];
  }
}
#undef SBAR
#undef WAIT_BAR
}

constexpr int NWAVES = 8;
constexpr int BATCH = 4, SEQ = 4096, D = 1024, H = 16, HD = 64, FF = 4096;
constexpr int M = BATCH * SEQ;
constexpr int NQKV = 3 * D, WIN_LD = 3 * D + H;
constexpr int NG = 64, NP = 64, NC = 16, LCH = 16, NCHUNK = M / LCH  , KA = LCH * NC + 2 * NP  ;

constexpr size_t MiB = 1u << 20;
constexpr size_t WS_CTL = 0;
constexpr size_t WS_BAR = 256 * 1024;
constexpr size_t WS_LAMT = 3 * MiB;
constexpr size_t WS_LF = 1 * MiB, WS_KB = 2 * MiB;
constexpr size_t WS_WQKV = 4 * MiB, WS_WO = 10 * MiB, WS_W1A = 12 * MiB, WS_W2A = 20 * MiB, WS_W1B = 28 * MiB, WS_W2B = 36 * MiB, WS_WSSM = 44 * MiB, WS_WGLU = 46 * MiB;
constexpr size_t WS_BT3 = 50 * MiB, WS_WT1 = 62 * MiB;
constexpr size_t WS_XN = 70 * MiB;
constexpr size_t WS_QO = 102 * MiB, WS_K = 134 * MiB, WS_V = 166 * MiB;
constexpr size_t WS_O = 198 * MiB;
constexpr size_t WS_H = 102 * MiB;
constexpr size_t WS_AALL = 102 * MiB, WS_SBUF = 150 * MiB, WS_Z = 182 * MiB;
constexpr size_t WS_END = 230 * MiB;

constexpr int RING_OFF = 0, RING_BYTES = 131072;
constexpr int XCH_OFF = RING_BYTES;
constexpr int MISC_OFF = XCH_OFF + 8192;
constexpr int LDS_BYTES = 147456;

#define GAS __attribute__((address_space(1)))
#define LAS __attribute__((address_space(3)))
typedef unsigned short bf16;
typedef unsigned v4u __attribute__((ext_vector_type(4)));
typedef float f32x4 __attribute__((ext_vector_type(4)));
#define LDS_WAIT() asm volatile("s_waitcnt lgkmcnt(0)" ::: "memory")
__device__ __forceinline__ unsigned f2bf(float f) { unsigned u = __builtin_bit_cast(unsigned, f); return (u + 0x7fffu + ((u >> 16) & 1u)) >> 16; }
__device__ __forceinline__ unsigned pk2(float lo, float hi) { unsigned r; asm("v_cvt_pk_bf16_f32 %0, %1, %2" : "=v"(r) : "v"(lo), "v"(hi)); return r; }
__device__ __forceinline__ float wave_sum(float v) {
#pragma unroll
    for (int o = 1; o < 64; o <<= 1) v += __shfl_xor(v, o);
    return v;
}
__device__ __forceinline__ void sincos_d(double a, double& s, double& c) {
    const double k = rint(a * 0.63661977236758134308);
    double r = fma(-k, 1.57079632679489655800e+00, a); r = fma(-k, 6.12323399573676603587e-17, r);
    const int q = ((int)k) & 3;
    const double r2 = r * r;
    const double sp = r * (1.0 + r2 * (-1.0 / 6 + r2 * (1.0 / 120 + r2 * (-1.0 / 5040 + r2 * (1.0 / 362880 + r2 * (-1.0 / 39916800 + r2 * (1.0 / 6227020800.0)))))));
    const double cp = 1.0 + r2 * (-0.5 + r2 * (1.0 / 24 + r2 * (-1.0 / 720 + r2 * (1.0 / 40320 + r2 * (-1.0 / 3628800 + r2 * (1.0 / 479001600.0 + r2 * (-1.0 / 87178291200.0)))))));
    s = (q == 0) ? sp : (q == 1) ? cp : (q == 2) ? -sp : -cp;
    c = (q == 0) ? cp : (q == 1) ? -sp : (q == 2) ? -cp : sp;
}

#define XB_TMO      128
#define XB_XCNT(j)  (256  + 64 * (j))
#define XB_XSUB(j)  (1280 + 64 * (j))
#define XB_XGEN(j)  (2304 + 64 * (j))
#define XB_TOP      3328
#define XB_TOPGEN   3392
#define XCD_BAR_WORDS 3456
#define XB_SPIN_CAP (1u << 18)

__device__ __forceinline__ unsigned xb_ld(unsigned* p)              { return __hip_atomic_load(p, __ATOMIC_RELAXED, __HIP_MEMORY_SCOPE_AGENT); }
__device__ __forceinline__ unsigned xb_add(unsigned* p, unsigned v) { return __hip_atomic_fetch_add(p, v, __ATOMIC_RELAXED, __HIP_MEMORY_SCOPE_AGENT); }
__device__ __forceinline__ unsigned xb_xcc_id() { return (unsigned)__builtin_amdgcn_s_getreg((3 << 11) | 20) & 0xFu; }
#define XB_SPIN(cond, bar) do { unsigned _sp = 0; while (cond) { __builtin_amdgcn_s_sleep(1); \
    if ((++_sp & 255u) == 0u) { if (xb_ld(&(bar)[XB_TMO])) break; if (_sp > XB_SPIN_CAP) { atomicAdd(&(bar)[XB_TMO], 1u); break; } } } } while (0)

struct XcdBarrier {
    unsigned* bar; unsigned x;
    volatile LAS unsigned* st;
};

__device__ __forceinline__ XcdBarrier xcd_barrier_post(unsigned* bar, volatile LAS unsigned* st) {
    XcdBarrier b; b.bar = bar; b.x = xb_xcc_id(); b.st = st;
    if (threadIdx.x == 0) (void)xb_add(&bar[XB_XCNT(b.x)], 1u);
    return b;
}
__device__ __forceinline__ void xcd_barrier_complete(unsigned* bar, unsigned x, unsigned& nloc, unsigned& nx) {
    const unsigned G = gridDim.x * gridDim.y * gridDim.z;
    unsigned sum, cnt, mine, sp = 0u;
    for (;;) {
        sum = 0u; cnt = 0u; mine = 0u;
#pragma unroll
        for (unsigned j = 0; j < 16; ++j) { const unsigned c = xb_ld(&bar[XB_XCNT(j)]); sum += c; cnt += (c > 0u) ? 1u : 0u; mine = (j == x) ? c : mine; }
        if (sum == G) break;
        __builtin_amdgcn_s_sleep(1);
        if ((++sp & 255u) == 0u) { if (xb_ld(&bar[XB_TMO])) break; if (sp > XB_SPIN_CAP) { atomicAdd(&bar[XB_TMO], 1u); break; } }
    }
    nloc = mine > 0u ? mine : 1u; nx = cnt > 0u ? cnt : 1u;
}

__device__ __forceinline__ void xcd_barrier(const XcdBarrier& b) {
    asm volatile("s_waitcnt vmcnt(0)" ::: "memory");
    __syncthreads();
    if (threadIdx.x == 0) {
        unsigned* bar = b.bar;
        __builtin_amdgcn_s_waitcnt(0);
        unsigned nloc = b.st[0], nx = b.st[1];
        if (nloc == 0u) { xcd_barrier_complete(bar, b.x, nloc, nx); b.st[0] = nloc; b.st[1] = nx; }
        const unsigned old = xb_add(&bar[XB_XSUB(b.x)], 1u);
        const unsigned gen = old / nloc;
        if (old + 1u == (gen + 1u) * nloc) {
            __builtin_amdgcn_fence(__ATOMIC_RELEASE, "agent");
            asm volatile("s_waitcnt vmcnt(0)" ::: "memory");
            const unsigned og = xb_add(&bar[XB_TOP], 1u);
            const unsigned tg = og / nx;
            if (og + 1u == (tg + 1u) * nx) xb_add(&bar[XB_TOPGEN], 1u);
            else XB_SPIN(xb_ld(&bar[XB_TOPGEN]) == tg, bar);
            __builtin_amdgcn_fence(__ATOMIC_ACQUIRE, "agent");
            xb_add(&bar[XB_XGEN(b.x)], 1u);
            asm volatile("s_waitcnt vmcnt(0)" ::: "memory");
        } else {
            XB_SPIN(xb_ld(&bar[XB_XGEN(b.x)]) == gen, bar);
            __builtin_amdgcn_fence(__ATOMIC_ACQUIRE, "agent");
            asm volatile("s_waitcnt vmcnt(0)" ::: "memory");
        }
    }
    __syncthreads();
}

struct Args { const float* in[20]; float* out; unsigned char* ws; int ph_lo, ph_hi; };

typedef const __attribute__((address_space(4))) Args* KArgs;
__device__ __forceinline__ KArgs kargs() { KArgs p = (KArgs)__builtin_amdgcn_kernarg_segment_ptr(); asm volatile("" : "+s"(p)); return p; }
__device__ __forceinline__ void p0_transpose_item(const float* W, int ldw, int K, int ncols, bf16* WT, LAS float* scr, int item, int lane, const float* gk, int glu) {
    const int nblk = ncols / 32, kb = item / nblk, nb = item % nblk, k0 = 64 * kb, n0 = 32 * nb;
    int src0 = n0;
    if (glu == 1) src0 = ((n0 >> 7) & 1) * 1024 + 128 * (n0 >> 8) + (n0 & 127);
    if (glu == 2) src0 = (n0 & ~255) + 64 * ((n0 >> 5) & 3) + 32 * ((n0 >> 7) & 1);
#pragma unroll 8
    for (int i = 0; i < 32; ++i) { const int kk = 2 * i + (lane >> 5); const float g = gk ? gk[k0 + kk] : 1.0f; scr[kk * 33 + (lane & 31)] = __builtin_nontemporal_load(W + (size_t)(k0 + kk) * ldw + src0 + (lane & 31)) * g; }
    LDS_WAIT(); asm volatile("" ::: "memory");
    const int c = lane & 7;
#pragma unroll
    for (int j = 0; j < 4; ++j) { const int n = (lane >> 3) + 8 * j; const LAS float* s = scr + (8 * c) * 33 + n;
        v4u o; o.x = pk2(s[0 * 33], s[1 * 33]); o.y = pk2(s[2 * 33], s[3 * 33]); o.z = pk2(s[4 * 33], s[5 * 33]); o.w = pk2(s[6 * 33], s[7 * 33]);
        *(GAS v4u*)(WT + (size_t)(n0 + n) * K + k0 + 8 * c) = o; }
    LDS_WAIT(); asm volatile("" ::: "memory");
}

__device__ __forceinline__ void ssm_setup(LAS unsigned char* lds, int tid, unsigned* ctr, volatile LAS unsigned* slot) {
    KArgs a = kargs();
    const float* a_re = a->in[9]; const float* a_im = a->in[10]; const float* b_re = a->in[11]; const float* b_im = a->in[12];
    const float* c_re = a->in[13]; const float* c_im = a->in[14]; const float* log_dt = a->in[15];
    bf16* BT3 = (bf16*)(a->ws + WS_BT3); bf16* WT1 = (bf16*)(a->ws + WS_WT1);
    LAS float* lamp = (LAS float*)lds;
    LAS float* bbt = lamp + 17 * 64 * 2;
    LAS float* cct = bbt + 64 * 16 * 2;
    LAS float* Kt = cct + 16 * 64 * 2;
    for (;;) {
        if (tid == 0) slot[0] = atomicAdd(ctr, 1u);
        __syncthreads();
        const int w = (int)slot[0];
        if (w >= 4 * NG) break;
        const int g = w >> 2, q = w & 3;
        {
            LAS double* ld = (LAS double*)(Kt);
            if (tid < 64) { const int p = tid; const double dt = exp((double)log_dt[g]), are = (double)a_re[g * 64 + p], aim = (double)a_im[g * 64 + p];
                double sn, cs; sincos_d(dt * aim, sn, cs); const double mag = exp(dt * are); const double lr = mag * cs, li = mag * sn;
                const double nr = lr - 1.0, ni = li, den = are * are + aim * aim;
                ld[p * 4] = lr; ld[p * 4 + 1] = li; ld[p * 4 + 2] = (nr * are + ni * aim) / den; ld[p * 4 + 3] = (ni * are - nr * aim) / den;
                if (q == 0) { double pr = lr, pi = li; f32x4 o;
#pragma unroll 1
                    for (int sq = 0; sq < 9; ++sq) { if (sq == 4) { o.x = (float)pr; o.y = (float)pi; } const double t = pr * pr - pi * pi; pi = 2.0 * pr * pi; pr = t; }
                    o.z = (float)pr; o.w = (float)pi; *(f32x4*)((float*)(a->ws + WS_LAMT) + (size_t)(g * 64 + p) * 4) = o; } }
            __syncthreads();
#pragma unroll 1
            for (int idx = tid; idx < 17 * 64; idx += 512) { const int tau = idx >> 6, p = idx & 63; double br = ld[p * 4], bi = ld[p * 4 + 1], rr = 1.0, ri = 0.0;
#pragma unroll
                for (int bit = 0; bit < 5; ++bit) { if ((tau >> bit) & 1) { const double t = rr * br - ri * bi; ri = rr * bi + ri * br; rr = t; } const double t2 = br * br - bi * bi; bi = 2.0 * br * bi; br = t2; }
                lamp[idx * 2] = (float)rr; lamp[idx * 2 + 1] = (float)ri; }
#pragma unroll 1
            for (int idx = tid; idx < 64 * 16; idx += 512) { const int p = idx >> 4; const double sr = ld[p * 4 + 2], si = ld[p * 4 + 3];
                const double br = (double)b_re[g * 1024 + idx], bi = (double)b_im[g * 1024 + idx];
                bbt[idx * 2] = (float)(sr * br - si * bi); bbt[idx * 2 + 1] = (float)(sr * bi + si * br); }
        }
        for (int i = tid; i < 1024; i += 512) { cct[i * 2] = c_re[g * 1024 + i]; cct[i * 2 + 1] = c_im[g * 1024 + i]; }
        __syncthreads();
        {
            const int tau = tid >> 5, cp = (tid >> 1) & 15, c0 = (tid & 1) * 8; float sacc[8];
#pragma unroll
            for (int e = 0; e < 8; ++e) sacc[e] = 0.f;
#pragma unroll 2
            for (int p = 0; p < 64; ++p) { const float cr = cct[(cp * 64 + p) * 2], ci = cct[(cp * 64 + p) * 2 + 1], lr = lamp[(tau * 64 + p) * 2], li = lamp[(tau * 64 + p) * 2 + 1];
                const float dr = cr * lr - ci * li, di = cr * li + ci * lr;
                const LAS f32x4* bp = (const LAS f32x4*)(bbt + (p * 16 + c0) * 2);
#pragma unroll
                for (int e4 = 0; e4 < 4; ++e4) { const f32x4 b4 = bp[e4]; sacc[2 * e4] += dr * b4.x - di * b4.y; sacc[2 * e4 + 1] += dr * b4.z - di * b4.w; } }
#pragma unroll
            for (int e = 0; e < 8; ++e) Kt[tau * 256 + cp * 16 + c0 + e] = sacc[e] + ((tau == 0 && c0 + e == cp) ? a->in[16][16 * g + cp] : 0.f);
        }
        __syncthreads();
#pragma unroll 1
        for (int r = 0; r < 6; ++r) { const int pc = tid + 512 * r, rr = pc / 48, k8 = (pc % 48) * 8, n = 64 * q + rr, j = n >> 4, cp = n & 15; float v[8];
            if (k8 < 256) { const int s = k8 >> 4, c0 = k8 & 15;
#pragma unroll
                for (int e = 0; e < 8; ++e) v[e] = (j >= s) ? Kt[(j - s) * 256 + cp * 16 + c0 + e] : 0.f;
            } else { const int im = (k8 - 256) >> 6, p0 = (k8 - 256) & 63;
#pragma unroll
                for (int e = 0; e < 8; ++e) { const int p = p0 + e; const float cr = cct[(cp * 64 + p) * 2], ci = cct[(cp * 64 + p) * 2 + 1], lr = lamp[((j + 1) * 64 + p) * 2], li = lamp[((j + 1) * 64 + p) * 2 + 1];
                    v[e] = im ? -(cr * li + ci * lr) : (cr * lr - ci * li); } }
            v4u o; o.x = pk2(v[0], v[1]); o.y = pk2(v[2], v[3]); o.z = pk2(v[4], v[5]); o.w = pk2(v[6], v[7]);
            *(GAS v4u*)(BT3 + (size_t)(g * 256 + n) * KA + k8) = o; }
#pragma unroll 1
        for (int r = 0; r < 4; ++r) { const int pc = tid + 512 * r, rr = pc >> 5, k8 = (pc & 31) * 8, n = 64 * q + rr; float v[8];
            if (n < 128) { const int p = n & 63, im = n >> 6, s = k8 >> 4, c0 = k8 & 15; const float lr = lamp[((15 - s) * 64 + p) * 2], li = lamp[((15 - s) * 64 + p) * 2 + 1];
#pragma unroll
                for (int e = 0; e < 8; ++e) { const float br = bbt[(p * 16 + c0 + e) * 2], bi = bbt[(p * 16 + c0 + e) * 2 + 1]; v[e] = im ? (lr * bi + li * br) : (lr * br - li * bi); }
            } else {
#pragma unroll
                for (int e = 0; e < 8; ++e) v[e] = 0.f; }
            v4u o; o.x = pk2(v[0], v[1]); o.y = pk2(v[2], v[3]); o.z = pk2(v[4], v[5]); o.w = pk2(v[6], v[7]);
            *(GAS v4u*)(WT1 + (size_t)(g * 256 + n) * 256 + k8) = o; }
        __syncthreads();
    }
}

__device__ __forceinline__ void p0_prologue(LAS unsigned char* lds, int tid, int lane, int wave, int vcu, int G) {
    const int gw = vcu * NWAVES + wave, NGW = G * NWAVES;
    { KArgs a = kargs(); const float* nmix = a->in[1]; const float* nmlp = a->in[2]; const float* w_in = a->in[3]; unsigned char* ws = a->ws;
    LAS float* scr = (LAS float*)(lds + RING_OFF + wave * 16384);
    constexpr int I_QKV = (D / 64) * (NQKV / 32), I_O = (D / 64) * (D / 32), I_1 = (D / 64) * (FF / 32), I_2 = (FF / 64) * (D / 32), I_G = (D / 64) * (2 * D / 32);
    constexpr int NITEMS = I_QKV + I_O + 2 * I_1 + 2 * I_2 + I_O + I_G;
    for (int it = gw; it < NITEMS; it += NGW) {
        int r = it;
        if (r < I_1) { p0_transpose_item(a->in[18] + (size_t)D * FF, FF, D, FF, (bf16*)(ws + WS_W1B), scr, r, lane, nmlp + D, 0); continue; } r -= I_1;
        if (r < I_2) { p0_transpose_item(a->in[19] + (size_t)FF * D, D, FF, D, (bf16*)(ws + WS_W2B), scr, r, lane, nullptr, 0); continue; } r -= I_2;
        if (r < I_G) { p0_transpose_item(a->in[17], 2 * D, D, 2 * D, (bf16*)(ws + WS_WGLU), scr, r, lane, nullptr, 1); continue; } r -= I_G;
        if (r < I_O) { p0_transpose_item(a->in[8], D, D, D, (bf16*)(ws + WS_WSSM), scr, r, lane, nmix + D, 0); continue; } r -= I_O;
        if (r < I_2) { p0_transpose_item(a->in[19], D, FF, D, (bf16*)(ws + WS_W2A), scr, r, lane, nullptr, 0); continue; } r -= I_2;
        if (r < I_1) { p0_transpose_item(a->in[18], FF, D, FF, (bf16*)(ws + WS_W1A), scr, r, lane, nmlp, 0); continue; } r -= I_1;
        if (r < I_O) { p0_transpose_item(a->in[7], D, D, D, (bf16*)(ws + WS_WO), scr, r, lane, nullptr, 0); continue; } r -= I_O;
        p0_transpose_item(w_in, WIN_LD, D, NQKV, (bf16*)(ws + WS_WQKV), scr, r, lane, nullptr, 2);
    }
    }
    KArgs a = kargs(); const float* x = a->in[0]; const float* nmix = a->in[1]; const float* w_in = a->in[3]; const float* b_f = a->in[4]; unsigned char* ws = a->ws;
    { float* rs = (float*)(ws + WS_CTL); for (int i = blockIdx.x * 512 + tid; i < 3 * M; i += G * 512) rs[i] = 0.f; }
    __syncthreads();
    LAS float* wfT = (LAS float*)(lds + RING_OFF);
    for (int i = tid; i < D * H; i += 512) { const int k = i >> 4, h = i & 15; wfT[h * D + k] = w_in[(size_t)k * WIN_LD + NQKV + h]; }
    __syncthreads();
    bf16* XN = (bf16*)(ws + WS_XN); float* LF = (float*)(ws + WS_LF);
    for (int m = gw; m < M; m += NGW) {
        const GAS f32x4* xr = (const GAS f32x4*)(x + (size_t)m * D) + lane;
        f32x4 v[4]; float s = 0.f;
#pragma unroll
        for (int j = 0; j < 4; ++j) { v[j] = __builtin_nontemporal_load(xr + 64 * j); s += (v[j].x * v[j].x + v[j].y * v[j].y) + (v[j].z * v[j].z + v[j].w * v[j].w); }
        const float ssx = wave_sum(s); const float rs = 1.0f / sqrtf(ssx * (1.f / D) + 1e-6f);
        if (lane == 0) ((float*)(ws + WS_CTL))[3 * M + m] = ssx;
        GAS unsigned long long* o8 = (GAS unsigned long long*)(XN + (size_t)m * D) + lane;
#pragma unroll
        for (int j = 0; j < 4; ++j) { const f32x4 g4 = *(const f32x4*)(nmix + 256 * j + 4 * lane); v[j] = v[j] * rs * g4;
            o8[64 * j] = (unsigned long long)pk2(v[j].x, v[j].y) | ((unsigned long long)pk2(v[j].z, v[j].w) << 32); }
        float acc[16];
#pragma unroll
        for (int h = 0; h < 16; ++h) { float t = 0.f; if ((h & 3) == 0) asm volatile("" ::: "memory");
#pragma unroll
            for (int j = 0; j < 4; ++j) { const f32x4 w4 = *(const LAS f32x4*)(wfT + h * D + 256 * j + 4 * lane); t += (v[j].x * w4.x + v[j].y * w4.y) + (v[j].z * w4.z + v[j].w * w4.w); }
            acc[h] = t; }
#pragma unroll
        for (int i = 0; i < 8; ++i) { const bool hi = (lane & 32) != 0; const float send = hi ? acc[i] : acc[i + 8], keep = hi ? acc[i + 8] : acc[i]; acc[i] = keep + __shfl_xor(send, 32); }
#pragma unroll
        for (int i = 0; i < 4; ++i) { const bool hi = (lane & 16) != 0; const float send = hi ? acc[i] : acc[i + 4], keep = hi ? acc[i + 4] : acc[i]; acc[i] = keep + __shfl_xor(send, 16); }
#pragma unroll
        for (int i = 0; i < 2; ++i) { const bool hi = (lane & 8) != 0; const float send = hi ? acc[i] : acc[i + 2], keep = hi ? acc[i + 2] : acc[i]; acc[i] = keep + __shfl_xor(send, 8); }
        { const bool hi = (lane & 4) != 0; const float send = hi ? acc[0] : acc[1], keep = hi ? acc[1] : acc[0]; acc[0] = keep + __shfl_xor(send, 4); }
        float f = acc[0]; f += __shfl_xor(f, 2); f += __shfl_xor(f, 1);
        const int hh = lane >> 2;
        const float z = f + b_f[hh];
        const float lf = fminf(z, 0.f) - 0.6931471805599453f * __builtin_amdgcn_logf(1.0f + __builtin_amdgcn_exp2f(-1.4426950408889634f * fabsf(z)));
        if ((lane & 3) == 0) LF[(size_t)((m >> 12) * 16 + hh) * SEQ + (m & (SEQ - 1))] = lf;
    }
}

__device__ __forceinline__ void cumsum_phase(LAS unsigned char* lds, int tid, int lane, int wave) {
    KArgs a = kargs();
    const float* LF = (const float*)(a->ws + WS_LF); float* KB = (float*)(a->ws + WS_KB);
    LAS float* wsum = (LAS float*)(lds + MISC_OFF);
    for (int bh = blockIdx.x; bh < BATCH * H; bh += gridDim.x) {
        const float* src = LF + (size_t)bh * SEQ + 8 * tid;
        const f32x4 a0 = *(const f32x4*)src, a1 = *(const f32x4*)(src + 4);
        float p[8]; p[0] = a0.x; p[1] = p[0] + a0.y; p[2] = p[1] + a0.z; p[3] = p[2] + a0.w; p[4] = p[3] + a1.x; p[5] = p[4] + a1.y; p[6] = p[5] + a1.z; p[7] = p[6] + a1.w;
        float incl = p[7];
#pragma unroll
        for (int o = 1; o < 64; o <<= 1) { const float t = __shfl_up(incl, o); if (lane >= o) incl += t; }
        if (lane == 63) wsum[wave] = incl;
        __syncthreads();
        float off = incl - p[7];
        for (int w = 0; w < wave; ++w) off += wsum[w];
        f32x4 o0, o1;
        o0.x = -(p[0] + off) * 1.4426950408889634f; o0.y = -(p[1] + off) * 1.4426950408889634f; o0.z = -(p[2] + off) * 1.4426950408889634f; o0.w = -(p[3] + off) * 1.4426950408889634f;
        o1.x = -(p[4] + off) * 1.4426950408889634f; o1.y = -(p[5] + off) * 1.4426950408889634f; o1.z = -(p[6] + off) * 1.4426950408889634f; o1.w = -(p[7] + off) * 1.4426950408889634f;
        float* dst = KB + (size_t)bh * SEQ + 8 * tid;
        *(f32x4*)dst = o0; *(f32x4*)(dst + 4) = o1;
        __syncthreads();
    }
}

template <bool FROM_LDS> __device__ __forceinline__ void scan_phase(LAS unsigned char* lds, int lane, int wave, int vcu) {
    KArgs a = kargs();
    const float* SB = (const float*)(a->ws + WS_SBUF); bf16* AA = (bf16*)(a->ws + WS_AALL);
    LAS float* est = (LAS float*)(lds + (FROM_LDS ? 256 * pg8::SL_PITCH * 4 : RING_OFF));
    const LAS float* SL = (const LAS float*)(lds + RING_OFF);
    for (int w = vcu; w < NG * BATCH; w += gridDim.x) {
        const int g = w >> 2, b = w & 3, p = lane;
        const f32x4 lt = *(const f32x4*)((const float*)(a->ws + WS_LAMT) + (size_t)(g * 64 + p) * 4);
        const float l16r = lt.x, l16i = lt.y, l512r = lt.z, l512i = lt.w;
        const size_t row0 = (size_t)g * 1024 + b * 256 + 32 * wave;
        float sr[32], si[32];
#pragma unroll
        for (int i = 0; i < 32; ++i) { if (FROM_LDS) { sr[i] = SL[(32 * wave + i) * pg8::SL_PITCH + p]; si[i] = SL[(32 * wave + i) * pg8::SL_PITCH + 64 + p]; } else { sr[i] = SB[(row0 + i) * 128 + p]; si[i] = SB[(row0 + i) * 128 + 64 + p]; } }
        float xr = 0.f, xi = 0.f;
#pragma unroll
        for (int i = 0; i < 32; ++i) { const float nr = l16r * xr - l16i * xi + sr[i], ni = l16r * xi + l16i * xr + si[i]; xr = nr; xi = ni; sr[i] = xr; si[i] = xi; }
        est[(wave * 64 + p) * 2] = xr; est[(wave * 64 + p) * 2 + 1] = xi;
        __syncthreads();
        float pr = 0.f, pi = 0.f;
        for (int v = 0; v < wave; ++v) { const float er = est[(v * 64 + p) * 2], ei = est[(v * 64 + p) * 2 + 1]; const float nr = l512r * pr - l512i * pi + er, ni = l512r * pi + l512i * pr + ei; pr = nr; pi = ni; }
        float qr = 0.f, qi = 0.f;
#pragma unroll
        for (int i = 0; i < 32; ++i) { bf16* dst = AA + (row0 + i) * KA + 256 + p;
            { const unsigned pkd = pk2(qr + pr, qi + pi); dst[0] = (bf16)(pkd & 0xffffu); dst[64] = (bf16)(pkd >> 16); }
            qr = sr[i]; qi = si[i];
            const float nr = l16r * pr - l16i * pi, ni = l16r * pi + l16i * pr; pr = nr; pi = ni; }
        __syncthreads();
    }
}

__global__ void __launch_bounds__(NWAVES * 64, 2) fwd_megakernel(Args args) {
    extern __shared__ __attribute__((aligned(16))) unsigned char lds_raw[];
    cg::grid_group grid = cg::this_grid();
    LAS unsigned char* lds = (LAS unsigned char*)lds_raw;
    const int tid = threadIdx.x, lane = tid & 63, wave = __builtin_amdgcn_readfirstlane(tid >> 6);
    const int G = gridDim.x; const int bx = blockIdx.x; const int vcu = (G % 8 == 0) ? (bx % 8) * (G / 8) + bx / 8 : bx;
    const int lo = kargs()->ph_lo, hi = kargs()->ph_hi;
#define ws (kargs()->ws)
#define AIN(k) (kargs()->in[k])
#define AOUT (kargs()->out)
#ifndef ONLY
#define ONLY -1
#endif
#define IN(k) ((ONLY < 0 || ONLY == (k)) && lo <= (k) && (k) < hi)
#define WG_SEAM() do { asm volatile("s_waitcnt vmcnt(0) lgkmcnt(0)" ::: "memory"); __syncthreads(); if (wave == 0) { __builtin_amdgcn_fence(__ATOMIC_ACQUIRE, "agent"); asm volatile("s_waitcnt vmcnt(0)" ::: "memory"); } __syncthreads(); } while (0)
#define SEAM(k) do { if (IN(k) && IN((k) + 1)) { xcd_barrier(xbar); } } while (0)
#define rowss ((float*)(ws + WS_CTL))
#define XN ((bf16*)(ws + WS_XN))
#define HB ((bf16*)(ws + WS_H))

    if (tid < 32) ((LAS unsigned*)(lds + MISC_OFF))[tid] = 0u;
    if (bx == 0) { unsigned* bw = (unsigned*)(ws + WS_BAR); for (int i = tid; i < XCD_BAR_WORDS; i += NWAVES * 64) bw[i] = 0u; if (tid < 9) bw[4096 + 64 * tid] = 0u; }
    if (IN(0)) { p0_prologue(lds, tid, lane, wave, vcu, G); }
    __threadfence(); grid.sync();
    XcdBarrier xbar = xcd_barrier_post((unsigned*)(ws + WS_BAR), (volatile LAS unsigned*)(lds + MISC_OFF) + 8);
    if (IN(1)) cumsum_phase(lds, tid, lane, wave);
    if (IN(1)) {
        pg8::Gemm g{XN, (const bf16*)(ws + WS_WQKV), M, NQKV, D, D, D}; pg8::StaticOrder S; S.init(M, NQKV, G, bx);
        { LAS float* gl = (LAS float*)(lds + MISC_OFF + 1024); if (tid < 64) gl[tid] = AIN(5)[tid] * attn_body::C2; else if (tid < 128) gl[tid] = AIN(6)[tid - 64]; __syncthreads(); }
        pg8::EpiQKV E{(bf16*)(ws + WS_QO), (size_t)(WS_K - WS_QO) / 2, (PG8_LAS const float*)(lds + MISC_OFF + 1024)};
        pg8::gemm_phase(lds + RING_OFF, g, S, E);
    }
    SEAM(1);
    if (IN(2)) {
        const attn_body::AttnTensors AT{(const attn_body::bf16*)(ws + WS_QO), (const attn_body::bf16*)(ws + WS_K), (const attn_body::bf16*)(ws + WS_V), (attn_body::bf16*)(ws + WS_O), (const float*)(ws + WS_KB), AIN(5), AIN(6)};
        const attn_body::StaticOrder S(G, bx);
        attn_body::attn_phase<attn_body::StaticOrder>((char*)lds_raw + RING_OFF, AT, S, (unsigned*)(ws + WS_BAR) + 4096, (volatile LAS unsigned*)(lds + MISC_OFF) + 16, xbar.x);
        ssm_setup(lds, tid, (unsigned*)(ws + WS_BAR) + 4096 + 64 * 8, (volatile LAS unsigned*)(lds + MISC_OFF) + 18);
    }
    SEAM(2);
    if (IN(3)) {
        pg8::Gemm g{(const bf16*)(ws + WS_O), (const bf16*)(ws + WS_WO), M, D, D, D, D}; pg8::StaticOrder S; S.init(M, D, G, bx);
        pg8::EpiResid E{nullptr, XN, nullptr, XN, rowss, rowss + 3 * M, AIN(1), nullptr};
        pg8::gemm_phase(lds + RING_OFF, g, S, E);
    }
    SEAM(3);
    if (IN(4)) {
        pg8::Gemm g{XN, (const bf16*)(ws + WS_W1A), M, FF, D, D, D}; pg8::StaticOrder S; S.init(M, FF, G, bx);
        pg8::EpiSqrelu E{HB, FF};
        pg8::gemm_phase(lds + RING_OFF, g, S, E);
    }
    SEAM(4);
    if (IN(5)) {
        pg8::Gemm g{HB, (const bf16*)(ws + WS_W2A), M, D, FF, FF, FF}; pg8::StaticOrder S; S.init(M, D, G, bx);
        pg8::EpiResid E{nullptr, XN, nullptr, XN, rowss + M, nullptr, nullptr, rowss};
        pg8::gemm_phase(lds + RING_OFF, g, S, E);
    }
    SEAM(5);
    if (IN(6)) {
        pg8::Gemm g{XN, (const bf16*)(ws + WS_WSSM), M, D, D, D, D}; pg8::StaticOrder S; S.init(M, D, G, bx);
        pg8::EpiU E{(bf16*)(ws + WS_AALL), rowss + M};
        pg8::gemm_phase(lds + RING_OFF, g, S, E);
    }
    SEAM(6);
    if (G == NG * BATCH) {
        if (IN(7)) {
            pg8::Gemm g{(const bf16*)(ws + WS_AALL), (const bf16*)(ws + WS_WT1), NG * 1024, 256, 256, KA, 256}; pg8::BatchOrder S; S.init(NG * 4, G, vcu);
            pg8::EpiSLds E{(PG8_LAS float*)(lds + RING_OFF)};
            pg8::gemm_phase(lds + RING_OFF, g, S, E);
        }
        __syncthreads();
        if (IN(8)) scan_phase<true>(lds, lane, wave, vcu);
        WG_SEAM();
    } else {
        if (IN(7)) {
            pg8::Gemm g{(const bf16*)(ws + WS_AALL), (const bf16*)(ws + WS_WT1), NG * 1024, 256, 256, KA, 256}; pg8::BatchOrder S; S.init(NG * 4, G, vcu);
            pg8::EpiS E{(float*)(ws + WS_SBUF)};
            pg8::gemm_phase(lds + RING_OFF, g, S, E);
        }
        SEAM(7);
        if (IN(8)) scan_phase<false>(lds, lane, wave, vcu);
        SEAM(8);
    }
    if (IN(9)) {
        pg8::Gemm g{(const bf16*)(ws + WS_AALL), (const bf16*)(ws + WS_BT3), NG * 1024, 256, KA, KA, KA}; pg8::BatchOrder S; S.init(NG * 4, G, vcu);
        pg8::EpiY E{(bf16*)(ws + WS_Z)};
        pg8::gemm_phase(lds + RING_OFF, g, S, E);
    }
    SEAM(9);
    if (IN(10)) {
        pg8::Gemm g{(const bf16*)(ws + WS_Z), (const bf16*)(ws + WS_WGLU), M, 2 * D, D, D, D}; pg8::StaticOrder S; S.init(M, 2 * D, G, bx);
        pg8::EpiGlu E{XN, rowss + 2 * M};
        pg8::gemm_phase(lds + RING_OFF, g, S, E);
    }
    SEAM(10);
    if (IN(11)) {
        pg8::Gemm g{XN, (const bf16*)(ws + WS_W1B), M, FF, D, D, D}; pg8::StaticOrder S; S.init(M, FF, G, bx);
        pg8::EpiSqrelu E{HB, FF};
        pg8::gemm_phase(lds + RING_OFF, g, S, E);
    }
    SEAM(11);
    if (IN(12)) {
        pg8::Gemm g{HB, (const bf16*)(ws + WS_W2B), M, D, FF, FF, FF}; pg8::StaticOrder S; S.init(M, D, G, bx);
        pg8::EpiResid E{nullptr, XN, AOUT, nullptr, nullptr, nullptr, nullptr, rowss + 2 * M};
        pg8::gemm_phase(lds + RING_OFF, g, S, E);
    }
#undef IN
#undef SEAM
#undef ws
#undef AIN
#undef AOUT
#undef rowss
#undef XN
#undef HB
}

extern "C" void kernel_launch(void* const* d_in, const int* in_sizes, int n_in, void* d_out, int out_size, void* d_ws, size_t ws_size, hipStream_t stream) {
    static int grid = 0;
    if (grid == 0) {
        if (n_in != 20 || in_sizes[0] != M * D || out_size != M * D || ws_size < WS_END) { fprintf(stderr, "kernel_launch: unexpected shapes (n_in %d, in0 %d, out %d, ws %zu)\n", n_in, n_in > 0 ? in_sizes[0] : -1, out_size, ws_size); grid = -1; return; }
        int dev = 0, cus = 0, per_cu = 0;
        if (hipGetDevice(&dev) != hipSuccess || hipDeviceGetAttribute(&cus, hipDeviceAttributeMultiprocessorCount, dev) != hipSuccess) { grid = -1; return; }
        if (hipFuncSetAttribute((const void*)fwd_megakernel, hipFuncAttributeMaxDynamicSharedMemorySize, LDS_BYTES) != hipSuccess) { fprintf(stderr, "kernel_launch: hipFuncSetAttribute failed\n"); grid = -1; return; }
        if (hipOccupancyMaxActiveBlocksPerMultiprocessor(&per_cu, (const void*)fwd_megakernel, NWAVES * 64, LDS_BYTES) != hipSuccess || per_cu < 1) { fprintf(stderr, "kernel_launch: occupancy query reports %d workgroups per CU\n", per_cu); (void)hipGetLastError(); per_cu = 1; }
        grid = cus;
        if (grid != 256) fprintf(stderr, "kernel_launch: %d CUs; the attention unit order expects 256\n", grid);
    }
    if (grid < 0) return;
    Args a{};
    for (int i = 0; i < 20; ++i) a.in[i] = (const float*)d_in[i];
    a.out = (float*)d_out; a.ws = (unsigned char*)d_ws; a.ph_lo = 0; a.ph_hi = 13;
    void* params[] = {&a};
    const hipError_t le = hipLaunchCooperativeKernel((const void*)fwd_megakernel, dim3(grid), dim3(NWAVES * 64), params, LDS_BYTES, stream);
    if (le != hipSuccess) fprintf(stderr, "kernel_launch: cooperative launch failed: %s (grid %d)\n", hipGetErrorName(le), grid);
}
```

```cpp
#include <hip/hip_runtime.h>
#include <hip/hip_cooperative_groups.h>
#include <hip/hip_bf16.h>
#include <cstdio>
#include <cstdint>
#include <cmath>
namespace cg = cooperative_groups;

namespace pg8 {
#define PG8_LAS __attribute__((address_space(3)))
typedef unsigned short bf16_t;
typedef short bf16x8 __attribute__((ext_vector_type(8)));
typedef float f32x4 __attribute__((ext_vector_type(4)));
typedef unsigned u32x4 __attribute__((ext_vector_type(4)));
constexpr int BM = 256, BK = 64, HALF = 128, HTB = HALF * BK * 2  , STAGE_BYTES = 8 * HTB, NXCD = 8, WGM = 8;

__host__ __device__ __forceinline__ int lds_byte(int r, int c) { const int st = (r >> 4) * 2 + (c >> 5), rr = r & 15, cc = c & 31, ob = rr * 64 + cc * 2; return st * 1024 + (ob ^ (((ob >> 9) & 1) << 5)); }
__host__ __device__ __forceinline__ void stage_rc(int b, int& R, int& C) { const int st = b / 1024, sb = b % 1024, swz = sb ^ (((sb >> 9) & 1) << 5); R = (st >> 1) * 16 + swz / 64; C = (st & 1) * 32 + (swz % 64) / 2; }
__host__ __device__ __forceinline__ int perm32(int rho) { const int n = rho >> 4, i = rho & 15; return 8 * (i >> 2) + 4 * n + (i & 3); }

struct Unit { int pm, pn; };
struct Gemm { const bf16_t* A; const bf16_t* Bt; int M, N, K, lda, ldb; };

struct StaticOrder {
    int nM, nN, nwg, G, c;
    __host__ __device__ void init(int M, int N, int G_, int c_) { nM = M / BM; nN = N / BM; nwg = nM * nN; G = G_; c = c_; }
    __host__ __device__ bool next(int i, Unit& u) const {
        const long L = (long)i * G + c; if (L >= nwg) return false;
        int wgid = (int)L; { const int q = nwg / NXCD, r = nwg % NXCD, xcd = wgid % NXCD, off = wgid / NXCD; wgid = (xcd < r ? xcd * (q + 1) : r * (q + 1) + (xcd - r) * q) + off; }
        const int nig = WGM * nN, gid = wgid / nig, fm = gid * WGM, gsz = (nM - fm) < WGM ? (nM - fm) : WGM;
        u.pm = fm + ((wgid % nig) % gsz); u.pn = (wgid % nig) / gsz; return true;
    }
};
struct BatchOrder {
    int n, G, c;
    __host__ __device__ void init(int n_, int G_, int c_) { n = n_; G = G_; c = c_; }
    __host__ __device__ bool next(int i, Unit& u) const { const long L = (long)i * G + c; if (L >= n) return false; u.pm = (int)L; u.pn = (int)(L >> 2); return true; }
};

__device__ __forceinline__ unsigned cvt_pk_bf16(float lo, float hi) { unsigned r; asm volatile("v_cvt_pk_bf16_f32 %0, %1, %2" : "=v"(r) : "v"(lo), "v"(hi)); return r; }
__device__ __forceinline__ u32x4 pack8(const f32x4 v0, const f32x4 v1) { u32x4 w; w.x = cvt_pk_bf16(v0[0], v0[1]); w.y = cvt_pk_bf16(v0[2], v0[3]); w.z = cvt_pk_bf16(v1[0], v1[1]); w.w = cvt_pk_bf16(v1[2], v1[3]); return w; }
__device__ __forceinline__ float fq_sum(float s) {
    auto a = __builtin_amdgcn_permlane16_swap(__float_as_uint(s), __float_as_uint(s), false, false); s = __uint_as_float(a[0]) + __uint_as_float(a[1]);
    auto b = __builtin_amdgcn_permlane32_swap(__float_as_uint(s), __float_as_uint(s), false, false); return __uint_as_float(b[0]) + __uint_as_float(b[1]); }
__device__ __forceinline__ float bf2f(unsigned short h) { return __uint_as_float(((unsigned)h) << 16); }
__device__ __forceinline__ float sq4(const f32x4 x) { return __builtin_fmaf(x[3], x[3], __builtin_fmaf(x[2], x[2], __builtin_fmaf(x[1], x[1], x[0] * x[0]))); }
__device__ __forceinline__ float sigmoid_f(float x) { return __builtin_amdgcn_rcpf(1.0f + __builtin_amdgcn_exp2f(-1.4426950408889634f * x)); }
__device__ __forceinline__ float gelu_tanh_f(float y) { const float a = y * (1.0f + 0.044715f * y * y) * (2.0f * 0.7978845608028654f); return y * sigmoid_f(a); }
constexpr float RMS_EPS = 1e-6f;

struct EpiQKV {
    static constexpr bool PERM = true, AFTER_DRAIN = false;
    bf16_t* Q; size_t kv_stride; PG8_LAS const float* gl;
    __device__ __forceinline__ void operator()(const f32x4 (&acc)[2][2][4][2], const Unit& u, int wr, int wc, int fr, int fq) const {
        const int t = u.pn >> 2;
        bf16_t* base = Q + (size_t)t * kv_stride;
        int row0 = u.pm * BM + wr * 64 + fr, col0 = (u.pn & 3) * BM + wc * 64 + 8 * fq;
        asm volatile("" : "+v"(row0), "+v"(col0));
        f32x4 g[2][2];
#pragma unroll
        for (int bj = 0; bj < 2; ++bj)
#pragma unroll
            for (int n = 0; n < 2; ++n) g[bj][n] = (f32x4){1.f, 1.f, 1.f, 1.f};
        if (t < 2) { PG8_LAS const float* gs = gl + 64 * t + 8 * fq;
#pragma unroll
            for (int bj = 0; bj < 2; ++bj)
#pragma unroll
                for (int n = 0; n < 2; ++n) g[bj][n] = *(PG8_LAS const f32x4*)(gs + 32 * bj + 4 * n); }
#pragma unroll
        for (int ai = 0; ai < 2; ++ai)
#pragma unroll
            for (int m = 0; m < 4; ++m) { bf16_t* rowp = base + (size_t)(row0 + ai * HALF + m * 16) * 1024 + col0;
                float r = 1.f;
                if (t < 2) { float s = (sq4(acc[ai][0][m][0]) + sq4(acc[ai][0][m][1])) + (sq4(acc[ai][1][m][0]) + sq4(acc[ai][1][m][1]));
                    s = fq_sum(s); r = __builtin_amdgcn_rsqf(s * (1.0f / 64.0f) + RMS_EPS); }
#pragma unroll
                for (int bj = 0; bj < 2; ++bj) *(u32x4*)(rowp + bj * 32) = pack8(acc[ai][bj][m][0] * r * g[bj][0], acc[ai][bj][m][1] * r * g[bj][1]); }
    }
};

__device__ __forceinline__ void unpack8(const u32x4 w, f32x4& v0, f32x4& v1) {
    v0[0] = __uint_as_float(w.x << 16); v0[1] = __uint_as_float(w.x & 0xffff0000u); v0[2] = __uint_as_float(w.y << 16); v0[3] = __uint_as_float(w.y & 0xffff0000u);
    v1[0] = __uint_as_float(w.z << 16); v1[1] = __uint_as_float(w.z & 0xffff0000u); v1[2] = __uint_as_float(w.w << 16); v1[3] = __uint_as_float(w.w & 0xffff0000u); }
struct EpiResid {
    static constexpr bool PERM = true, AFTER_DRAIN = false;
    const float* basef; const bf16_t* baseb; float* out; bf16_t* xb; float* rowss; const float* unss; const float* ung; const float* accss;
    __device__ __forceinline__ void operator()(const f32x4 (&acc)[2][2][4][2], const Unit& u, int wr, int wc, int fr, int fq) const {
        const int row0 = u.pm * BM + wr * 64 + fr, col0 = u.pn * BM + wc * 32 + 8 * fq;
        f32x4 ginv[2][2];
#pragma unroll
        for (int bj = 0; bj < 2; ++bj)
#pragma unroll
            for (int n = 0; n < 2; ++n) { ginv[bj][n] = (f32x4){1.f, 1.f, 1.f, 1.f}; if (unss) { const f32x4 gg = *(const f32x4*)(ung + col0 + bj * HALF + 4 * n);
#pragma unroll
                for (int i = 0; i < 4; ++i) ginv[bj][n][i] = __builtin_amdgcn_rcpf(gg[i]); } }
#pragma unroll
        for (int ai = 0; ai < 2; ++ai)
#pragma unroll
            for (int m = 0; m < 4; ++m) { const int row = row0 + ai * HALF + m * 16; const size_t off = (size_t)row * 1024 + col0; float sq = 0.f;
                const float asc = accss ? __builtin_amdgcn_rcpf(accss[row] * (1.0f / 1024.0f) + RMS_EPS) : 1.0f;
#pragma unroll
                for (int bj = 0; bj < 2; ++bj) {
                    f32x4 b0, b1;
                    if (basef) { b0 = *(const f32x4*)(basef + off + bj * HALF); b1 = *(const f32x4*)(basef + off + bj * HALF + 4); }
                    else { unpack8(*(const u32x4*)(baseb + off + bj * HALF), b0, b1);
                        if (unss) { const float ri = __builtin_amdgcn_sqrtf(unss[row] * (1.0f / 1024.0f) + RMS_EPS); b0 = b0 * ri * ginv[bj][0]; b1 = b1 * ri * ginv[bj][1]; } }
                    const f32x4 v0 = acc[ai][bj][m][0] * asc + b0, v1 = acc[ai][bj][m][1] * asc + b1;
                    if (out) { __builtin_nontemporal_store(v0, (f32x4*)(out + off + bj * HALF)); __builtin_nontemporal_store(v1, (f32x4*)(out + off + bj * HALF + 4)); }
                    if (xb) *(u32x4*)(xb + off + bj * HALF) = pack8(v0, v1);
                    sq += sq4(v0) + sq4(v1); }
                if (rowss) { sq = fq_sum(sq); if (fq == 0) atomicAdd(rowss + row, sq); } }
    }
};
struct EpiGlu {
    static constexpr bool PERM = true, AFTER_DRAIN = false;
    bf16_t* xb; float* rowss;
    __device__ __forceinline__ void operator()(const f32x4 (&acc)[2][2][4][2], const Unit& u, int wr, int wc, int fr, int fq) const {
        const int row0 = u.pm * BM + wr * 64 + fr, col0 = u.pn * HALF + wc * 32 + 8 * fq;
#pragma unroll
        for (int ai = 0; ai < 2; ++ai)
#pragma unroll
            for (int m = 0; m < 4; ++m) { const int row = row0 + ai * HALF + m * 16; const size_t off = (size_t)row * 1024 + col0;
                f32x4 v[2]; unpack8(*(const u32x4*)(xb + off), v[0], v[1]);
#pragma unroll
                for (int n = 0; n < 2; ++n) { const f32x4 val = acc[ai][0][m][n], gt = acc[ai][1][m][n];
#pragma unroll
                    for (int i = 0; i < 4; ++i) v[n][i] += val[i] * sigmoid_f(gt[i]); }
                *(u32x4*)(xb + off) = pack8(v[0], v[1]);
                float sq = sq4(v[0]) + sq4(v[1]);
                sq = fq_sum(sq); if (fq == 0) atomicAdd(rowss + row, sq); }
    }
};
struct EpiSqrelu {
    static constexpr bool PERM = true, AFTER_DRAIN = false;
    bf16_t* O; int ldc;
    __device__ __forceinline__ void operator()(const f32x4 (&acc)[2][2][4][2], const Unit& u, int wr, int wc, int fr, int fq) const {
        const int row0 = u.pm * BM + wr * 64 + fr, col0 = u.pn * BM + wc * 32 + 8 * fq;
#pragma unroll
        for (int ai = 0; ai < 2; ++ai)
#pragma unroll
            for (int m = 0; m < 4; ++m) { const int row = row0 + ai * HALF + m * 16;
                bf16_t* rowp = O + (size_t)row * ldc + col0;
#pragma unroll
                for (int bj = 0; bj < 2; ++bj) { f32x4 v0 = acc[ai][bj][m][0], v1 = acc[ai][bj][m][1];
#pragma unroll
                    for (int i = 0; i < 4; ++i) { const float a = fmaxf(v0[i], 0.f), b = fmaxf(v1[i], 0.f); v0[i] = a * a; v1[i] = b * b; }
                    *(u32x4*)(rowp + bj * HALF) = pack8(v0, v1); } }
    }
};
struct EpiU {
    static constexpr bool PERM = true, AFTER_DRAIN = false;
    bf16_t* AA; const float* rowss;
    __device__ __forceinline__ void operator()(const f32x4 (&acc)[2][2][4][2], const Unit& u, int wr, int wc, int fr, int fq) const {
        const int row0 = u.pm * BM + wr * 64 + fr, col0 = u.pn * BM + wc * 32 + 8 * fq;
#pragma unroll
        for (int ai = 0; ai < 2; ++ai)
#pragma unroll
            for (int m = 0; m < 4; ++m) { const int row = row0 + ai * HALF + m * 16; const float rs = __builtin_amdgcn_rsqf(rowss[row] * (1.0f / 1024.0f) + RMS_EPS);
                const int kc = row >> 4, s = row & 15;
#pragma unroll
                for (int bj = 0; bj < 2; ++bj) { const int n = col0 + bj * HALF, g = n >> 4, c0 = n & 15;
                    *(u32x4*)(AA + ((size_t)(g * 1024 + kc) * 384 + s * 16 + c0)) = pack8(acc[ai][bj][m][0] * rs, acc[ai][bj][m][1] * rs); } }
    }
};
struct EpiS {
    static constexpr bool PERM = true, AFTER_DRAIN = false;
    float* S;
    __device__ __forceinline__ void operator()(const f32x4 (&acc)[2][2][4][2], const Unit& u, int wr, int wc, int fr, int fq) const {
        const int row0 = u.pm * BM + wr * 64 + fr, col0 = wc * 32 + 8 * fq;
#pragma unroll
        for (int ai = 0; ai < 2; ++ai)
#pragma unroll
            for (int m = 0; m < 4; ++m) { float* p = S + (size_t)(row0 + ai * HALF + m * 16) * 128 + col0;
                *(f32x4*)p = acc[ai][0][m][0]; *(f32x4*)(p + 4) = acc[ai][0][m][1]; }
    }
};
constexpr int SL_PITCH = 132;
struct EpiSLds {
    static constexpr bool PERM = true, AFTER_DRAIN = true;
    PG8_LAS float* SL;
    __device__ __forceinline__ void operator()(const f32x4 (&acc)[2][2][4][2], const Unit& u, int wr, int wc, int fr, int fq) const {
        const int row0 = wr * 64 + fr, col0 = wc * 32 + 8 * fq;
#pragma unroll
        for (int ai = 0; ai < 2; ++ai)
#pragma unroll
            for (int m = 0; m < 4; ++m) { PG8_LAS float* p = SL + (row0 + ai * HALF + m * 16) * SL_PITCH + col0;
                *(PG8_LAS f32x4*)p = acc[ai][0][m][0]; *(PG8_LAS f32x4*)(p + 4) = acc[ai][0][m][1]; }
    }
};
struct EpiY {
    static constexpr bool PERM = true, AFTER_DRAIN = false;
    bf16_t* Z;
    __device__ __forceinline__ void operator()(const f32x4 (&acc)[2][2][4][2], const Unit& u, int wr, int wc, int fr, int fq) const {
        int row0 = u.pm * BM + wr * 64 + fr, n0 = wc * 32 + 8 * fq; const int g = u.pn;
        asm volatile("" : "+v"(row0), "+v"(n0));
#pragma unroll
        for (int ai = 0; ai < 2; ++ai)
#pragma unroll
            for (int m = 0; m < 4; ++m) { const int row = row0 + ai * HALF + m * 16, kc = row & 1023;
#pragma unroll
                for (int bj = 0; bj < 2; ++bj) { const int n = n0 + bj * HALF, j = n >> 4, c0 = n & 15, ch = 16 * g + c0;
                    f32x4 v0 = acc[ai][bj][m][0], v1 = acc[ai][bj][m][1];
#pragma unroll
                    for (int i = 0; i < 4; ++i) { v0[i] = gelu_tanh_f(v0[i]); v1[i] = gelu_tanh_f(v1[i]); }
                    *(u32x4*)(Z + (size_t)(kc * 16 + j) * 1024 + ch) = pack8(v0, v1); } }
    }
};

template <class Epi, class Sched>
__device__ __forceinline__ void gemm_phase(PG8_LAS unsigned char* lds, const Gemm g, const Sched& S, const Epi& E) {
    int tid_ = threadIdx.x; asm volatile("" : "+v"(tid_));
    const int tid = tid_, wid = __builtin_amdgcn_readfirstlane(tid >> 6), lane = tid & 63, wr = wid >> 2, wc = wid & 3, fr = lane & 15, fq = lane >> 4;
    const int K = g.K, nt = K / BK;
    unsigned voffA[2], voffB[2];
#pragma unroll
    for (int i = 0; i < 2; ++i) { int R, C; stage_rc(tid * 16 + i * 8192, R, C); const int Rb = Epi::PERM ? ((R & ~31) + perm32(R & 31)) : R;
        voffA[i] = (unsigned)(R * g.lda + C) * 2u; voffB[i] = (unsigned)(Rb * g.ldb + C) * 2u; }
    const size_t kstep = (size_t)(BK * 2);
    const size_t hA = (size_t)HALF * g.lda * 2, hB = (size_t)HALF * g.ldb * 2;
    const size_t tA = 2 * hA, tB = 2 * hB;
    const unsigned ldsw = (unsigned)wid * 1024u;
    const int aoff = lds_byte(wr * 64 + fr, fq * 8), boff = lds_byte(wc * 32 + fr, fq * 8);
#define PG8_SA(b, h) (((b) * 2 + (h)) * HTB)
#define PG8_SB(b, h) ((4 + (b) * 2 + (h)) * HTB)
#define PG8_STAGE(bufoff, gbase, voff) do { _Pragma("unroll") for (int _i = 0; _i < 2; ++_i) \
        __builtin_amdgcn_global_load_lds((const unsigned*)((const char*)(gbase) + (voff)[_i]), (PG8_LAS unsigned*)(lds + (bufoff) + ldsw + _i * 8192), 16, 0, 0); } while (0)
#define PG8_LDA(dst, b, h) do { _Pragma("unroll") for (int m = 0; m < 4; ++m) _Pragma("unroll") for (int k = 0; k < 2; ++k) dst[m][k] = *(const PG8_LAS bf16x8*)(lds + PG8_SA(b, h) + aoff + m * 2048 + k * 1024); } while (0)
#define PG8_LDB(dst, b, h) do { _Pragma("unroll") for (int n = 0; n < 2; ++n) _Pragma("unroll") for (int k = 0; k < 2; ++k) dst[n][k] = *(const PG8_LAS bf16x8*)(lds + PG8_SB(b, h) + boff + n * 2048 + k * 1024); } while (0)
#define PG8_MMA(ai, bj, At, Bt) do { __builtin_amdgcn_s_setprio(1); _Pragma("unroll") for (int m = 0; m < 4; ++m) _Pragma("unroll") for (int n = 0; n < 2; ++n) _Pragma("unroll") for (int k = 0; k < 2; ++k) \
        acc[ai][bj][m][n] = __builtin_amdgcn_mfma_f32_16x16x32_bf16(Bt[n][k], At[m][k], acc[ai][bj][m][n], 0, 0, 0); __builtin_amdgcn_s_setprio(0); } while (0)
#define PG8_WAIT_V(n) asm volatile("s_waitcnt vmcnt(" #n ")" ::: "memory")
#define PG8_WAIT_L(n) asm volatile("s_waitcnt lgkmcnt(" #n ")" ::: "memory")
#define PG8_BAR __builtin_amdgcn_s_barrier()
#define PG8_SCHED __builtin_amdgcn_sched_barrier(0)
    Unit cur, nxt; int ui = 0;
    if (!S.next(0, cur)) return;
    f32x4 acc[2][2][4][2];
#pragma unroll
    for (int a = 0; a < 2; ++a)
#pragma unroll
        for (int b = 0; b < 2; ++b)
#pragma unroll
            for (int m = 0; m < 4; ++m)
#pragma unroll
                for (int n = 0; n < 2; ++n) acc[a][b][m][n] = (f32x4){0.f, 0.f, 0.f, 0.f};
    bf16x8 At[4][2], B0[2][2], B1[2][2];
    const char* cA = (const char*)g.A + (size_t)cur.pm * tA; const char* cB = (const char*)g.Bt + (size_t)cur.pn * tB;
    PG8_STAGE(PG8_SB(0, 0), cB, voffB); PG8_STAGE(PG8_SB(0, 1), cB + hB, voffB); PG8_STAGE(PG8_SA(0, 0), cA, voffA); PG8_STAGE(PG8_SA(0, 1), cA + hA, voffA);
    if (wr == 1) PG8_BAR;
    PG8_WAIT_V(2); PG8_BAR;
    PG8_STAGE(PG8_SB(1, 0), cB + kstep, voffB); PG8_STAGE(PG8_SA(1, 0), cA + kstep, voffA); PG8_STAGE(PG8_SB(1, 1), cB + hB + kstep, voffB);
    PG8_WAIT_V(6); PG8_BAR;
    for (;;) {
        const bool has_next = S.next(ui + 1, nxt);
        const char* nA = has_next ? (const char*)g.A + (size_t)nxt.pm * tA : cA; const char* nB = has_next ? (const char*)g.Bt + (size_t)nxt.pn * tB : cB;
        for (int t = 0; t < nt; t += 2) {
            const bool last = (t == nt - 2);
            const char* a1 = cA + (size_t)(t + 1) * kstep;
            const char* a2 = last ? nA : cA + (size_t)(t + 2) * kstep; const char* b2 = last ? nB : cB + (size_t)(t + 2) * kstep;
            const char* a3 = a2 + kstep; const char* b3 = b2 + kstep;
            PG8_LDB(B0, 0, 0); PG8_LDB(B1, 0, 1); PG8_SCHED; PG8_LDA(At, 0, 0); PG8_STAGE(PG8_SA(1, 1), a1 + hA, voffA);
            PG8_WAIT_V(8); PG8_WAIT_L(0); PG8_BAR; PG8_MMA(0, 0, At, B0); PG8_MMA(0, 1, At, B1); PG8_BAR; PG8_SCHED;
            PG8_LDA(At, 0, 1); PG8_STAGE(PG8_SB(0, 0), b2, voffB); PG8_STAGE(PG8_SB(0, 1), b2 + hB, voffB); PG8_STAGE(PG8_SA(0, 0), a2, voffA);
            PG8_WAIT_V(8); PG8_WAIT_L(0); PG8_BAR; PG8_MMA(1, 0, At, B0); PG8_MMA(1, 1, At, B1); PG8_BAR; PG8_SCHED;
            PG8_LDB(B0, 1, 0); PG8_LDB(B1, 1, 1); PG8_SCHED; PG8_LDA(At, 1, 0); PG8_STAGE(PG8_SA(0, 1), a2 + hA, voffA);
            PG8_WAIT_V(8); PG8_WAIT_L(0); PG8_BAR; PG8_MMA(0, 0, At, B0); PG8_MMA(0, 1, At, B1); PG8_BAR; PG8_SCHED;
            PG8_LDA(At, 1, 1); PG8_STAGE(PG8_SB(1, 0), b3, voffB); PG8_STAGE(PG8_SB(1, 1), b3 + hB, voffB); PG8_STAGE(PG8_SA(1, 0), a3, voffA);
            PG8_WAIT_V(8); PG8_WAIT_L(0); PG8_BAR; PG8_MMA(1, 0, At, B0); PG8_MMA(1, 1, At, B1); PG8_BAR; PG8_SCHED;
        }
        if (wr == 0) PG8_BAR;
        if constexpr (!Epi::AFTER_DRAIN) E(acc, cur, wr, wc, fr, fq);
        if (!has_next) break;
#pragma unroll
        for (int a = 0; a < 2; ++a)
#pragma unroll
            for (int b = 0; b < 2; ++b)
#pragma unroll
                for (int m = 0; m < 4; ++m)
#pragma unroll
                    for (int n = 0; n < 2; ++n) acc[a][b][m][n] = (f32x4){0.f, 0.f, 0.f, 0.f};
        cur = nxt; cA = nA; cB = nB; ++ui;
        if (wr == 1) PG8_BAR;
    }
    PG8_WAIT_V(0);
    PG8_BAR;
    if constexpr (Epi::AFTER_DRAIN) E(acc, cur, wr, wc, fr, fq);
#undef PG8_SA
#undef PG8_SB
#undef PG8_STAGE
#undef PG8_LDA
#undef PG8_LDB
#undef PG8_MMA
#undef PG8_WAIT_V
#undef PG8_WAIT_L
#undef PG8_BAR
#undef PG8_SCHED
}
}

#include <hip/hip_bf16.h>
#include <cmath>
namespace attn_body {
using bf16=__hip_bfloat16;
using bf16x8=__attribute__((ext_vector_type(8)))short;
using s16x4=__attribute__((ext_vector_type(4)))short;
using f32x16=__attribute__((ext_vector_type(16)))float;
using u32x4=__attribute__((ext_vector_type(4)))unsigned;
constexpr int BATCH=4,NHEAD=16,SEQ=4096,D=64,DM=NHEAD*D;
constexpr int NW=8,QBLK=32,QB=QBLK*NW,KVBLK=64,NQB=SEQ/QB;
constexpr int ATTN_PITCH=DM, ATTN_UNIT_ROWS=QB;
__device__ __forceinline__ int crow(int r,int hi){return (r&3)+8*(r>>2)+4*hi;}
#define SBAR() __builtin_amdgcn_sched_barrier(0)
__device__ __forceinline__ void cmask(f32x16&p0,f32x16&p1,int jb,int qrel,int hi){
  const float NEG=-INFINITY; int kb=64*jb+4*hi;
  #pragma unroll
  for(int r=0;r<16;++r){int kv=kb+(r&3)+8*(r>>2); if(kv>qrel)p0[r]=NEG; if(kv+32>qrel)p1[r]=NEG;}
}

constexpr int NSLOT=3, SLOTB=8192;
constexpr int LDS_K=0, LDS_V=NSLOT*SLOTB, LDS_WS=2*NSLOT*SLOTB, LDS_OST=LDS_WS+NW*64*4, LDS_KBIAS=LDS_OST+NW*4096, LDS_BYTES=LDS_KBIAS+(SEQ+64)*4;
constexpr float C2=0.125f*1.4426950408889634f;
__device__ __forceinline__ void glds16(const void*gsrc,unsigned lds_dst){unsigned keep;
  asm volatile("s_mov_b32 %0, m0\n\ts_mov_b32 m0, %2\n\ts_nop 0\n\tglobal_load_lds_dwordx4 %1, off\n\ts_mov_b32 m0, %0":"=&s"(keep):"v"(gsrc),"s"(lds_dst):"memory");}
__device__ __forceinline__ float max3f(float a,float b,float c){float r;asm("v_max3_f32 %0, %1, %2, %3":"=v"(r):"v"(a),"v"(b),"v"(c));return r;}
__device__ __forceinline__ float max2f(float a,float b){float r;asm("v_max_f32_e32 %0, %1, %2":"=v"(r):"v"(a),"v"(b));return r;}
__device__ __forceinline__ float fadd_s(float a,float b){float r;asm("v_add_f32_e32 %0, %1, %2":"=v"(r):"v"(a),"v"(b));return r;}
__device__ __forceinline__ float fsub_s(float a,float b){float r;asm("v_sub_f32_e32 %0, %1, %2":"=v"(r):"v"(a),"v"(b));return r;}
typedef float f32x2_t __attribute__((ext_vector_type(2))); typedef __bf16 bf16x2_t __attribute__((ext_vector_type(2)));
__device__ __forceinline__ unsigned cvtpk_s(float lo,float hi){f32x2_t v={lo,hi};bf16x2_t b=__builtin_convertvector(v,bf16x2_t);return __builtin_bit_cast(unsigned,b);}
#define WAIT_BAR(N) asm volatile("s_waitcnt vmcnt(" #N ") lgkmcnt(0)\n\ts_barrier":::"memory")

__device__ __forceinline__ void qkt(f32x16&p0,f32x16&p1,const char*Kslot,const bf16x8*qr,int r32,int hi){
  const char*kb=Kslot+hi*1024+r32*16;
  #pragma unroll
  for(int d0=0;d0<4;++d0){
    const bf16x8 b0=*reinterpret_cast<const bf16x8*>(kb+d0*2048);
    const bf16x8 b1=*reinterpret_cast<const bf16x8*>(kb+d0*2048+512);
    {p0=__builtin_amdgcn_mfma_f32_32x32x16_bf16(b0,qr[d0],p0,0,0,0);p1=__builtin_amdgcn_mfma_f32_32x32x16_bf16(b1,qr[d0],p1,0,0,0);}}
}
typedef __attribute__((address_space(3))) const char* lds_cptr;
typedef short v4i16_t __attribute__((ext_vector_type(4)));
__device__ __forceinline__ void kload8(bf16x8*kf,lds_cptr kp){
  kf[0]=*(const __attribute__((address_space(3))) bf16x8*)(kp);      kf[1]=*(const __attribute__((address_space(3))) bf16x8*)(kp+512);
  kf[2]=*(const __attribute__((address_space(3))) bf16x8*)(kp+2048); kf[3]=*(const __attribute__((address_space(3))) bf16x8*)(kp+2560);
  kf[4]=*(const __attribute__((address_space(3))) bf16x8*)(kp+4096); kf[5]=*(const __attribute__((address_space(3))) bf16x8*)(kp+4608);
  kf[6]=*(const __attribute__((address_space(3))) bf16x8*)(kp+6144); kf[7]=*(const __attribute__((address_space(3))) bf16x8*)(kp+6656);
}
__device__ __forceinline__ void kload2(bf16x8*kf,lds_cptr kp,int j){ kf[2*j]=*(const __attribute__((address_space(3))) bf16x8*)(kp+j*2048); kf[2*j+1]=*(const __attribute__((address_space(3))) bf16x8*)(kp+j*2048+512); }
__device__ __forceinline__ s16x4 vtr(lds_cptr p){ return __builtin_bit_cast(s16x4,__builtin_amdgcn_ds_read_tr16_b64_v4i16((__attribute__((address_space(3))) v4i16_t*)p)); }
__device__ __forceinline__ float rowmax(const f32x16&p0,const f32x16&p1){
  float a=max3f(p0[0],p0[1],p1[0]),b=max3f(p0[2],p0[3],p1[1]);a=max3f(a,p1[2],p1[3]);
  #pragma unroll
  for(int r=4;r<16;r+=4){a=max3f(a,p0[r],p0[r+1]);b=max3f(b,p0[r+2],p0[r+3]);a=max3f(a,p1[r],p1[r+1]);b=max3f(b,p1[r+2],p1[r+3]);}
  const float m=max2f(a,b);
  auto rr=__builtin_amdgcn_permlane32_swap(__float_as_uint(m),__float_as_uint(m),false,false);
  return max2f(__uint_as_float(rr[0]),__uint_as_float(rr[1]));
}
__device__ __forceinline__ void pv(f32x16*o,int vb,bf16x8 pa0,bf16x8 pa1,bf16x8 pa2,bf16x8 pa3){
  #pragma unroll
  for(int d0=0;d0<2;++d0){s16x4 lo[4],hi[4];
    #pragma unroll
    for(int ks=0;ks<4;++ks){
      asm volatile("ds_read_b64_tr_b16 %0,%1 offset:%c2":"=&v"(lo[ks]):"v"(vb),"i"(d0*4096+ks*1024):"memory");
      asm volatile("ds_read_b64_tr_b16 %0,%1 offset:%c2":"=&v"(hi[ks]):"v"(vb),"i"(d0*4096+ks*1024+512):"memory");}
    asm volatile("s_waitcnt lgkmcnt(0)":::"memory");SBAR();
    #define PK(k) (bf16x8){lo[k][0],lo[k][1],lo[k][2],lo[k][3],hi[k][0],hi[k][1],hi[k][2],hi[k][3]}
    o[d0]=__builtin_amdgcn_mfma_f32_32x32x16_bf16(pa0,PK(0),o[d0],0,0,0);
    o[d0]=__builtin_amdgcn_mfma_f32_32x32x16_bf16(pa1,PK(1),o[d0],0,0,0);
    o[d0]=__builtin_amdgcn_mfma_f32_32x32x16_bf16(pa2,PK(2),o[d0],0,0,0);
    o[d0]=__builtin_amdgcn_mfma_f32_32x32x16_bf16(pa3,PK(3),o[d0],0,0,0);
    #undef PK
  }
}

#ifndef ATTN_STORE16
#define ATTN_STORE16(p,v) (*(u32x4*)(p)=(v))
#endif
template<int THRL> __device__ __forceinline__ void attn_unit(int b,int h,int qb,const bf16*Q,const bf16*__restrict__ K,const bf16*__restrict__ V,bf16*O,const float*__restrict__ KBg,const float skip_thr,char*shm){
  int tid_=threadIdx.x; asm volatile("":"+v"(tid_)); const int tid=tid_,lane=tid&63,r32=lane&31,hi=lane>>5; const int wid=__builtin_amdgcn_readfirstlane(tid>>6);
  const long rowbase=(long)b*SEQ; const int q0=qb*QB;
  const bf16*Qw=Q+(rowbase+q0+wid*QBLK)*DM+h*D;
  const int NTF=(q0+QB)/KVBLK; int t0=0;
  { const float*kbg=KBg+(long)(b*NHEAD+h)*SEQ; const float kq=kbg[q0]; bool sk=false; if(lane<NTF-4) sk=(kq-kbg[64*lane+63])>skip_thr;
    const unsigned long long mk=__ballot(sk); t0=(mk==~0ull)?64:__builtin_ctzll(~mk); t0&=~1; if(t0>NTF-4)t0=NTF-4; t0=__builtin_amdgcn_readfirstlane(t0); }
  const bf16*Kh=K+(rowbase+(long)t0*KVBLK)*DM+h*D,*Vh=V+(rowbase+(long)t0*KVBLK)*DM+h*D;
  const lds_cptr shm3=(lds_cptr)shm;
  const unsigned lds0=(unsigned)(uintptr_t)shm;
  float*wsf=(float*)(shm+LDS_WS)+wid*64;
  const bf16*ksrc=Kh+(long)lane*DM+wid*8;
  const bf16*vsrc=Vh+(long)(16*(wid&3)+(lane>>2))*DM+(wid>>2)*32+(lane&3)*8;
  const unsigned kdst=lds0+LDS_K+wid*1024, vdst=lds0+LDS_V+wid*1024;
  #define DMA_K(t,slot) glds16(ksrc+(long)(t)*KVBLK*DM,(unsigned)__builtin_amdgcn_readfirstlane(kdst+(slot)))
  #define DMA_V(t,slot) glds16(vsrc+(long)(t)*KVBLK*DM,(unsigned)__builtin_amdgcn_readfirstlane(vdst+(slot)))
  const int vb0=(int)(lds0+LDS_V)+((lane>>4)&1)*32+(lane&3)*8+(4*hi+((lane&15)>>2))*64;
  const char*Kbase=shm+LDS_K; bf16x8 kf[8];
  const lds_cptr kp0=shm3+LDS_K+hi*1024+r32*16; const lds_cptr vp0=shm3+LDS_V+((lane>>4)&1)*32+(lane&3)*8+(4*hi+((lane&15)>>2))*64;
  const int NT=NTF-t0;
  DMA_K(0,0);DMA_V(0,0);DMA_K(1,SLOTB);
  typedef __attribute__((address_space(3))) float* lds_fptr; typedef float f32x4_t __attribute__((ext_vector_type(4)));
  const lds_fptr kbL=(lds_fptr)(shm3+LDS_KBIAS);
  { const float*kbsrc=KBg+(long)(b*NHEAD+h)*SEQ+64*t0; int i0_=4*tid; asm volatile("":"+v"(i0_));   for(int i=i0_;i<64*NT;i+=4*NW*64) *(__attribute__((address_space(3))) f32x4_t*)(kbL+i)=*(const f32x4_t*)(kbsrc+i); }
  #define KBLOAD(P0,P1,t) do{ int h4_=4*hi; asm volatile("":"+v"(h4_));   const lds_fptr kq_=kbL+64*(t)+h4_; _Pragma("unroll") for(int i_=0;i_<4;++i_){ const f32x4_t a_=*(const __attribute__((address_space(3))) f32x4_t*)(kq_+8*i_); const f32x4_t b_=*(const __attribute__((address_space(3))) f32x4_t*)(kq_+32+8*i_); \
      P0[4*i_]=a_[0];P0[4*i_+1]=a_[1];P0[4*i_+2]=a_[2];P0[4*i_+3]=a_[3]; P1[4*i_]=b_[0];P1[4*i_+1]=b_[1];P1[4*i_+2]=b_[2];P1[4*i_+3]=b_[3]; } }while(0)
  bf16x8 qr[4];
  #pragma unroll
  for(int d0=0;d0<4;++d0)qr[d0]=*reinterpret_cast<const bf16x8*>(&Qw[(long)r32*DM+d0*16+hi*8]);
  float mhat=0.f,l_reg=0.f;f32x16 o[2];o[0]=f32x16{};o[1]=f32x16{};
  const int qrel=wid*QBLK+r32;
  #define CMASK(P0,P1,t) do{int jb_=(t)-(NT-4); if(jb_>=0)cmask(P0,P1,jb_,qrel,hi);}while(0)
  bool resc=false;
  #define START(P0,P1) do{ const float rm=rowmax(P0,P1); resc=false; \
    { const float dl=rm; mhat=fadd_s(mhat,dl); \
      _Pragma("unroll") for(int r=0;r<16;++r){P0[r]=fsub_s(P0[r],dl);P1[r]=fsub_s(P1[r],dl);} } \
    _Pragma("unroll") for(int r=0;r<16;++r)P0[r]=__builtin_amdgcn_exp2f(P0[r]); }while(0)
  #define RESC() do{ if(resc){ asm volatile("s_waitcnt lgkmcnt(0)":::"memory"); \
      _Pragma("unroll") for(int d_=0;d_<2;++d_) _Pragma("unroll") for(int r=0;r<16;++r)o[d_][r]*=wsf[crow(r,hi)]; } }while(0)
  f32x16 pA0,pA1,pB0,pB1;
  int sl_prev=0,sl_cur=0,sl_next=SLOTB;
  #define ROT() do{sl_prev=sl_cur;sl_cur=sl_next;sl_next=(sl_next==(NSLOT-1)*SLOTB)?0:sl_next+SLOTB;}while(0)
  DMA_K(2,2*SLOTB);
  WAIT_BAR(3);
  KBLOAD(pA0,pA1,0);
  qkt(pA0,pA1,Kbase,qr,r32,hi);asm volatile("s_nop 15\n\ts_nop 7":"+v"(pA0),"+v"(pA1));CMASK(pA0,pA1,0);
  START(pA0,pA1);
  KBLOAD(pB0,pB1,1);
  _Pragma("unroll") for(int r=0;r<16;++r){pB0[r]-=mhat;pB1[r]-=mhat;}
  _Pragma("unroll") for(int r=0;r<16;++r)pA1[r]=__builtin_amdgcn_exp2f(pA1[r]);
  WAIT_BAR(0);
  DMA_K(3,0);DMA_V(1,SLOTB);
  ROT();
  kload8(kf,kp0+sl_cur);
  WAIT_BAR(2);
  s16x4 vlo[8],vhi[8]; u32x4 pw0,pw1,pw2,pw3;
  #define PKW(P,B) cvtpk_s(P[B],P[B+1])
  #define PAF(k) __builtin_bit_cast(bf16x8,pw##k)
  #define VFR(i) (bf16x8){vlo[i][0],vlo[i][1],vlo[i][2],vlo[i][3],vhi[i][0],vhi[i][1],vhi[i][2],vhi[i][3]}
  #define PIN(x) asm volatile("":"+v"(x))
  #define MX3(a,b,c) __builtin_fmaxf(__builtin_fmaxf((a),(b)),(c))
  #define GAPA(MF,A0,A1,A2,A3,W0,W1,PW) do{ MF; sacc+=A0; sacc+=A1; sacc+=A2; sacc+=A3; PIN(sacc); W0; W1; PIN(PW); SBAR(); }while(0)
  #define EX(v) __builtin_amdgcn_exp2f(v)
  #define GAPB(MF,X,B) do{ MF; X[B]=EX(X[B]); X[B+1]=EX(X[B+1]); X[B+2]=EX(X[B+2]); X[B+3]=EX(X[B+3]); PIN(X); SBAR(); }while(0)
  #define VRD(i) do{ vlo[i]=vtr(vp_+(((i)>>2)*4096+((i)&3)*1024)); vhi[i]=vtr(vp_+(((i)>>2)*4096+((i)&3)*1024+512)); }while(0)
  #define KRD(G,j) do{ if(G){ kload2(kf,kp0+sl_next,j); SBAR(); } }while(0)
  #define NB(G,Y,B) do{ if(G){ Y[B]-=mhat; Y[B+1]-=mhat; Y[B+2]-=mhat; Y[B+3]-=mhat; PIN(Y); SBAR(); } }while(0)
  #define STEP(C0,C1,P0,P1,t,GK,GV,GL,GN) do{ SBAR(); \
    const lds_cptr vp_=vp0+sl_prev; \
    VRD(0); SBAR(); float sacc=(P0[0]+P0[1]); \
    GAPA(C0=__builtin_amdgcn_mfma_f32_32x32x16_bf16(kf[0],qr[0],C0,0,0,0), P0[2],P0[3],P0[4],P0[5],     pw0[0]=PKW(P0,0), pw0[1]=PKW(P0,2), pw0); \
    VRD(4); SBAR(); GAPA(C1=__builtin_amdgcn_mfma_f32_32x32x16_bf16(kf[1],qr[0],C1,0,0,0), P0[6],P0[7],P0[8],P0[9],     pw0[2]=PKW(P0,4), pw0[3]=PKW(P0,6), pw0); \
    VRD(1); SBAR(); GAPA(C0=__builtin_amdgcn_mfma_f32_32x32x16_bf16(kf[2],qr[1],C0,0,0,0),   P0[10],P0[11],P0[12],P0[13], pw1[0]=PKW(P0,8), pw1[1]=PKW(P0,10), pw1); \
    VRD(5); SBAR(); GAPA(C1=__builtin_amdgcn_mfma_f32_32x32x16_bf16(kf[3],qr[1],C1,0,0,0),   P0[14],P0[15],P1[0],P1[1],   pw1[2]=PKW(P0,12),pw1[3]=PKW(P0,14), pw1); \
    VRD(2); SBAR(); GAPA(C0=__builtin_amdgcn_mfma_f32_32x32x16_bf16(kf[4],qr[2],C0,0,0,0),   P1[2],P1[3],P1[4],P1[5],     pw2[0]=PKW(P1,0), pw2[1]=PKW(P1,2), pw2); \
    VRD(6); SBAR(); GAPA(C1=__builtin_amdgcn_mfma_f32_32x32x16_bf16(kf[5],qr[2],C1,0,0,0),   P1[6],P1[7],P1[8],P1[9],     pw2[2]=PKW(P1,4), pw2[3]=PKW(P1,6), pw2); \
    VRD(3); SBAR(); GAPA(C0=__builtin_amdgcn_mfma_f32_32x32x16_bf16(kf[6],qr[3],C0,0,0,0),   P1[10],P1[11],P1[12],P1[13], pw3[0]=PKW(P1,8), pw3[1]=PKW(P1,10), pw3); \
    VRD(7); SBAR(); GAPA(C1=__builtin_amdgcn_mfma_f32_32x32x16_bf16(kf[7],qr[3],C1,0,0,0),   P1[14],P1[15],0.f,0.f,       pw3[2]=PKW(P1,12),pw3[3]=PKW(P1,14), pw3); \
    l_reg+=sacc; \
    if(GK){DMA_K((t)+3,sl_cur);} if(GV){DMA_V((t)+1,sl_next);} \
    CMASK(C0,C1,t); \
    { float a=MX3(C0[0],C0[1],C1[0]),b=MX3(C0[2],C0[3],C1[1]); a=MX3(a,C1[2],C1[3]); \
      _Pragma("unroll") for(int r=4;r<16;r+=4){a=MX3(a,C0[r],C0[r+1]);b=MX3(b,C0[r+2],C0[r+3]);a=MX3(a,C1[r],C1[r+1]);b=MX3(b,C1[r+2],C1[r+3]);} \
      float rm=__builtin_fmaxf(a,b); { auto rr=__builtin_amdgcn_permlane32_swap(__float_as_uint(rm),__float_as_uint(rm),false,false); rm=__builtin_fmaxf(__uint_as_float(rr[0]),__uint_as_float(rr[1])); } \
      resc=false; \
      if(__builtin_expect(__any(rm>(float)THRL),0)){ const float dl=__builtin_fmaxf(rm,0.f); mhat+=dl; \
        _Pragma("unroll") for(int r=0;r<16;++r){C0[r]-=dl;C1[r]-=dl;} \
        const float f=__builtin_amdgcn_exp2f(-dl); l_reg*=f; if(hi==0)wsf[r32]=f; resc=true; } } \
    if(GN){ KBLOAD(P0,P1,(t)+1); } \
    SBAR(); \
    GAPB(o[0]=__builtin_amdgcn_mfma_f32_32x32x16_bf16(PAF(0),VFR(0),o[0],0,0,0), C0,0); NB(GN,P0,0); \
    GAPB(o[1]=__builtin_amdgcn_mfma_f32_32x32x16_bf16(PAF(0),VFR(4),o[1],0,0,0), C0,4); NB(GN,P0,4); \
    KRD(GL,0); GAPB(o[0]=__builtin_amdgcn_mfma_f32_32x32x16_bf16(PAF(1),VFR(1),o[0],0,0,0), C0,8); NB(GN,P0,8); \
    KRD(GL,1); GAPB(o[1]=__builtin_amdgcn_mfma_f32_32x32x16_bf16(PAF(1),VFR(5),o[1],0,0,0), C0,12); NB(GN,P0,12); \
    KRD(GL,2); GAPB(o[0]=__builtin_amdgcn_mfma_f32_32x32x16_bf16(PAF(2),VFR(2),o[0],0,0,0), C1,0); NB(GN,P1,0); \
    KRD(GL,3); GAPB(o[1]=__builtin_amdgcn_mfma_f32_32x32x16_bf16(PAF(2),VFR(6),o[1],0,0,0), C1,4); NB(GN,P1,4); \
    GAPB(o[0]=__builtin_amdgcn_mfma_f32_32x32x16_bf16(PAF(3),VFR(3),o[0],0,0,0), C1,8); NB(GN,P1,8); \
    GAPB(o[1]=__builtin_amdgcn_mfma_f32_32x32x16_bf16(PAF(3),VFR(7),o[1],0,0,0), C1,12); NB(GN,P1,12); \
    }while(0)
  int t=1;
  #undef CMASK
  #define CMASK(P0,P1,t) do{}while(0)
  for(;t+5<NT;t+=2){
    STEP(pB0,pB1,pA0,pA1,t,true,true,true,true);     WAIT_BAR(2); RESC(); ROT();
    STEP(pA0,pA1,pB0,pB1,t+1,true,true,true,true);   WAIT_BAR(2); RESC(); ROT();
  }
  #undef CMASK
  #define CMASK(P0,P1,t) do{int jb_=(t)-(NT-4); if(jb_>=0)cmask(P0,P1,jb_,qrel,hi);}while(0)
  #define ENDW(tt) do{ if((tt)+3<NT){WAIT_BAR(2);} else if((tt)+2<NT){WAIT_BAR(1);} else {WAIT_BAR(0);} }while(0)
  for(;t+1<NT;t+=2){
    STEP(pB0,pB1,pA0,pA1,t,(t+3<NT),(t+1<NT),(t+1<NT),(t+1<NT));       ENDW(t);   RESC(); ROT();
    STEP(pA0,pA1,pB0,pB1,t+1,(t+4<NT),(t+2<NT),(t+2<NT),(t+2<NT));     ENDW(t+1); RESC(); ROT();
  }
  STEP(pB0,pB1,pA0,pA1,NT-1,false,false,false,false); RESC();
  { float sacc=pB0[0]+pB0[1]; _Pragma("unroll") for(int r=2;r<16;++r)sacc+=pB0[r]; _Pragma("unroll") for(int r=0;r<16;++r)sacc+=pB1[r]; l_reg+=sacc;
    pw0=(u32x4){PKW(pB0,0),PKW(pB0,2),PKW(pB0,4),PKW(pB0,6)};pw1=(u32x4){PKW(pB0,8),PKW(pB0,10),PKW(pB0,12),PKW(pB0,14)};pw2=(u32x4){PKW(pB1,0),PKW(pB1,2),PKW(pB1,4),PKW(pB1,6)};pw3=(u32x4){PKW(pB1,8),PKW(pB1,10),PKW(pB1,12),PKW(pB1,14)};
    SBAR(); pv(o,vb0+sl_cur,PAF(0),PAF(1),PAF(2),PAF(3)); }
  #undef PKW
  #undef PAF
  #undef VFR
  #undef PIN
  #undef MX3
  #undef GAPA
  #undef GAPB
  #undef EX
  #undef VRD
  #undef KRD
  #undef NB
  #undef KBLOAD
  #undef STEP
  #undef ENDW
  {auto rr=__builtin_amdgcn_permlane32_swap(__float_as_uint(l_reg),__float_as_uint(l_reg),false,false);l_reg=__uint_as_float(rr[0])+__uint_as_float(rr[1]);}
  if(hi==0)wsf[32+r32]=l_reg;asm volatile("s_waitcnt lgkmcnt(0)":::"memory");
  float rli[16];
  #pragma unroll
  for(int r=0;r<16;++r)rli[r]=__builtin_amdgcn_rcpf(wsf[32+crow(r,hi)]);
  bf16*Ow=O+(rowbase+q0+wid*QBLK)*DM+h*D;
  { bf16*stg=(bf16*)(shm+LDS_OST)+wid*2048;
    #pragma unroll
    for(int r=0;r<16;++r){const int orow=crow(r,hi);
      #pragma unroll
      for(int d0=0;d0<2;++d0)stg[orow*64+d0*32+r32]=__float2bfloat16(o[d0][r]*rli[r]);}
    asm volatile("s_waitcnt lgkmcnt(0)":::"memory");
    #pragma unroll
    for(int i=0;i<4;++i){const int row=i*8+(lane>>3),ch=lane&7; const u32x4 v=*(const u32x4*)(stg+row*64+ch*8); ATTN_STORE16(Ow+(long)row*DM+ch*8,v);} }
  asm volatile("s_waitcnt lgkmcnt(0)\n\ts_barrier":::"memory");
  #undef DMA_K
  #undef DMA_V
  #undef CMASK
  #undef START
  #undef RESC
  #undef ROT
}
constexpr int ATTN_LDS_BYTES=LDS_BYTES;
struct AttnTensors { const bf16* Q; const bf16* K; const bf16* V; bf16* O; const float* KB; const float* qg; const float* kg; };
struct AttnUnit { int bh; int qb; };
struct StaticOrder {
  int vcu;
  __device__ __forceinline__ explicit StaticOrder(int grid,int block):vcu((block%8)*(grid/8)+block/8){}
  __device__ __forceinline__ bool next(int i,AttnUnit&u)const{ if(i>=4)return false; const int s=vcu&3; u.bh=vcu>>2; u.qb=(i==0)?s:(i==1)?7-s:(i==2)?8+s:15-s; return true; }
  __device__ __forceinline__ void a_ready(const AttnUnit&)const{}
  __device__ __forceinline__ void done(const AttnUnit&)const{}
};
__device__ __forceinline__ int attn_ticket(unsigned*ctr,unsigned myx){
  for(unsigned k=0;k<8;++k){ const unsigned q=(myx+k)&7u; const unsigned m=atomicAdd(ctr+64*q,1u); if(m<128u) return (int)(q*128u+m); }
  return -1;
}
template<class Sched,int THRL=60> __device__ __forceinline__ void attn_phase(char*lds,const AttnTensors&T,const Sched&S,unsigned*ctr,volatile __attribute__((address_space(3))) unsigned*slot,unsigned myx){
  float thr; { const int l=threadIdx.x&63; float a=fabsf(T.qg[l]),c=fabsf(T.kg[l]);
    for(int o=1;o<64;o<<=1){a=fmaxf(a,__shfl_xor(a,o));c=fmaxf(c,__shfl_xor(c,o));}
    thr=2.0f*(1.05f*a*c*64.0f*C2)+40.0f; }
  if(threadIdx.x==0) slot[0]=(unsigned)attn_ticket(ctr,myx);
  __syncthreads();
  int n=(int)slot[0];
  while(n>=0){
    int pre=-1; if(threadIdx.x==0) pre=attn_ticket(ctr,myx);
    const int m=n&127, bh=8*(n>>7)+(m&7);
    attn_unit<THRL>(bh/NHEAD,bh%NHEAD,(NQB-1)-(m>>3),T.Q,T.K,T.V,T.O,T.KB,thr,lds);
    if(threadIdx.x==0) slot[0]=(unsigned)pre;
    __syncthreads();
    n=(int)slot[0];
  }
}
#undef SBAR
#undef WAIT_BAR
}

constexpr int NWAVES = 8;
constexpr int BATCH = 4, SEQ = 4096, D = 1024, H = 16, HD = 64, FF = 4096;
constexpr int M = BATCH * SEQ;
constexpr int NQKV = 3 * D, WIN_LD = 3 * D + H;
constexpr int NG = 64, NP = 64, NC = 16, LCH = 16, NCHUNK = M / LCH  , KA = LCH * NC + 2 * NP  ;

constexpr size_t MiB = 1u << 20;
constexpr size_t WS_CTL = 0;
constexpr size_t WS_BAR = 256 * 1024;
constexpr size_t WS_LAMT = 3 * MiB;
constexpr size_t WS_LF = 1 * MiB, WS_KB = 2 * MiB;
constexpr size_t WS_WQKV = 4 * MiB, WS_WO = 10 * MiB, WS_W1A = 12 * MiB, WS_W2A = 20 * MiB, WS_W1B = 28 * MiB, WS_W2B = 36 * MiB, WS_WSSM = 44 * MiB, WS_WGLU = 46 * MiB;
constexpr size_t WS_BT3 = 50 * MiB, WS_WT1 = 62 * MiB;
constexpr size_t WS_XN = 70 * MiB;
constexpr size_t WS_QO = 102 * MiB, WS_K = 134 * MiB, WS_V = 166 * MiB;
constexpr size_t WS_O = 198 * MiB;
constexpr size_t WS_H = 102 * MiB;
constexpr size_t WS_AALL = 102 * MiB, WS_SBUF = 150 * MiB, WS_Z = 182 * MiB;
constexpr size_t WS_END = 230 * MiB;

constexpr int RING_OFF = 0, RING_BYTES = 131072;
constexpr int XCH_OFF = RING_BYTES;
constexpr int MISC_OFF = XCH_OFF + 8192;
constexpr int LDS_BYTES = 147456;

#define GAS __attribute__((address_space(1)))
#define LAS __attribute__((address_space(3)))
typedef unsigned short bf16;
typedef unsigned v4u __attribute__((ext_vector_type(4)));
typedef float f32x4 __attribute__((ext_vector_type(4)));
#define LDS_WAIT() asm volatile("s_waitcnt lgkmcnt(0)" ::: "memory")
__device__ __forceinline__ unsigned f2bf(float f) { unsigned u = __builtin_bit_cast(unsigned, f); return (u + 0x7fffu + ((u >> 16) & 1u)) >> 16; }
__device__ __forceinline__ unsigned pk2(float lo, float hi) { unsigned r; asm("v_cvt_pk_bf16_f32 %0, %1, %2" : "=v"(r) : "v"(lo), "v"(hi)); return r; }
__device__ __forceinline__ float wave_sum(float v) {
#pragma unroll
    for (int o = 1; o < 64; o <<= 1) v += __shfl_xor(v, o);
    return v;
}
__device__ __forceinline__ void sincos_d(double a, double& s, double& c) {
    const double k = rint(a * 0.63661977236758134308);
    double r = fma(-k, 1.57079632679489655800e+00, a); r = fma(-k, 6.12323399573676603587e-17, r);
    const int q = ((int)k) & 3;
    const double r2 = r * r;
    const double sp = r * (1.0 + r2 * (-1.0 / 6 + r2 * (1.0 / 120 + r2 * (-1.0 / 5040 + r2 * (1.0 / 362880 + r2 * (-1.0 / 39916800 + r2 * (1.0 / 6227020800.0)))))));
    const double cp = 1.0 + r2 * (-0.5 + r2 * (1.0 / 24 + r2 * (-1.0 / 720 + r2 * (1.0 / 40320 + r2 * (-1.0 / 3628800 + r2 * (1.0 / 479001600.0 + r2 * (-1.0 / 87178291200.0)))))));
    s = (q == 0) ? sp : (q == 1) ? cp : (q == 2) ? -sp : -cp;
    c = (q == 0) ? cp : (q == 1) ? -sp : (q == 2) ? -cp : sp;
}

#define XB_TMO      128
#define XB_XCNT(j)  (256  + 64 * (j))
#define XB_XSUB(j)  (1280 + 64 * (j))
#define XB_XGEN(j)  (2304 + 64 * (j))
#define XB_TOP      3328
#define XB_TOPGEN   3392
#define XCD_BAR_WORDS 3456
#define XB_SPIN_CAP (1u << 18)

__device__ __forceinline__ unsigned xb_ld(unsigned* p)              { return __hip_atomic_load(p, __ATOMIC_RELAXED, __HIP_MEMORY_SCOPE_AGENT); }
__device__ __forceinline__ unsigned xb_add(unsigned* p, unsigned v) { return __hip_atomic_fetch_add(p, v, __ATOMIC_RELAXED, __HIP_MEMORY_SCOPE_AGENT); }
__device__ __forceinline__ unsigned xb_xcc_id() { return (unsigned)__builtin_amdgcn_s_getreg((3 << 11) | 20) & 0xFu; }
#define XB_SPIN(cond, bar) do { unsigned _sp = 0; while (cond) { __builtin_amdgcn_s_sleep(1); \
    if ((++_sp & 255u) == 0u) { if (xb_ld(&(bar)[XB_TMO])) break; if (_sp > XB_SPIN_CAP) { atomicAdd(&(bar)[XB_TMO], 1u); break; } } } } while (0)

struct XcdBarrier {
    unsigned* bar; unsigned x;
    volatile LAS unsigned* st;
};

__device__ __forceinline__ XcdBarrier xcd_barrier_post(unsigned* bar, volatile LAS unsigned* st) {
    XcdBarrier b; b.bar = bar; b.x = xb_xcc_id(); b.st = st;
    if (threadIdx.x == 0) (void)xb_add(&bar[XB_XCNT(b.x)], 1u);
    return b;
}
__device__ __forceinline__ void xcd_barrier_complete(unsigned* bar, unsigned x, unsigned& nloc, unsigned& nx) {
    const unsigned G = gridDim.x * gridDim.y * gridDim.z;
    unsigned sum, cnt, mine, sp = 0u;
    for (;;) {
        sum = 0u; cnt = 0u; mine = 0u;
#pragma unroll
        for (unsigned j = 0; j < 16; ++j) { const unsigned c = xb_ld(&bar[XB_XCNT(j)]); sum += c; cnt += (c > 0u) ? 1u : 0u; mine = (j == x) ? c : mine; }
        if (sum == G) break;
        __builtin_amdgcn_s_sleep(1);
        if ((++sp & 255u) == 0u) { if (xb_ld(&bar[XB_TMO])) break; if (sp > XB_SPIN_CAP) { atomicAdd(&bar[XB_TMO], 1u); break; } }
    }
    nloc = mine > 0u ? mine : 1u; nx = cnt > 0u ? cnt : 1u;
}

__device__ __forceinline__ void xcd_barrier(const XcdBarrier& b) {
    asm volatile("s_waitcnt vmcnt(0)" ::: "memory");
    __syncthreads();
    if (threadIdx.x == 0) {
        unsigned* bar = b.bar;
        __builtin_amdgcn_s_waitcnt(0);
        unsigned nloc = b.st[0], nx = b.st[1];
        if (nloc == 0u) { xcd_barrier_complete(bar, b.x, nloc, nx); b.st[0] = nloc; b.st[1] = nx; }
        const unsigned old = xb_add(&bar[XB_XSUB(b.x)], 1u);
        const unsigned gen = old / nloc;
        if (old + 1u == (gen + 1u) * nloc) {
            __builtin_amdgcn_fence(__ATOMIC_RELEASE, "agent");
            asm volatile("s_waitcnt vmcnt(0)" ::: "memory");
            const unsigned og = xb_add(&bar[XB_TOP], 1u);
            const unsigned tg = og / nx;
            if (og + 1u == (tg + 1u) * nx) xb_add(&bar[XB_TOPGEN], 1u);
            else XB_SPIN(xb_ld(&bar[XB_TOPGEN]) == tg, bar);
            __builtin_amdgcn_fence(__ATOMIC_ACQUIRE, "agent");
            xb_add(&bar[XB_XGEN(b.x)], 1u);
            asm volatile("s_waitcnt vmcnt(0)" ::: "memory");
        } else {
            XB_SPIN(xb_ld(&bar[XB_XGEN(b.x)]) == gen, bar);
            __builtin_amdgcn_fence(__ATOMIC_ACQUIRE, "agent");
            asm volatile("s_waitcnt vmcnt(0)" ::: "memory");
        }
    }
    __syncthreads();
}

struct Args { const float* in[20]; float* out; unsigned char* ws; int ph_lo, ph_hi; };

typedef const __attribute__((address_space(4))) Args* KArgs;
__device__ __forceinline__ KArgs kargs() { KArgs p = (KArgs)__builtin_amdgcn_kernarg_segment_ptr(); asm volatile("" : "+s"(p)); return p; }
__device__ __forceinline__ void p0_transpose_item(const float* W, int ldw, int K, int ncols, bf16* WT, LAS float* scr, int item, int lane, const float* gk, int glu) {
    const int nblk = ncols / 32, kb = item / nblk, nb = item % nblk, k0 = 64 * kb, n0 = 32 * nb;
    int src0 = n0;
    if (glu == 1) src0 = ((n0 >> 7) & 1) * 1024 + 128 * (n0 >> 8) + (n0 & 127);
    if (glu == 2) src0 = (n0 & ~255) + 64 * ((n0 >> 5) & 3) + 32 * ((n0 >> 7) & 1);
#pragma unroll 8
    for (int i = 0; i < 32; ++i) { const int kk = 2 * i + (lane >> 5); const float g = gk ? gk[k0 + kk] : 1.0f; scr[kk * 33 + (lane & 31)] = __builtin_nontemporal_load(W + (size_t)(k0 + kk) * ldw + src0 + (lane & 31)) * g; }
    LDS_WAIT(); asm volatile("" ::: "memory");
    const int c = lane & 7;
#pragma unroll
    for (int j = 0; j < 4; ++j) { const int n = (lane >> 3) + 8 * j; const LAS float* s = scr + (8 * c) * 33 + n;
        v4u o; o.x = pk2(s[0 * 33], s[1 * 33]); o.y = pk2(s[2 * 33], s[3 * 33]); o.z = pk2(s[4 * 33], s[5 * 33]); o.w = pk2(s[6 * 33], s[7 * 33]);
        *(GAS v4u*)(WT + (size_t)(n0 + n) * K + k0 + 8 * c) = o; }
    LDS_WAIT(); asm volatile("" ::: "memory");
}

__device__ __forceinline__ void ssm_setup(LAS unsigned char* lds, int tid, unsigned* ctr, volatile LAS unsigned* slot) {
    KArgs a = kargs();
    const float* a_re = a->in[9]; const float* a_im = a->in[10]; const float* b_re = a->in[11]; const float* b_im = a->in[12];
    const float* c_re = a->in[13]; const float* c_im = a->in[14]; const float* log_dt = a->in[15];
    bf16* BT3 = (bf16*)(a->ws + WS_BT3); bf16* WT1 = (bf16*)(a->ws + WS_WT1);
    LAS float* lamp = (LAS float*)lds;
    LAS float* bbt = lamp + 17 * 64 * 2;
    LAS float* cct = bbt + 64 * 16 * 2;
    LAS float* Kt = cct + 16 * 64 * 2;
    for (;;) {
        if (tid == 0) slot[0] = atomicAdd(ctr, 1u);
        __syncthreads();
        const int w = (int)slot[0];
        if (w >= 4 * NG) break;
        const int g = w >> 2, q = w & 3;
        {
            LAS double* ld = (LAS double*)(Kt);
            if (tid < 64) { const int p = tid; const double dt = exp((double)log_dt[g]), are = (double)a_re[g * 64 + p], aim = (double)a_im[g * 64 + p];
                double sn, cs; sincos_d(dt * aim, sn, cs); const double mag = exp(dt * are); const double lr = mag * cs, li = mag * sn;
                const double nr = lr - 1.0, ni = li, den = are * are + aim * aim;
                ld[p * 4] = lr; ld[p * 4 + 1] = li; ld[p * 4 + 2] = (nr * are + ni * aim) / den; ld[p * 4 + 3] = (ni * are - nr * aim) / den;
                if (q == 0) { double pr = lr, pi = li; f32x4 o;
#pragma unroll 1
                    for (int sq = 0; sq < 9; ++sq) { if (sq == 4) { o.x = (float)pr; o.y = (float)pi; } const double t = pr * pr - pi * pi; pi = 2.0 * pr * pi; pr = t; }
                    o.z = (float)pr; o.w = (float)pi; *(f32x4*)((float*)(a->ws + WS_LAMT) + (size_t)(g * 64 + p) * 4) = o; } }
            __syncthreads();
#pragma unroll 1
            for (int idx = tid; idx < 17 * 64; idx += 512) { const int tau = idx >> 6, p = idx & 63; double br = ld[p * 4], bi = ld[p * 4 + 1], rr = 1.0, ri = 0.0;
#pragma unroll
                for (int bit = 0; bit < 5; ++bit) { if ((tau >> bit) & 1) { const double t = rr * br - ri * bi; ri = rr * bi + ri * br; rr = t; } const double t2 = br * br - bi * bi; bi = 2.0 * br * bi; br = t2; }
                lamp[idx * 2] = (float)rr; lamp[idx * 2 + 1] = (float)ri; }
#pragma unroll 1
            for (int idx = tid; idx < 64 * 16; idx += 512) { const int p = idx >> 4; const double sr = ld[p * 4 + 2], si = ld[p * 4 + 3];
                const double br = (double)b_re[g * 1024 + idx], bi = (double)b_im[g * 1024 + idx];
                bbt[idx * 2] = (float)(sr * br - si * bi); bbt[idx * 2 + 1] = (float)(sr * bi + si * br); }
        }
        for (int i = tid; i < 1024; i += 512) { cct[i * 2] = c_re[g * 1024 + i]; cct[i * 2 + 1] = c_im[g * 1024 + i]; }
        __syncthreads();
        {
            const int tau = tid >> 5, cp = (tid >> 1) & 15, c0 = (tid & 1) * 8; float sacc[8];
#pragma unroll
            for (int e = 0; e < 8; ++e) sacc[e] = 0.f;
#pragma unroll 2
            for (int p = 0; p < 64; ++p) { const float cr = cct[(cp * 64 + p) * 2], ci = cct[(cp * 64 + p) * 2 + 1], lr = lamp[(tau * 64 + p) * 2], li = lamp[(tau * 64 + p) * 2 + 1];
                const float dr = cr * lr - ci * li, di = cr * li + ci * lr;
                const LAS f32x4* bp = (const LAS f32x4*)(bbt + (p * 16 + c0) * 2);
#pragma unroll
                for (int e4 = 0; e4 < 4; ++e4) { const f32x4 b4 = bp[e4]; sacc[2 * e4] += dr * b4.x - di * b4.y; sacc[2 * e4 + 1] += dr * b4.z - di * b4.w; } }
#pragma unroll
            for (int e = 0; e < 8; ++e) Kt[tau * 256 + cp * 16 + c0 + e] = sacc[e] + ((tau == 0 && c0 + e == cp) ? a->in[16][16 * g + cp] : 0.f);
        }
        __syncthreads();
#pragma unroll 1
        for (int r = 0; r < 6; ++r) { const int pc = tid + 512 * r, rr = pc / 48, k8 = (pc % 48) * 8, n = 64 * q + rr, j = n >> 4, cp = n & 15; float v[8];
            if (k8 < 256) { const int s = k8 >> 4, c0 = k8 & 15;
#pragma unroll
                for (int e = 0; e < 8; ++e) v[e] = (j >= s) ? Kt[(j - s) * 256 + cp * 16 + c0 + e] : 0.f;
            } else { const int im = (k8 - 256) >> 6, p0 = (k8 - 256) & 63;
#pragma unroll
                for (int e = 0; e < 8; ++e) { const int p = p0 + e; const float cr = cct[(cp * 64 + p) * 2], ci = cct[(cp * 64 + p) * 2 + 1], lr = lamp[((j + 1) * 64 + p) * 2], li = lamp[((j + 1) * 64 + p) * 2 + 1];
                    v[e] = im ? -(cr * li + ci * lr) : (cr * lr - ci * li); } }
            v4u o; o.x = pk2(v[0], v[1]); o.y = pk2(v[2], v[3]); o.z = pk2(v[4], v[5]); o.w = pk2(v[6], v[7]);
            *(GAS v4u*)(BT3 + (size_t)(g * 256 + n) * KA + k8) = o; }
#pragma unroll 1
        for (int r = 0; r < 4; ++r) { const int pc = tid + 512 * r, rr = pc >> 5, k8 = (pc & 31) * 8, n = 64 * q + rr; float v[8];
            if (n < 128) { const int p = n & 63, im = n >> 6, s = k8 >> 4, c0 = k8 & 15; const float lr = lamp[((15 - s) * 64 + p) * 2], li = lamp[((15 - s) * 64 + p) * 2 + 1];
#pragma unroll
                for (int e = 0; e < 8; ++e) { const float br = bbt[(p * 16 + c0 + e) * 2], bi = bbt[(p * 16 + c0 + e) * 2 + 1]; v[e] = im ? (lr * bi + li * br) : (lr * br - li * bi); }
            } else {
#pragma unroll
                for (int e = 0; e < 8; ++e) v[e] = 0.f; }
            v4u o; o.x = pk2(v[0], v[1]); o.y = pk2(v[2], v[3]); o.z = pk2(v[4], v[5]); o.w = pk2(v[6], v[7]);
            *(GAS v4u*)(WT1 + (size_t)(g * 256 + n) * 256 + k8) = o; }
        __syncthreads();
    }
}

__device__ __forceinline__ void p0_prologue(LAS unsigned char* lds, int tid, int lane, int wave, int vcu, int G) {
    const int gw = vcu * NWAVES + wave, NGW = G * NWAVES;
    { KArgs a = kargs(); const float* nmix = a->in[1]; const float* nmlp = a->in[2]; const float* w_in = a->in[3]; unsigned char* ws = a->ws;
    LAS float* scr = (LAS float*)(lds + RING_OFF + wave * 16384);
    constexpr int I_QKV = (D / 64) * (NQKV / 32), I_O = (D / 64) * (D / 32), I_1 = (D / 64) * (FF / 32), I_2 = (FF / 64) * (D / 32), I_G = (D / 64) * (2 * D / 32);
    constexpr int NITEMS = I_QKV + I_O + 2 * I_1 + 2 * I_2 + I_O + I_G;
    for (int it = gw; it < NITEMS; it += NGW) {
        int r = it;
        if (r < I_1) { p0_transpose_item(a->in[18] + (size_t)D * FF, FF, D, FF, (bf16*)(ws + WS_W1B), scr, r, lane, nmlp + D, 0); continue; } r -= I_1;
        if (r < I_2) { p0_transpose_item(a->in[19] + (size_t)FF * D, D, FF, D, (bf16*)(ws + WS_W2B), scr, r, lane, nullptr, 0); continue; } r -= I_2;
        if (r < I_G) { p0_transpose_item(a->in[17], 2 * D, D, 2 * D, (bf16*)(ws + WS_WGLU), scr, r, lane, nullptr, 1); continue; } r -= I_G;
        if (r < I_O) { p0_transpose_item(a->in[8], D, D, D, (bf16*)(ws + WS_WSSM), scr, r, lane, nmix + D, 0); continue; } r -= I_O;
        if (r < I_2) { p0_transpose_item(a->in[19], D, FF, D, (bf16*)(ws + WS_W2A), scr, r, lane, nullptr, 0); continue; } r -= I_2;
        if (r < I_1) { p0_transpose_item(a->in[18], FF, D, FF, (bf16*)(ws + WS_W1A), scr, r, lane, nmlp, 0); continue; } r -= I_1;
        if (r < I_O) { p0_transpose_item(a->in[7], D, D, D, (bf16*)(ws + WS_WO), scr, r, lane, nullptr, 0); continue; } r -= I_O;
        p0_transpose_item(w_in, WIN_LD, D, NQKV, (bf16*)(ws + WS_WQKV), scr, r, lane, nullptr, 2);
    }
    }
    KArgs a = kargs(); const float* x = a->in[0]; const float* nmix = a->in[1]; const float* w_in = a->in[3]; const float* b_f = a->in[4]; unsigned char* ws = a->ws;
    { float* rs = (float*)(ws + WS_CTL); for (int i = blockIdx.x * 512 + tid; i < 3 * M; i += G * 512) rs[i] = 0.f; }
    __syncthreads();
    LAS float* wfT = (LAS float*)(lds + RING_OFF);
    for (int i = tid; i < D * H; i += 512) { const int k = i >> 4, h = i & 15; wfT[h * D + k] = w_in[(size_t)k * WIN_LD + NQKV + h]; }
    __syncthreads();
    bf16* XN = (bf16*)(ws + WS_XN); float* LF = (float*)(ws + WS_LF);
    for (int m = gw; m < M; m += NGW) {
        const GAS f32x4* xr = (const GAS f32x4*)(x + (size_t)m * D) + lane;
        f32x4 v[4]; float s = 0.f;
#pragma unroll
        for (int j = 0; j < 4; ++j) { v[j] = __builtin_nontemporal_load(xr + 64 * j); s += (v[j].x * v[j].x + v[j].y * v[j].y) + (v[j].z * v[j].z + v[j].w * v[j].w); }
        const float ssx = wave_sum(s); const float rs = 1.0f / sqrtf(ssx * (1.f / D) + 1e-6f);
        if (lane == 0) ((float*)(ws + WS_CTL))[3 * M + m] = ssx;
        GAS unsigned long long* o8 = (GAS unsigned long long*)(XN + (size_t)m * D) + lane;
#pragma unroll
        for (int j = 0; j < 4; ++j) { const f32x4 g4 = *(const f32x4*)(nmix + 256 * j + 4 * lane); v[j] = v[j] * rs * g4;
            o8[64 * j] = (unsigned long long)pk2(v[j].x, v[j].y) | ((unsigned long long)pk2(v[j].z, v[j].w) << 32); }
        float acc[16];
#pragma unroll
        for (int h = 0; h < 16; ++h) { float t = 0.f, t2 = 0.f; if ((h & 3) == 0) asm volatile("" ::: "memory");
#pragma unroll
            for (int j = 0; j < 4; ++j) { const f32x4 w4 = *(const LAS f32x4*)(wfT + h * D + 256 * j + 4 * lane);
                if (j & 1) { t2 = __builtin_fmaf(v[j].x, w4.x, t2); t2 = __builtin_fmaf(v[j].y, w4.y, t2); t2 = __builtin_fmaf(v[j].z, w4.z, t2); t2 = __builtin_fmaf(v[j].w, w4.w, t2); }
                else { t = __builtin_fmaf(v[j].x, w4.x, t); t = __builtin_fmaf(v[j].y, w4.y, t); t = __builtin_fmaf(v[j].z, w4.z, t); t = __builtin_fmaf(v[j].w, w4.w, t); } }
            acc[h] = t + t2; }
#pragma unroll
        for (int i = 0; i < 8; ++i) { const bool hi = (lane & 32) != 0; const float send = hi ? acc[i] : acc[i + 8], keep = hi ? acc[i + 8] : acc[i]; acc[i] = keep + __shfl_xor(send, 32); }
#pragma unroll
        for (int i = 0; i < 4; ++i) { const bool hi = (lane & 16) != 0; const float send = hi ? acc[i] : acc[i + 4], keep = hi ? acc[i + 4] : acc[i]; acc[i] = keep + __shfl_xor(send, 16); }
#pragma unroll
        for (int i = 0; i < 2; ++i) { const bool hi = (lane & 8) != 0; const float send = hi ? acc[i] : acc[i + 2], keep = hi ? acc[i + 2] : acc[i]; acc[i] = keep + __shfl_xor(send, 8); }
        { const bool hi = (lane & 4) != 0; const float send = hi ? acc[0] : acc[1], keep = hi ? acc[1] : acc[0]; acc[0] = keep + __shfl_xor(send, 4); }
        float f = acc[0]; f += __shfl_xor(f, 2); f += __shfl_xor(f, 1);
        const int hh = lane >> 2;
        const float z = f + b_f[hh];
        const float lf = fminf(z, 0.f) - 0.6931471805599453f * __builtin_amdgcn_logf(1.0f + __builtin_amdgcn_exp2f(-1.4426950408889634f * fabsf(z)));
        if ((lane & 3) == 0) LF[(size_t)((m >> 12) * 16 + hh) * SEQ + (m & (SEQ - 1))] = lf;
    }
}

__device__ __forceinline__ void cumsum_phase(LAS unsigned char* lds, int tid, int lane, int wave) {
    KArgs a = kargs();
    const float* LF = (const float*)(a->ws + WS_LF); float* KB = (float*)(a->ws + WS_KB);
    LAS float* wsum = (LAS float*)(lds + MISC_OFF);
    for (int bh = blockIdx.x; bh < BATCH * H; bh += gridDim.x) {
        const float* src = LF + (size_t)bh * SEQ + 8 * tid;
        const f32x4 a0 = *(const f32x4*)src, a1 = *(const f32x4*)(src + 4);
        float p[8]; p[0] = a0.x; p[1] = p[0] + a0.y; p[2] = p[1] + a0.z; p[3] = p[2] + a0.w; p[4] = p[3] + a1.x; p[5] = p[4] + a1.y; p[6] = p[5] + a1.z; p[7] = p[6] + a1.w;
        float incl = p[7];
#pragma unroll
        for (int o = 1; o < 64; o <<= 1) { const float t = __shfl_up(incl, o); if (lane >= o) incl += t; }
        if (lane == 63) wsum[wave] = incl;
        __syncthreads();
        float off = incl - p[7];
        for (int w = 0; w < wave; ++w) off += wsum[w];
        f32x4 o0, o1;
        o0.x = -(p[0] + off) * 1.4426950408889634f; o0.y = -(p[1] + off) * 1.4426950408889634f; o0.z = -(p[2] + off) * 1.4426950408889634f; o0.w = -(p[3] + off) * 1.4426950408889634f;
        o1.x = -(p[4] + off) * 1.4426950408889634f; o1.y = -(p[5] + off) * 1.4426950408889634f; o1.z = -(p[6] + off) * 1.4426950408889634f; o1.w = -(p[7] + off) * 1.4426950408889634f;
        float* dst = KB + (size_t)bh * SEQ + 8 * tid;
        *(f32x4*)dst = o0; *(f32x4*)(dst + 4) = o1;
        __syncthreads();
    }
}

template <bool FROM_LDS> __device__ __forceinline__ void scan_phase(LAS unsigned char* lds, int lane, int wave, int vcu) {
    KArgs a = kargs();
    const float* SB = (const float*)(a->ws + WS_SBUF); bf16* AA = (bf16*)(a->ws + WS_AALL);
    LAS float* est = (LAS float*)(lds + (FROM_LDS ? 256 * pg8::SL_PITCH * 4 : RING_OFF));
    const LAS float* SL = (const LAS float*)(lds + RING_OFF);
    for (int w = vcu; w < NG * BATCH; w += gridDim.x) {
        const int g = w >> 2, b = w & 3, p = lane;
        const f32x4 lt = *(const f32x4*)((const float*)(a->ws + WS_LAMT) + (size_t)(g * 64 + p) * 4);
        const float l16r = lt.x, l16i = lt.y, l512r = lt.z, l512i = lt.w;
        const size_t row0 = (size_t)g * 1024 + b * 256 + 32 * wave;
        float sr[32], si[32];
#pragma unroll
        for (int i = 0; i < 32; ++i) { if (FROM_LDS) { sr[i] = SL[(32 * wave + i) * pg8::SL_PITCH + p]; si[i] = SL[(32 * wave + i) * pg8::SL_PITCH + 64 + p]; } else { sr[i] = SB[(row0 + i) * 128 + p]; si[i] = SB[(row0 + i) * 128 + 64 + p]; } }
        float xr = 0.f, xi = 0.f;
#pragma unroll
        for (int i = 0; i < 32; ++i) { const float nr = l16r * xr - l16i * xi + sr[i], ni = l16r * xi + l16i * xr + si[i]; xr = nr; xi = ni; sr[i] = xr; si[i] = xi; }
        est[(wave * 64 + p) * 2] = xr; est[(wave * 64 + p) * 2 + 1] = xi;
        __syncthreads();
        float pr = 0.f, pi = 0.f;
        for (int v = 0; v < wave; ++v) { const float er = est[(v * 64 + p) * 2], ei = est[(v * 64 + p) * 2 + 1]; const float nr = l512r * pr - l512i * pi + er, ni = l512r * pi + l512i * pr + ei; pr = nr; pi = ni; }
        float qr = 0.f, qi = 0.f;
#pragma unroll
        for (int i = 0; i < 32; ++i) { bf16* dst = AA + (row0 + i) * KA + 256 + p;
            { const unsigned pkd = pk2(qr + pr, qi + pi); dst[0] = (bf16)(pkd & 0xffffu); dst[64] = (bf16)(pkd >> 16); }
            qr = sr[i]; qi = si[i];
            const float nr = l16r * pr - l16i * pi, ni = l16r * pi + l16i * pr; pr = nr; pi = ni; }
        __syncthreads();
    }
}

__global__ void __launch_bounds__(NWAVES * 64, 2) fwd_megakernel(Args args) {
    extern __shared__ __attribute__((aligned(16))) unsigned char lds_raw[];
    cg::grid_group grid = cg::this_grid();
    LAS unsigned char* lds = (LAS unsigned char*)lds_raw;
    const int tid = threadIdx.x, lane = tid & 63, wave = __builtin_amdgcn_readfirstlane(tid >> 6);
    const int G = gridDim.x; const int bx = blockIdx.x; const int vcu = (G % 8 == 0) ? (bx % 8) * (G / 8) + bx / 8 : bx;
    const int lo = kargs()->ph_lo, hi = kargs()->ph_hi;
#define ws (kargs()->ws)
#define AIN(k) (kargs()->in[k])
#define AOUT (kargs()->out)
#ifndef ONLY
#define ONLY -1
#endif
#define IN(k) ((ONLY < 0 || ONLY == (k)) && lo <= (k) && (k) < hi)
#define WG_SEAM() do { asm volatile("s_waitcnt vmcnt(0) lgkmcnt(0)" ::: "memory"); __syncthreads(); if (wave == 0) { __builtin_amdgcn_fence(__ATOMIC_ACQUIRE, "agent"); asm volatile("s_waitcnt vmcnt(0)" ::: "memory"); } __syncthreads(); } while (0)
#define SEAM(k) do { if (IN(k) && IN((k) + 1)) { xcd_barrier(xbar); } } while (0)
#define rowss ((float*)(ws + WS_CTL))
#define XN ((bf16*)(ws + WS_XN))
#define HB ((bf16*)(ws + WS_H))

    if (tid < 32) ((LAS unsigned*)(lds + MISC_OFF))[tid] = 0u;
    if (bx == 0) { unsigned* bw = (unsigned*)(ws + WS_BAR); for (int i = tid; i < XCD_BAR_WORDS; i += NWAVES * 64) bw[i] = 0u; if (tid < 9) bw[4096 + 64 * tid] = 0u; }
    if (IN(0)) { p0_prologue(lds, tid, lane, wave, vcu, G); }
    __threadfence(); grid.sync();
    XcdBarrier xbar = xcd_barrier_post((unsigned*)(ws + WS_BAR), (volatile LAS unsigned*)(lds + MISC_OFF) + 8);
    if (IN(1)) cumsum_phase(lds, tid, lane, wave);
    if (IN(1)) {
        pg8::Gemm g{XN, (const bf16*)(ws + WS_WQKV), M, NQKV, D, D, D}; pg8::StaticOrder S; S.init(M, NQKV, G, bx);
        { LAS float* gl = (LAS float*)(lds + MISC_OFF + 1024); if (tid < 64) gl[tid] = AIN(5)[tid] * attn_body::C2; else if (tid < 128) gl[tid] = AIN(6)[tid - 64]; __syncthreads(); }
        pg8::EpiQKV E{(bf16*)(ws + WS_QO), (size_t)(WS_K - WS_QO) / 2, (PG8_LAS const float*)(lds + MISC_OFF + 1024)};
        pg8::gemm_phase(lds + RING_OFF, g, S, E);
    }
    SEAM(1);
    if (IN(2)) {
        const attn_body::AttnTensors AT{(const attn_body::bf16*)(ws + WS_QO), (const attn_body::bf16*)(ws + WS_K), (const attn_body::bf16*)(ws + WS_V), (attn_body::bf16*)(ws + WS_O), (const float*)(ws + WS_KB), AIN(5), AIN(6)};
        const attn_body::StaticOrder S(G, bx);
        attn_body::attn_phase<attn_body::StaticOrder>((char*)lds_raw + RING_OFF, AT, S, (unsigned*)(ws + WS_BAR) + 4096, (volatile LAS unsigned*)(lds + MISC_OFF) + 16, xbar.x);
        ssm_setup(lds, tid, (unsigned*)(ws + WS_BAR) + 4096 + 64 * 8, (volatile LAS unsigned*)(lds + MISC_OFF) + 18);
    }
    SEAM(2);
    if (IN(3)) {
        pg8::Gemm g{(const bf16*)(ws + WS_O), (const bf16*)(ws + WS_WO), M, D, D, D, D}; pg8::StaticOrder S; S.init(M, D, G, bx);
        pg8::EpiResid E{nullptr, XN, nullptr, XN, rowss, rowss + 3 * M, AIN(1), nullptr};
        pg8::gemm_phase(lds + RING_OFF, g, S, E);
    }
    SEAM(3);
    if (IN(4)) {
        pg8::Gemm g{XN, (const bf16*)(ws + WS_W1A), M, FF, D, D, D}; pg8::StaticOrder S; S.init(M, FF, G, bx);
        pg8::EpiSqrelu E{HB, FF};
        pg8::gemm_phase(lds + RING_OFF, g, S, E);
    }
    SEAM(4);
    if (IN(5)) {
        pg8::Gemm g{HB, (const bf16*)(ws + WS_W2A), M, D, FF, FF, FF}; pg8::StaticOrder S; S.init(M, D, G, bx);
        pg8::EpiResid E{nullptr, XN, nullptr, XN, rowss + M, nullptr, nullptr, rowss};
        pg8::gemm_phase(lds + RING_OFF, g, S, E);
    }
    SEAM(5);
    if (IN(6)) {
        pg8::Gemm g{XN, (const bf16*)(ws + WS_WSSM), M, D, D, D, D}; pg8::StaticOrder S; S.init(M, D, G, bx);
        pg8::EpiU E{(bf16*)(ws + WS_AALL), rowss + M};
        pg8::gemm_phase(lds + RING_OFF, g, S, E);
    }
    SEAM(6);
    if (G == NG * BATCH) {
        if (IN(7)) {
            pg8::Gemm g{(const bf16*)(ws + WS_AALL), (const bf16*)(ws + WS_WT1), NG * 1024, 256, 256, KA, 256}; pg8::BatchOrder S; S.init(NG * 4, G, vcu);
            pg8::EpiSLds E{(PG8_LAS float*)(lds + RING_OFF)};
            pg8::gemm_phase(lds + RING_OFF, g, S, E);
        }
        __syncthreads();
        if (IN(8)) scan_phase<true>(lds, lane, wave, vcu);
        WG_SEAM();
    } else {
        if (IN(7)) {
            pg8::Gemm g{(const bf16*)(ws + WS_AALL), (const bf16*)(ws + WS_WT1), NG * 1024, 256, 256, KA, 256}; pg8::BatchOrder S; S.init(NG * 4, G, vcu);
            pg8::EpiS E{(float*)(ws + WS_SBUF)};
            pg8::gemm_phase(lds + RING_OFF, g, S, E);
        }
        SEAM(7);
        if (IN(8)) scan_phase<false>(lds, lane, wave, vcu);
        SEAM(8);
    }
    if (IN(9)) {
        pg8::Gemm g{(const bf16*)(ws + WS_AALL), (const bf16*)(ws + WS_BT3), NG * 1024, 256, KA, KA, KA}; pg8::BatchOrder S; S.init(NG * 4, G, vcu);
        pg8::EpiY E{(bf16*)(ws + WS_Z)};
        pg8::gemm_phase(lds + RING_OFF, g, S, E);
    }
    SEAM(9);
    if (IN(10)) {
        pg8::Gemm g{(const bf16*)(ws + WS_Z), (const bf16*)(ws + WS_WGLU), M, 2 * D, D, D, D}; pg8::StaticOrder S; S.init(M, 2 * D, G, bx);
        pg8::EpiGlu E{XN, rowss + 2 * M};
        pg8::gemm_phase(lds + RING_OFF, g, S, E);
    }
    SEAM(10);
    if (IN(11)) {
        pg8::Gemm g{XN, (const bf16*)(ws + WS_W1B), M, FF, D, D, D}; pg8::StaticOrder S; S.init(M, FF, G, bx);
        pg8::EpiSqrelu E{HB, FF};
        pg8::gemm_phase(lds + RING_OFF, g, S, E);
    }
    SEAM(11);
    if (IN(12)) {
        pg8::Gemm g{HB, (const bf16*)(ws + WS_W2B), M, D, FF, FF, FF}; pg8::StaticOrder S; S.init(M, D, G, bx);
        pg8::EpiResid E{nullptr, XN, AOUT, nullptr, nullptr, nullptr, nullptr, rowss + 2 * M};
        pg8::gemm_phase(lds + RING_OFF, g, S, E);
    }
#undef IN
#undef SEAM
#undef ws
#undef AIN
#undef AOUT
#undef rowss
#undef XN
#undef HB
}

extern "C" void kernel_launch(void* const* d_in, const int* in_sizes, int n_in, void* d_out, int out_size, void* d_ws, size_t ws_size, hipStream_t stream) {
    static int grid = 0;
    if (grid == 0) {
        if (n_in != 20 || in_sizes[0] != M * D || out_size != M * D || ws_size < WS_END) { fprintf(stderr, "kernel_launch: unexpected shapes (n_in %d, in0 %d, out %d, ws %zu)\n", n_in, n_in > 0 ? in_sizes[0] : -1, out_size, ws_size); grid = -1; return; }
        int dev = 0, cus = 0, per_cu = 0;
        if (hipGetDevice(&dev) != hipSuccess || hipDeviceGetAttribute(&cus, hipDeviceAttributeMultiprocessorCount, dev) != hipSuccess) { grid = -1; return; }
        if (hipFuncSetAttribute((const void*)fwd_megakernel, hipFuncAttributeMaxDynamicSharedMemorySize, LDS_BYTES) != hipSuccess) { fprintf(stderr, "kernel_launch: hipFuncSetAttribute failed\n"); grid = -1; return; }
        if (hipOccupancyMaxActiveBlocksPerMultiprocessor(&per_cu, (const void*)fwd_megakernel, NWAVES * 64, LDS_BYTES) != hipSuccess || per_cu < 1) { fprintf(stderr, "kernel_launch: occupancy query reports %d workgroups per CU\n", per_cu); (void)hipGetLastError(); per_cu = 1; }
        grid = cus;
        if (grid != 256) fprintf(stderr, "kernel_launch: %d CUs; the attention unit order expects 256\n", grid);
    }
    if (grid < 0) return;
    Args a{};
    for (int i = 0; i < 20; ++i) a.in[i] = (const float*)d_in[i];
    a.out = (float*)d_out; a.ws = (unsigned char*)d_ws; a.ph_lo = 0; a.ph_hi = 13;
    void* params[] = {&a};
    const hipError_t le = hipLaunchCooperativeKernel((const void*)fwd_megakernel, dim3(grid), dim3(NWAVES * 64), params, LDS_BYTES, stream);
    if (le != hipSuccess) fprintf(stderr, "kernel_launch: cooperative launch failed: %s (grid %d)\n", hipGetErrorName(le), grid);
}
```

```cpp
#include <hip/hip_runtime.h>
#include <hip/hip_cooperative_groups.h>
#include <hip/hip_bf16.h>
#include <cstdio>
#include <cstdint>
#include <cmath>
namespace cg = cooperative_groups;

namespace pg8 {
#define PG8_LAS __attribute__((address_space(3)))
typedef unsigned short bf16_t;
typedef short bf16x8 __attribute__((ext_vector_type(8)));
typedef float f32x4 __attribute__((ext_vector_type(4)));
typedef unsigned u32x4 __attribute__((ext_vector_type(4)));
constexpr int BM = 256, BK = 64, HALF = 128, HTB = HALF * BK * 2  , STAGE_BYTES = 8 * HTB, NXCD = 8, WGM = 8;

__host__ __device__ __forceinline__ int lds_byte(int r, int c) { const int st = (r >> 4) * 2 + (c >> 5), rr = r & 15, cc = c & 31, ob = rr * 64 + cc * 2; return st * 1024 + (ob ^ (((ob >> 9) & 1) << 5)); }
__host__ __device__ __forceinline__ void stage_rc(int b, int& R, int& C) { const int st = b / 1024, sb = b % 1024, swz = sb ^ (((sb >> 9) & 1) << 5); R = (st >> 1) * 16 + swz / 64; C = (st & 1) * 32 + (swz % 64) / 2; }
__host__ __device__ __forceinline__ int perm32(int rho) { const int n = rho >> 4, i = rho & 15; return 8 * (i >> 2) + 4 * n + (i & 3); }

struct Unit { int pm, pn; };
struct Gemm { const bf16_t* A; const bf16_t* Bt; int M, N, K, lda, ldb; };

struct StaticOrder {
    int nM, nN, nwg, G, c;
    __host__ __device__ void init(int M, int N, int G_, int c_) { nM = M / BM; nN = N / BM; nwg = nM * nN; G = G_; c = c_; }
    __host__ __device__ bool next(int i, Unit& u) const {
        const long L = (long)i * G + c; if (L >= nwg) return false;
        int wgid = (int)L; { const int q = nwg / NXCD, r = nwg % NXCD, xcd = wgid % NXCD, off = wgid / NXCD; wgid = (xcd < r ? xcd * (q + 1) : r * (q + 1) + (xcd - r) * q) + off; }
        const int nig = WGM * nN, gid = wgid / nig, fm = gid * WGM, gsz = (nM - fm) < WGM ? (nM - fm) : WGM;
        u.pm = fm + ((wgid % nig) % gsz); u.pn = (wgid % nig) / gsz; return true;
    }
};
struct BatchOrder {
    int n, G, c;
    __host__ __device__ void init(int n_, int G_, int c_) { n = n_; G = G_; c = c_; }
    __host__ __device__ bool next(int i, Unit& u) const { const long L = (long)i * G + c; if (L >= n) return false; u.pm = (int)L; u.pn = (int)(L >> 2); return true; }
};

__device__ __forceinline__ unsigned cvt_pk_bf16(float lo, float hi) { unsigned r; asm volatile("v_cvt_pk_bf16_f32 %0, %1, %2" : "=v"(r) : "v"(lo), "v"(hi)); return r; }
__device__ __forceinline__ u32x4 pack8(const f32x4 v0, const f32x4 v1) { u32x4 w; w.x = cvt_pk_bf16(v0[0], v0[1]); w.y = cvt_pk_bf16(v0[2], v0[3]); w.z = cvt_pk_bf16(v1[0], v1[1]); w.w = cvt_pk_bf16(v1[2], v1[3]); return w; }
__device__ __forceinline__ float fq_sum(float s) {
    auto a = __builtin_amdgcn_permlane16_swap(__float_as_uint(s), __float_as_uint(s), false, false); s = __uint_as_float(a[0]) + __uint_as_float(a[1]);
    auto b = __builtin_amdgcn_permlane32_swap(__float_as_uint(s), __float_as_uint(s), false, false); return __uint_as_float(b[0]) + __uint_as_float(b[1]); }
__device__ __forceinline__ float bf2f(unsigned short h) { return __uint_as_float(((unsigned)h) << 16); }
__device__ __forceinline__ float sq4(const f32x4 x) { return __builtin_fmaf(x[3], x[3], __builtin_fmaf(x[2], x[2], __builtin_fmaf(x[1], x[1], x[0] * x[0]))); }
__device__ __forceinline__ float sigmoid_f(float x) { return __builtin_amdgcn_rcpf(1.0f + __builtin_amdgcn_exp2f(-1.4426950408889634f * x)); }
__device__ __forceinline__ float gelu_tanh_f(float y) { const float a = y * (1.0f + 0.044715f * y * y) * (2.0f * 0.7978845608028654f); return y * sigmoid_f(a); }
constexpr float RMS_EPS = 1e-6f;

struct EpiQKV {
    static constexpr bool PERM = true, AFTER_DRAIN = false;
    bf16_t* Q; size_t kv_stride; PG8_LAS const float* gl;
    __device__ __forceinline__ void operator()(const f32x4 (&acc)[2][2][4][2], const Unit& u, int wr, int wc, int fr, int fq) const {
        const int t = u.pn >> 2;
        bf16_t* base = Q + (size_t)t * kv_stride;
        int row0 = u.pm * BM + wr * 64 + fr, col0 = (u.pn & 3) * BM + wc * 64 + 8 * fq;
        asm volatile("" : "+v"(row0), "+v"(col0));
        f32x4 g[2][2];
#pragma unroll
        for (int bj = 0; bj < 2; ++bj)
#pragma unroll
            for (int n = 0; n < 2; ++n) g[bj][n] = (f32x4){1.f, 1.f, 1.f, 1.f};
        if (t < 2) { PG8_LAS const float* gs = gl + 64 * t + 8 * fq;
#pragma unroll
            for (int bj = 0; bj < 2; ++bj)
#pragma unroll
                for (int n = 0; n < 2; ++n) g[bj][n] = *(PG8_LAS const f32x4*)(gs + 32 * bj + 4 * n); }
#pragma unroll
        for (int ai = 0; ai < 2; ++ai)
#pragma unroll
            for (int m = 0; m < 4; ++m) { bf16_t* rowp = base + (size_t)(row0 + ai * HALF + m * 16) * 1024 + col0;
                float r = 1.f;
                if (t < 2) { float s = (sq4(acc[ai][0][m][0]) + sq4(acc[ai][0][m][1])) + (sq4(acc[ai][1][m][0]) + sq4(acc[ai][1][m][1]));
                    s = fq_sum(s); r = __builtin_amdgcn_rsqf(s * (1.0f / 64.0f) + RMS_EPS); }
#pragma unroll
                for (int bj = 0; bj < 2; ++bj) *(u32x4*)(rowp + bj * 32) = pack8(acc[ai][bj][m][0] * r * g[bj][0], acc[ai][bj][m][1] * r * g[bj][1]); }
    }
};

__device__ __forceinline__ void unpack8(const u32x4 w, f32x4& v0, f32x4& v1) {
    v0[0] = __uint_as_float(w.x << 16); v0[1] = __uint_as_float(w.x & 0xffff0000u); v0[2] = __uint_as_float(w.y << 16); v0[3] = __uint_as_float(w.y & 0xffff0000u);
    v1[0] = __uint_as_float(w.z << 16); v1[1] = __uint_as_float(w.z & 0xffff0000u); v1[2] = __uint_as_float(w.w << 16); v1[3] = __uint_as_float(w.w & 0xffff0000u); }
struct EpiResid {
    static constexpr bool PERM = true, AFTER_DRAIN = false;
    const float* basef; const bf16_t* baseb; float* out; bf16_t* xb; float* rowss; const float* unss; const float* ung; const float* accss;
    __device__ __forceinline__ void operator()(const f32x4 (&acc)[2][2][4][2], const Unit& u, int wr, int wc, int fr, int fq) const {
        const int row0 = u.pm * BM + wr * 64 + fr, col0 = u.pn * BM + wc * 32 + 8 * fq;
        f32x4 ginv[2][2];
#pragma unroll
        for (int bj = 0; bj < 2; ++bj)
#pragma unroll
            for (int n = 0; n < 2; ++n) { ginv[bj][n] = (f32x4){1.f, 1.f, 1.f, 1.f}; if (unss) { const f32x4 gg = *(const f32x4*)(ung + col0 + bj * HALF + 4 * n);
#pragma unroll
                for (int i = 0; i < 4; ++i) ginv[bj][n][i] = __builtin_amdgcn_rcpf(gg[i]); } }
#pragma unroll
        for (int ai = 0; ai < 2; ++ai)
#pragma unroll
            for (int m = 0; m < 4; ++m) { const int row = row0 + ai * HALF + m * 16; const size_t off = (size_t)row * 1024 + col0; float sq = 0.f;
                const float asc = accss ? __builtin_amdgcn_rcpf(accss[row] * (1.0f / 1024.0f) + RMS_EPS) : 1.0f;
#pragma unroll
                for (int bj = 0; bj < 2; ++bj) {
                    f32x4 b0, b1;
                    if (basef) { b0 = *(const f32x4*)(basef + off + bj * HALF); b1 = *(const f32x4*)(basef + off + bj * HALF + 4); }
                    else { unpack8(*(const u32x4*)(baseb + off + bj * HALF), b0, b1);
                        if (unss) { const float ri = __builtin_amdgcn_sqrtf(unss[row] * (1.0f / 1024.0f) + RMS_EPS); b0 = b0 * ri * ginv[bj][0]; b1 = b1 * ri * ginv[bj][1]; } }
                    const f32x4 v0 = acc[ai][bj][m][0] * asc + b0, v1 = acc[ai][bj][m][1] * asc + b1;
                    if (out) { __builtin_nontemporal_store(v0, (f32x4*)(out + off + bj * HALF)); __builtin_nontemporal_store(v1, (f32x4*)(out + off + bj * HALF + 4)); }
                    if (xb) *(u32x4*)(xb + off + bj * HALF) = pack8(v0, v1);
                    sq += sq4(v0) + sq4(v1); }
                if (rowss) { sq = fq_sum(sq); if (fq == 0) atomicAdd(rowss + row, sq); } }
    }
};
struct EpiGlu {
    static constexpr bool PERM = true, AFTER_DRAIN = false;
    bf16_t* xb; float* rowss;
    __device__ __forceinline__ void operator()(const f32x4 (&acc)[2][2][4][2], const Unit& u, int wr, int wc, int fr, int fq) const {
        const int row0 = u.pm * BM + wr * 64 + fr, col0 = u.pn * HALF + wc * 32 + 8 * fq;
#pragma unroll
        for (int ai = 0; ai < 2; ++ai)
#pragma unroll
            for (int m = 0; m < 4; ++m) { const int row = row0 + ai * HALF + m * 16; const size_t off = (size_t)row * 1024 + col0;
                f32x4 v[2]; unpack8(*(const u32x4*)(xb + off), v[0], v[1]);
#pragma unroll
                for (int n = 0; n < 2; ++n) { const f32x4 val = acc[ai][0][m][n], gt = acc[ai][1][m][n];
#pragma unroll
                    for (int i = 0; i < 4; ++i) v[n][i] += val[i] * sigmoid_f(gt[i]); }
                *(u32x4*)(xb + off) = pack8(v[0], v[1]);
                float sq = sq4(v[0]) + sq4(v[1]);
                sq = fq_sum(sq); if (fq == 0) atomicAdd(rowss + row, sq); }
    }
};
struct EpiSqrelu {
    static constexpr bool PERM = true, AFTER_DRAIN = false;
    bf16_t* O; int ldc;
    __device__ __forceinline__ void operator()(const f32x4 (&acc)[2][2][4][2], const Unit& u, int wr, int wc, int fr, int fq) const {
        const int row0 = u.pm * BM + wr * 64 + fr, col0 = u.pn * BM + wc * 32 + 8 * fq;
#pragma unroll
        for (int ai = 0; ai < 2; ++ai)
#pragma unroll
            for (int m = 0; m < 4; ++m) { const int row = row0 + ai * HALF + m * 16;
                bf16_t* rowp = O + (size_t)row * ldc + col0;
#pragma unroll
                for (int bj = 0; bj < 2; ++bj) { f32x4 v0 = acc[ai][bj][m][0], v1 = acc[ai][bj][m][1];
#pragma unroll
                    for (int i = 0; i < 4; ++i) { const float a = fmaxf(v0[i], 0.f), b = fmaxf(v1[i], 0.f); v0[i] = a * a; v1[i] = b * b; }
                    *(u32x4*)(rowp + bj * HALF) = pack8(v0, v1); } }
    }
};
struct EpiU {
    static constexpr bool PERM = true, AFTER_DRAIN = false;
    bf16_t* AA; const float* rowss;
    __device__ __forceinline__ void operator()(const f32x4 (&acc)[2][2][4][2], const Unit& u, int wr, int wc, int fr, int fq) const {
        const int row0 = u.pm * BM + wr * 64 + fr, col0 = u.pn * BM + wc * 32 + 8 * fq;
#pragma unroll
        for (int ai = 0; ai < 2; ++ai)
#pragma unroll
            for (int m = 0; m < 4; ++m) { const int row = row0 + ai * HALF + m * 16; const float rs = __builtin_amdgcn_rsqf(rowss[row] * (1.0f / 1024.0f) + RMS_EPS);
                const int kc = row >> 4, s = row & 15;
#pragma unroll
                for (int bj = 0; bj < 2; ++bj) { const int n = col0 + bj * HALF, g = n >> 4, c0 = n & 15;
                    *(u32x4*)(AA + ((size_t)(g * 1024 + kc) * 384 + s * 16 + c0)) = pack8(acc[ai][bj][m][0] * rs, acc[ai][bj][m][1] * rs); } }
    }
};
struct EpiS {
    static constexpr bool PERM = true, AFTER_DRAIN = false;
    float* S;
    __device__ __forceinline__ void operator()(const f32x4 (&acc)[2][2][4][2], const Unit& u, int wr, int wc, int fr, int fq) const {
        const int row0 = u.pm * BM + wr * 64 + fr, col0 = wc * 32 + 8 * fq;
#pragma unroll
        for (int ai = 0; ai < 2; ++ai)
#pragma unroll
            for (int m = 0; m < 4; ++m) { float* p = S + (size_t)(row0 + ai * HALF + m * 16) * 128 + col0;
                *(f32x4*)p = acc[ai][0][m][0]; *(f32x4*)(p + 4) = acc[ai][0][m][1]; }
    }
};
constexpr int SL_PITCH = 132;
struct EpiSLds {
    static constexpr bool PERM = true, AFTER_DRAIN = true;
    PG8_LAS float* SL;
    __device__ __forceinline__ void operator()(const f32x4 (&acc)[2][2][4][2], const Unit& u, int wr, int wc, int fr, int fq) const {
        const int row0 = wr * 64 + fr, col0 = wc * 32 + 8 * fq;
#pragma unroll
        for (int ai = 0; ai < 2; ++ai)
#pragma unroll
            for (int m = 0; m < 4; ++m) { PG8_LAS float* p = SL + (row0 + ai * HALF + m * 16) * SL_PITCH + col0;
                *(PG8_LAS f32x4*)p = acc[ai][0][m][0]; *(PG8_LAS f32x4*)(p + 4) = acc[ai][0][m][1]; }
    }
};
struct EpiY {
    static constexpr bool PERM = true, AFTER_DRAIN = false;
    bf16_t* Z;
    __device__ __forceinline__ void operator()(const f32x4 (&acc)[2][2][4][2], const Unit& u, int wr, int wc, int fr, int fq) const {
        int row0 = u.pm * BM + wr * 64 + fr, n0 = wc * 32 + 8 * fq; const int g = u.pn;
        asm volatile("" : "+v"(row0), "+v"(n0));
#pragma unroll
        for (int ai = 0; ai < 2; ++ai)
#pragma unroll
            for (int m = 0; m < 4; ++m) { const int row = row0 + ai * HALF + m * 16, kc = row & 1023;
#pragma unroll
                for (int bj = 0; bj < 2; ++bj) { const int n = n0 + bj * HALF, j = n >> 4, c0 = n & 15, ch = 16 * g + c0;
                    f32x4 v0 = acc[ai][bj][m][0], v1 = acc[ai][bj][m][1];
#pragma unroll
                    for (int i = 0; i < 4; ++i) { v0[i] = gelu_tanh_f(v0[i]); v1[i] = gelu_tanh_f(v1[i]); }
                    *(u32x4*)(Z + (size_t)(kc * 16 + j) * 1024 + ch) = pack8(v0, v1); } }
    }
};

template <class Epi, class Sched>
__device__ __forceinline__ void gemm_phase(PG8_LAS unsigned char* lds, const Gemm g, const Sched& S, const Epi& E) {
    int tid_ = threadIdx.x; asm volatile("" : "+v"(tid_));
    const int tid = tid_, wid = __builtin_amdgcn_readfirstlane(tid >> 6), lane = tid & 63, wr = wid >> 2, wc = wid & 3, fr = lane & 15, fq = lane >> 4;
    const int K = g.K, nt = K / BK;
    unsigned voffA[2], voffB[2];
#pragma unroll
    for (int i = 0; i < 2; ++i) { int R, C; stage_rc(tid * 16 + i * 8192, R, C); const int Rb = Epi::PERM ? ((R & ~31) + perm32(R & 31)) : R;
        voffA[i] = (unsigned)(R * g.lda + C) * 2u; voffB[i] = (unsigned)(Rb * g.ldb + C) * 2u; }
    const size_t kstep = (size_t)(BK * 2);
    const size_t hA = (size_t)HALF * g.lda * 2, hB = (size_t)HALF * g.ldb * 2;
    const size_t tA = 2 * hA, tB = 2 * hB;
    const unsigned ldsw = (unsigned)wid * 1024u;
    const int aoff = lds_byte(wr * 64 + fr, fq * 8), boff = lds_byte(wc * 32 + fr, fq * 8);
#define PG8_SA(b, h) (((b) * 2 + (h)) * HTB)
#define PG8_SB(b, h) ((4 + (b) * 2 + (h)) * HTB)
#define PG8_STAGE(bufoff, gbase, voff) do { _Pragma("unroll") for (int _i = 0; _i < 2; ++_i) \
        __builtin_amdgcn_global_load_lds((const unsigned*)((const char*)(gbase) + (voff)[_i]), (PG8_LAS unsigned*)(lds + (bufoff) + ldsw + _i * 8192), 16, 0, 0); } while (0)
#define PG8_LDA(dst, b, h) do { _Pragma("unroll") for (int m = 0; m < 4; ++m) _Pragma("unroll") for (int k = 0; k < 2; ++k) dst[m][k] = *(const PG8_LAS bf16x8*)(lds + PG8_SA(b, h) + aoff + m * 2048 + k * 1024); } while (0)
#define PG8_LDB(dst, b, h) do { _Pragma("unroll") for (int n = 0; n < 2; ++n) _Pragma("unroll") for (int k = 0; k < 2; ++k) dst[n][k] = *(const PG8_LAS bf16x8*)(lds + PG8_SB(b, h) + boff + n * 2048 + k * 1024); } while (0)
#define PG8_MMA(ai, bj, At, Bt) do { __builtin_amdgcn_s_setprio(1); _Pragma("unroll") for (int m = 0; m < 4; ++m) _Pragma("unroll") for (int n = 0; n < 2; ++n) _Pragma("unroll") for (int k = 0; k < 2; ++k) \
        acc[ai][bj][m][n] = __builtin_amdgcn_mfma_f32_16x16x32_bf16(Bt[n][k], At[m][k], acc[ai][bj][m][n], 0, 0, 0); __builtin_amdgcn_s_setprio(0); } while (0)
#define PG8_WAIT_V(n) asm volatile("s_waitcnt vmcnt(" #n ")" ::: "memory")
#define PG8_WAIT_L(n) asm volatile("s_waitcnt lgkmcnt(" #n ")" ::: "memory")
#define PG8_BAR __builtin_amdgcn_s_barrier()
#define PG8_SCHED __builtin_amdgcn_sched_barrier(0)
    Unit cur, nxt; int ui = 0;
    if (!S.next(0, cur)) return;
    f32x4 acc[2][2][4][2];
#pragma unroll
    for (int a = 0; a < 2; ++a)
#pragma unroll
        for (int b = 0; b < 2; ++b)
#pragma unroll
            for (int m = 0; m < 4; ++m)
#pragma unroll
                for (int n = 0; n < 2; ++n) acc[a][b][m][n] = (f32x4){0.f, 0.f, 0.f, 0.f};
    bf16x8 At[4][2], B0[2][2], B1[2][2];
    const char* cA = (const char*)g.A + (size_t)cur.pm * tA; const char* cB = (const char*)g.Bt + (size_t)cur.pn * tB;
    PG8_STAGE(PG8_SB(0, 0), cB, voffB); PG8_STAGE(PG8_SB(0, 1), cB + hB, voffB); PG8_STAGE(PG8_SA(0, 0), cA, voffA); PG8_STAGE(PG8_SA(0, 1), cA + hA, voffA);
    if (wr == 1) PG8_BAR;
    PG8_WAIT_V(2); PG8_BAR;
    PG8_STAGE(PG8_SB(1, 0), cB + kstep, voffB); PG8_STAGE(PG8_SA(1, 0), cA + kstep, voffA); PG8_STAGE(PG8_SB(1, 1), cB + hB + kstep, voffB);
    PG8_WAIT_V(6); PG8_BAR;
    for (;;) {
        const bool has_next = S.next(ui + 1, nxt);
        const char* nA = has_next ? (const char*)g.A + (size_t)nxt.pm * tA : cA; const char* nB = has_next ? (const char*)g.Bt + (size_t)nxt.pn * tB : cB;
        for (int t = 0; t < nt; t += 2) {
            const bool last = (t == nt - 2);
            const char* a1 = cA + (size_t)(t + 1) * kstep;
            const char* a2 = last ? nA : cA + (size_t)(t + 2) * kstep; const char* b2 = last ? nB : cB + (size_t)(t + 2) * kstep;
            const char* a3 = a2 + kstep; const char* b3 = b2 + kstep;
            PG8_LDB(B0, 0, 0); PG8_LDB(B1, 0, 1); PG8_SCHED; PG8_LDA(At, 0, 0); PG8_STAGE(PG8_SA(1, 1), a1 + hA, voffA);
            PG8_WAIT_V(8); PG8_WAIT_L(0); PG8_BAR; PG8_MMA(0, 0, At, B0); PG8_MMA(0, 1, At, B1); PG8_BAR; PG8_SCHED;
            PG8_LDA(At, 0, 1); PG8_STAGE(PG8_SB(0, 0), b2, voffB); PG8_STAGE(PG8_SB(0, 1), b2 + hB, voffB); PG8_STAGE(PG8_SA(0, 0), a2, voffA);
            PG8_WAIT_V(8); PG8_WAIT_L(0); PG8_BAR; PG8_MMA(1, 0, At, B0); PG8_MMA(1, 1, At, B1); PG8_BAR; PG8_SCHED;
            PG8_LDB(B0, 1, 0); PG8_LDB(B1, 1, 1); PG8_SCHED; PG8_LDA(At, 1, 0); PG8_STAGE(PG8_SA(0, 1), a2 + hA, voffA);
            PG8_WAIT_V(8); PG8_WAIT_L(0); PG8_BAR; PG8_MMA(0, 0, At, B0); PG8_MMA(0, 1, At, B1); PG8_BAR; PG8_SCHED;
            PG8_LDA(At, 1, 1); PG8_STAGE(PG8_SB(1, 0), b3, voffB); PG8_STAGE(PG8_SB(1, 1), b3 + hB, voffB); PG8_STAGE(PG8_SA(1, 0), a3, voffA);
            PG8_WAIT_V(8); PG8_WAIT_L(0); PG8_BAR; PG8_MMA(1, 0, At, B0); PG8_MMA(1, 1, At, B1); PG8_BAR; PG8_SCHED;
        }
        if (wr == 0) PG8_BAR;
        if constexpr (!Epi::AFTER_DRAIN) E(acc, cur, wr, wc, fr, fq);
        if (!has_next) break;
#pragma unroll
        for (int a = 0; a < 2; ++a)
#pragma unroll
            for (int b = 0; b < 2; ++b)
#pragma unroll
                for (int m = 0; m < 4; ++m)
#pragma unroll
                    for (int n = 0; n < 2; ++n) acc[a][b][m][n] = (f32x4){0.f, 0.f, 0.f, 0.f};
        cur = nxt; cA = nA; cB = nB; ++ui;
        if (wr == 1) PG8_BAR;
    }
    PG8_WAIT_V(0);
    PG8_BAR;
    if constexpr (Epi::AFTER_DRAIN) E(acc, cur, wr, wc, fr, fq);
#undef PG8_SA
#undef PG8_SB
#undef PG8_STAGE
#undef PG8_LDA
#undef PG8_LDB
#undef PG8_MMA
#undef PG8_WAIT_V
#undef PG8_WAIT_L
#undef PG8_BAR
#undef PG8_SCHED
}
}

#include <hip/hip_bf16.h>
#include <cmath>
namespace attn_body {
using bf16=__hip_bfloat16;
using bf16x8=__attribute__((ext_vector_type(8)))short;
using s16x4=__attribute__((ext_vector_type(4)))short;
using f32x16=__attribute__((ext_vector_type(16)))float;
using u32x4=__attribute__((ext_vector_type(4)))unsigned;
constexpr int BATCH=4,NHEAD=16,SEQ=4096,D=64,DM=NHEAD*D;
constexpr int NW=8,QBLK=32,QB=QBLK*NW,KVBLK=64,NQB=SEQ/QB;
constexpr int ATTN_PITCH=DM, ATTN_UNIT_ROWS=QB;
__device__ __forceinline__ int crow(int r,int hi){return (r&3)+8*(r>>2)+4*hi;}
#define SBAR() __builtin_amdgcn_sched_barrier(0)
__device__ __forceinline__ void cmask(f32x16&p0,f32x16&p1,int jb,int qrel,int hi){
  const float NEG=-INFINITY; int kb=64*jb+4*hi;
  #pragma unroll
  for(int r=0;r<16;++r){int kv=kb+(r&3)+8*(r>>2); if(kv>qrel)p0[r]=NEG; if(kv+32>qrel)p1[r]=NEG;}
}

constexpr int NSLOT=3, SLOTB=8192;
constexpr int LDS_K=0, LDS_V=NSLOT*SLOTB, LDS_WS=2*NSLOT*SLOTB, LDS_OST=LDS_WS+NW*64*4, LDS_KBIAS=LDS_OST+NW*4096, LDS_BYTES=LDS_KBIAS+(SEQ+64)*4;
constexpr float C2=0.125f*1.4426950408889634f;
__device__ __forceinline__ void glds16(const void*gsrc,unsigned lds_dst){unsigned keep;
  asm volatile("s_mov_b32 %0, m0\n\ts_mov_b32 m0, %2\n\ts_nop 0\n\tglobal_load_lds_dwordx4 %1, off\n\ts_mov_b32 m0, %0":"=&s"(keep):"v"(gsrc),"s"(lds_dst):"memory");}
__device__ __forceinline__ float max3f(float a,float b,float c){float r;asm("v_max3_f32 %0, %1, %2, %3":"=v"(r):"v"(a),"v"(b),"v"(c));return r;}
__device__ __forceinline__ float max2f(float a,float b){float r;asm("v_max_f32_e32 %0, %1, %2":"=v"(r):"v"(a),"v"(b));return r;}
__device__ __forceinline__ float fadd_s(float a,float b){float r;asm("v_add_f32_e32 %0, %1, %2":"=v"(r):"v"(a),"v"(b));return r;}
__device__ __forceinline__ float fsub_s(float a,float b){float r;asm("v_sub_f32_e32 %0, %1, %2":"=v"(r):"v"(a),"v"(b));return r;}
typedef float f32x2_t __attribute__((ext_vector_type(2))); typedef __bf16 bf16x2_t __attribute__((ext_vector_type(2)));
__device__ __forceinline__ unsigned cvtpk_s(float lo,float hi){f32x2_t v={lo,hi};bf16x2_t b=__builtin_convertvector(v,bf16x2_t);return __builtin_bit_cast(unsigned,b);}
#define WAIT_BAR(N) asm volatile("s_waitcnt vmcnt(" #N ") lgkmcnt(0)\n\ts_barrier":::"memory")

__device__ __forceinline__ void qkt(f32x16&p0,f32x16&p1,const char*Kslot,const bf16x8*qr,int r32,int hi){
  const char*kb=Kslot+hi*1024+r32*16;
  #pragma unroll
  for(int d0=0;d0<4;++d0){
    const bf16x8 b0=*reinterpret_cast<const bf16x8*>(kb+d0*2048);
    const bf16x8 b1=*reinterpret_cast<const bf16x8*>(kb+d0*2048+512);
    {p0=__builtin_amdgcn_mfma_f32_32x32x16_bf16(b0,qr[d0],p0,0,0,0);p1=__builtin_amdgcn_mfma_f32_32x32x16_bf16(b1,qr[d0],p1,0,0,0);}}
}
typedef __attribute__((address_space(3))) const char* lds_cptr;
typedef short v4i16_t __attribute__((ext_vector_type(4)));
__device__ __forceinline__ void kload8(bf16x8*kf,lds_cptr kp){
  kf[0]=*(const __attribute__((address_space(3))) bf16x8*)(kp);      kf[1]=*(const __attribute__((address_space(3))) bf16x8*)(kp+512);
  kf[2]=*(const __attribute__((address_space(3))) bf16x8*)(kp+2048); kf[3]=*(const __attribute__((address_space(3))) bf16x8*)(kp+2560);
  kf[4]=*(const __attribute__((address_space(3))) bf16x8*)(kp+4096); kf[5]=*(const __attribute__((address_space(3))) bf16x8*)(kp+4608);
  kf[6]=*(const __attribute__((address_space(3))) bf16x8*)(kp+6144); kf[7]=*(const __attribute__((address_space(3))) bf16x8*)(kp+6656);
}
__device__ __forceinline__ void kload2(bf16x8*kf,lds_cptr kp,int j){ kf[2*j]=*(const __attribute__((address_space(3))) bf16x8*)(kp+j*2048); kf[2*j+1]=*(const __attribute__((address_space(3))) bf16x8*)(kp+j*2048+512); }
__device__ __forceinline__ s16x4 vtr(lds_cptr p){ return __builtin_bit_cast(s16x4,__builtin_amdgcn_ds_read_tr16_b64_v4i16((__attribute__((address_space(3))) v4i16_t*)p)); }
__device__ __forceinline__ float rowmax(const f32x16&p0,const f32x16&p1){
  float a=max3f(p0[0],p0[1],p1[0]),b=max3f(p0[2],p0[3],p1[1]);a=max3f(a,p1[2],p1[3]);
  #pragma unroll
  for(int r=4;r<16;r+=4){a=max3f(a,p0[r],p0[r+1]);b=max3f(b,p0[r+2],p0[r+3]);a=max3f(a,p1[r],p1[r+1]);b=max3f(b,p1[r+2],p1[r+3]);}
  const float m=max2f(a,b);
  auto rr=__builtin_amdgcn_permlane32_swap(__float_as_uint(m),__float_as_uint(m),false,false);
  return max2f(__uint_as_float(rr[0]),__uint_as_float(rr[1]));
}
__device__ __forceinline__ void pv(f32x16*o,int vb,bf16x8 pa0,bf16x8 pa1,bf16x8 pa2,bf16x8 pa3){
  #pragma unroll
  for(int d0=0;d0<2;++d0){s16x4 lo[4],hi[4];
    #pragma unroll
    for(int ks=0;ks<4;++ks){
      asm volatile("ds_read_b64_tr_b16 %0,%1 offset:%c2":"=&v"(lo[ks]):"v"(vb),"i"(d0*4096+ks*1024):"memory");
      asm volatile("ds_read_b64_tr_b16 %0,%1 offset:%c2":"=&v"(hi[ks]):"v"(vb),"i"(d0*4096+ks*1024+512):"memory");}
    asm volatile("s_waitcnt lgkmcnt(0)":::"memory");SBAR();
    #define PK(k) (bf16x8){lo[k][0],lo[k][1],lo[k][2],lo[k][3],hi[k][0],hi[k][1],hi[k][2],hi[k][3]}
    o[d0]=__builtin_amdgcn_mfma_f32_32x32x16_bf16(pa0,PK(0),o[d0],0,0,0);
    o[d0]=__builtin_amdgcn_mfma_f32_32x32x16_bf16(pa1,PK(1),o[d0],0,0,0);
    o[d0]=__builtin_amdgcn_mfma_f32_32x32x16_bf16(pa2,PK(2),o[d0],0,0,0);
    o[d0]=__builtin_amdgcn_mfma_f32_32x32x16_bf16(pa3,PK(3),o[d0],0,0,0);
    #undef PK
  }
}

#ifndef ATTN_STORE16
#define ATTN_STORE16(p,v) (*(u32x4*)(p)=(v))
#endif
template<int THRL> __device__ __forceinline__ void attn_unit(int b,int h,int qb,const bf16*Q,const bf16*__restrict__ K,const bf16*__restrict__ V,bf16*O,const float*__restrict__ KBg,const float skip_thr,char*shm){
  int tid_=threadIdx.x; asm volatile("":"+v"(tid_)); const int tid=tid_,lane=tid&63,r32=lane&31,hi=lane>>5; const int wid=__builtin_amdgcn_readfirstlane(tid>>6);
  const long rowbase=(long)b*SEQ; const int q0=qb*QB;
  const bf16*Qw=Q+(rowbase+q0+wid*QBLK)*DM+h*D;
  const int NTF=(q0+QB)/KVBLK; int t0=0;
  { const float*kbg=KBg+(long)(b*NHEAD+h)*SEQ; const float kq=kbg[q0]; bool sk=false; if(lane<NTF-4) sk=(kq-kbg[64*lane+63])>skip_thr;
    const unsigned long long mk=__ballot(sk); t0=(mk==~0ull)?64:__builtin_ctzll(~mk); t0&=~1; if(t0>NTF-4)t0=NTF-4; t0=__builtin_amdgcn_readfirstlane(t0); }
  const bf16*Kh=K+(rowbase+(long)t0*KVBLK)*DM+h*D,*Vh=V+(rowbase+(long)t0*KVBLK)*DM+h*D;
  const lds_cptr shm3=(lds_cptr)shm;
  const unsigned lds0=(unsigned)(uintptr_t)shm;
  float*wsf=(float*)(shm+LDS_WS)+wid*64;
  const bf16*ksrc=Kh+(long)lane*DM+wid*8;
  const bf16*vsrc=Vh+(long)(16*(wid&3)+(lane>>2))*DM+(wid>>2)*32+(lane&3)*8;
  const unsigned kdst=lds0+LDS_K+wid*1024, vdst=lds0+LDS_V+wid*1024;
  #define DMA_K(t,slot) glds16(ksrc+(long)(t)*KVBLK*DM,(unsigned)__builtin_amdgcn_readfirstlane(kdst+(slot)))
  #define DMA_V(t,slot) glds16(vsrc+(long)(t)*KVBLK*DM,(unsigned)__builtin_amdgcn_readfirstlane(vdst+(slot)))
  const int vb0=(int)(lds0+LDS_V)+((lane>>4)&1)*32+(lane&3)*8+(4*hi+((lane&15)>>2))*64;
  const char*Kbase=shm+LDS_K; bf16x8 kf[8];
  const lds_cptr kp0=shm3+LDS_K+hi*1024+r32*16; const lds_cptr vp0=shm3+LDS_V+((lane>>4)&1)*32+(lane&3)*8+(4*hi+((lane&15)>>2))*64;
  const int NT=NTF-t0;
  DMA_K(0,0);DMA_V(0,0);DMA_K(1,SLOTB);
  typedef __attribute__((address_space(3))) float* lds_fptr; typedef float f32x4_t __attribute__((ext_vector_type(4)));
  const lds_fptr kbL=(lds_fptr)(shm3+LDS_KBIAS);
  { const float*kbsrc=KBg+(long)(b*NHEAD+h)*SEQ+64*t0; int i0_=4*tid; asm volatile("":"+v"(i0_));   for(int i=i0_;i<64*NT;i+=4*NW*64) *(__attribute__((address_space(3))) f32x4_t*)(kbL+i)=*(const f32x4_t*)(kbsrc+i); }
  #define KBLOAD(P0,P1,t) do{ int h4_=4*hi; asm volatile("":"+v"(h4_));   const lds_fptr kq_=kbL+64*(t)+h4_; _Pragma("unroll") for(int i_=0;i_<4;++i_){ const f32x4_t a_=*(const __attribute__((address_space(3))) f32x4_t*)(kq_+8*i_); const f32x4_t b_=*(const __attribute__((address_space(3))) f32x4_t*)(kq_+32+8*i_); \
      P0[4*i_]=a_[0];P0[4*i_+1]=a_[1];P0[4*i_+2]=a_[2];P0[4*i_+3]=a_[3]; P1[4*i_]=b_[0];P1[4*i_+1]=b_[1];P1[4*i_+2]=b_[2];P1[4*i_+3]=b_[3]; } }while(0)
  bf16x8 qr[4];
  #pragma unroll
  for(int d0=0;d0<4;++d0)qr[d0]=*reinterpret_cast<const bf16x8*>(&Qw[(long)r32*DM+d0*16+hi*8]);
  float mhat=0.f,l_reg=0.f;f32x16 o[2];o[0]=f32x16{};o[1]=f32x16{};
  const int qrel=wid*QBLK+r32;
  #define CMASK(P0,P1,t) do{int jb_=(t)-(NT-4); if(jb_>=0)cmask(P0,P1,jb_,qrel,hi);}while(0)
  bool resc=false;
  #define START(P0,P1) do{ const float rm=rowmax(P0,P1); resc=false; \
    { const float dl=rm; mhat=fadd_s(mhat,dl); \
      _Pragma("unroll") for(int r=0;r<16;++r){P0[r]=fsub_s(P0[r],dl);P1[r]=fsub_s(P1[r],dl);} } \
    _Pragma("unroll") for(int r=0;r<16;++r)P0[r]=__builtin_amdgcn_exp2f(P0[r]); }while(0)
  #define RESC() do{ if(resc){ asm volatile("s_waitcnt lgkmcnt(0)":::"memory"); \
      _Pragma("unroll") for(int d_=0;d_<2;++d_) _Pragma("unroll") for(int r=0;r<16;++r)o[d_][r]*=wsf[crow(r,hi)]; } }while(0)
  f32x16 pA0,pA1,pB0,pB1;
  int sl_prev=0,sl_cur=0,sl_next=SLOTB;
  #define ROT() do{sl_prev=sl_cur;sl_cur=sl_next;sl_next=(sl_next==(NSLOT-1)*SLOTB)?0:sl_next+SLOTB;}while(0)
  DMA_K(2,2*SLOTB);
  WAIT_BAR(3);
  KBLOAD(pA0,pA1,0);
  qkt(pA0,pA1,Kbase,qr,r32,hi);asm volatile("s_nop 15\n\ts_nop 7":"+v"(pA0),"+v"(pA1));CMASK(pA0,pA1,0);
  START(pA0,pA1);
  KBLOAD(pB0,pB1,1);
  _Pragma("unroll") for(int r=0;r<16;++r){pB0[r]-=mhat;pB1[r]-=mhat;}
  _Pragma("unroll") for(int r=0;r<16;++r)pA1[r]=__builtin_amdgcn_exp2f(pA1[r]);
  WAIT_BAR(0);
  DMA_K(3,0);DMA_V(1,SLOTB);
  ROT();
  kload8(kf,kp0+sl_cur);
  WAIT_BAR(2);
  s16x4 vlo[8],vhi[8]; u32x4 pw0,pw1,pw2,pw3;
  #define PKW(P,B) cvtpk_s(P[B],P[B+1])
  #define PAF(k) __builtin_bit_cast(bf16x8,pw##k)
  #define VFR(i) (bf16x8){vlo[i][0],vlo[i][1],vlo[i][2],vlo[i][3],vhi[i][0],vhi[i][1],vhi[i][2],vhi[i][3]}
  #define PIN(x) asm volatile("":"+v"(x))
  #define MX3(a,b,c) __builtin_fmaxf(__builtin_fmaxf((a),(b)),(c))
  #define GAPA(MF,A0,A1,A2,A3,W0,W1,PW) do{ MF; sacc+=A0; sacc+=A1; sacc+=A2; sacc+=A3; PIN(sacc); W0; W1; PIN(PW); SBAR(); }while(0)
  #define EX(v) __builtin_amdgcn_exp2f(v)
  #define GAPB(MF,X,B) do{ MF; X[B]=EX(X[B]); X[B+1]=EX(X[B+1]); X[B+2]=EX(X[B+2]); X[B+3]=EX(X[B+3]); PIN(X); SBAR(); }while(0)
  #define VRD(i) do{ vlo[i]=vtr(vp_+(((i)>>2)*4096+((i)&3)*1024)); vhi[i]=vtr(vp_+(((i)>>2)*4096+((i)&3)*1024+512)); }while(0)
  #define KRD(G,j) do{ if(G){ kload2(kf,kp0+sl_next,j); SBAR(); } }while(0)
  #define NB(G,Y,B) do{ if(G){ Y[B]-=mhat; Y[B+1]-=mhat; Y[B+2]-=mhat; Y[B+3]-=mhat; PIN(Y); SBAR(); } }while(0)
  #define STEP(C0,C1,P0,P1,t,GK,GV,GL,GN) do{ SBAR(); \
    const lds_cptr vp_=vp0+sl_prev; \
    VRD(0); SBAR(); float sacc=(P0[0]+P0[1]); \
    GAPA(C0=__builtin_amdgcn_mfma_f32_32x32x16_bf16(kf[0],qr[0],C0,0,0,0), P0[2],P0[3],P0[4],P0[5],     pw0[0]=PKW(P0,0), pw0[1]=PKW(P0,2), pw0); \
    VRD(4); SBAR(); GAPA(C1=__builtin_amdgcn_mfma_f32_32x32x16_bf16(kf[1],qr[0],C1,0,0,0), P0[6],P0[7],P0[8],P0[9],     pw0[2]=PKW(P0,4), pw0[3]=PKW(P0,6), pw0); \
    VRD(1); SBAR(); GAPA(C0=__builtin_amdgcn_mfma_f32_32x32x16_bf16(kf[2],qr[1],C0,0,0,0),   P0[10],P0[11],P0[12],P0[13], pw1[0]=PKW(P0,8), pw1[1]=PKW(P0,10), pw1); \
    VRD(5); SBAR(); GAPA(C1=__builtin_amdgcn_mfma_f32_32x32x16_bf16(kf[3],qr[1],C1,0,0,0),   P0[14],P0[15],P1[0],P1[1],   pw1[2]=PKW(P0,12),pw1[3]=PKW(P0,14), pw1); \
    VRD(2); SBAR(); GAPA(C0=__builtin_amdgcn_mfma_f32_32x32x16_bf16(kf[4],qr[2],C0,0,0,0),   P1[2],P1[3],P1[4],P1[5],     pw2[0]=PKW(P1,0), pw2[1]=PKW(P1,2), pw2); \
    VRD(6); SBAR(); GAPA(C1=__builtin_amdgcn_mfma_f32_32x32x16_bf16(kf[5],qr[2],C1,0,0,0),   P1[6],P1[7],P1[8],P1[9],     pw2[2]=PKW(P1,4), pw2[3]=PKW(P1,6), pw2); \
    VRD(3); SBAR(); GAPA(C0=__builtin_amdgcn_mfma_f32_32x32x16_bf16(kf[6],qr[3],C0,0,0,0),   P1[10],P1[11],P1[12],P1[13], pw3[0]=PKW(P1,8), pw3[1]=PKW(P1,10), pw3); \
    VRD(7); SBAR(); GAPA(C1=__builtin_amdgcn_mfma_f32_32x32x16_bf16(kf[7],qr[3],C1,0,0,0),   P1[14],P1[15],0.f,0.f,       pw3[2]=PKW(P1,12),pw3[3]=PKW(P1,14), pw3); \
    l_reg+=sacc; \
    if(GK){DMA_K((t)+3,sl_cur);} if(GV){DMA_V((t)+1,sl_next);} \
    CMASK(C0,C1,t); \
    { float a=MX3(C0[0],C0[1],C1[0]),b=MX3(C0[2],C0[3],C1[1]); a=MX3(a,C1[2],C1[3]); \
      _Pragma("unroll") for(int r=4;r<16;r+=4){a=MX3(a,C0[r],C0[r+1]);b=MX3(b,C0[r+2],C0[r+3]);a=MX3(a,C1[r],C1[r+1]);b=MX3(b,C1[r+2],C1[r+3]);} \
      float rm=__builtin_fmaxf(a,b); { auto rr=__builtin_amdgcn_permlane32_swap(__float_as_uint(rm),__float_as_uint(rm),false,false); rm=__builtin_fmaxf(__uint_as_float(rr[0]),__uint_as_float(rr[1])); } \
      resc=false; \
      if(__builtin_expect(__any(rm>(float)THRL),0)){ const float dl=__builtin_fmaxf(rm,0.f); mhat+=dl; \
        _Pragma("unroll") for(int r=0;r<16;++r){C0[r]-=dl;C1[r]-=dl;} \
        const float f=__builtin_amdgcn_exp2f(-dl); l_reg*=f; if(hi==0)wsf[r32]=f; resc=true; } } \
    if(GN){ KBLOAD(P0,P1,(t)+1); } \
    SBAR(); \
    GAPB(o[0]=__builtin_amdgcn_mfma_f32_32x32x16_bf16(PAF(0),VFR(0),o[0],0,0,0), C0,0); NB(GN,P0,0); \
    GAPB(o[1]=__builtin_amdgcn_mfma_f32_32x32x16_bf16(PAF(0),VFR(4),o[1],0,0,0), C0,4); NB(GN,P0,4); \
    KRD(GL,0); GAPB(o[0]=__builtin_amdgcn_mfma_f32_32x32x16_bf16(PAF(1),VFR(1),o[0],0,0,0), C0,8); NB(GN,P0,8); \
    KRD(GL,1); GAPB(o[1]=__builtin_amdgcn_mfma_f32_32x32x16_bf16(PAF(1),VFR(5),o[1],0,0,0), C0,12); NB(GN,P0,12); \
    KRD(GL,2); GAPB(o[0]=__builtin_amdgcn_mfma_f32_32x32x16_bf16(PAF(2),VFR(2),o[0],0,0,0), C1,0); NB(GN,P1,0); \
    KRD(GL,3); GAPB(o[1]=__builtin_amdgcn_mfma_f32_32x32x16_bf16(PAF(2),VFR(6),o[1],0,0,0), C1,4); NB(GN,P1,4); \
    GAPB(o[0]=__builtin_amdgcn_mfma_f32_32x32x16_bf16(PAF(3),VFR(3),o[0],0,0,0), C1,8); NB(GN,P1,8); \
    GAPB(o[1]=__builtin_amdgcn_mfma_f32_32x32x16_bf16(PAF(3),VFR(7),o[1],0,0,0), C1,12); NB(GN,P1,12); \
    }while(0)
  int t=1;
  #undef CMASK
  #define CMASK(P0,P1,t) do{}while(0)
  for(;t+5<NT;t+=2){
    STEP(pB0,pB1,pA0,pA1,t,true,true,true,true);     WAIT_BAR(2); RESC(); ROT();
    STEP(pA0,pA1,pB0,pB1,t+1,true,true,true,true);   WAIT_BAR(2); RESC(); ROT();
  }
  #undef CMASK
  #define CMASK(P0,P1,t) do{int jb_=(t)-(NT-4); if(jb_>=0)cmask(P0,P1,jb_,qrel,hi);}while(0)
  #define ENDW(tt) do{ if((tt)+3<NT){WAIT_BAR(2);} else if((tt)+2<NT){WAIT_BAR(1);} else {WAIT_BAR(0);} }while(0)
  for(;t+1<NT;t+=2){
    STEP(pB0,pB1,pA0,pA1,t,(t+3<NT),(t+1<NT),(t+1<NT),(t+1<NT));       ENDW(t);   RESC(); ROT();
    STEP(pA0,pA1,pB0,pB1,t+1,(t+4<NT),(t+2<NT),(t+2<NT),(t+2<NT));     ENDW(t+1); RESC(); ROT();
  }
  STEP(pB0,pB1,pA0,pA1,NT-1,false,false,false,false); RESC();
  { float sacc=pB0[0]+pB0[1]; _Pragma("unroll") for(int r=2;r<16;++r)sacc+=pB0[r]; _Pragma("unroll") for(int r=0;r<16;++r)sacc+=pB1[r]; l_reg+=sacc;
    pw0=(u32x4){PKW(pB0,0),PKW(pB0,2),PKW(pB0,4),PKW(pB0,6)};pw1=(u32x4){PKW(pB0,8),PKW(pB0,10),PKW(pB0,12),PKW(pB0,14)};pw2=(u32x4){PKW(pB1,0),PKW(pB1,2),PKW(pB1,4),PKW(pB1,6)};pw3=(u32x4){PKW(pB1,8),PKW(pB1,10),PKW(pB1,12),PKW(pB1,14)};
    SBAR(); pv(o,vb0+sl_cur,PAF(0),PAF(1),PAF(2),PAF(3)); }
  #undef PKW
  #undef PAF
  #undef VFR
  #undef PIN
  #undef MX3
  #undef GAPA
  #undef GAPB
  #undef EX
  #undef VRD
  #undef KRD
  #undef NB
  #undef KBLOAD
  #undef STEP
  #undef ENDW
  {auto rr=__builtin_amdgcn_permlane32_swap(__float_as_uint(l_reg),__float_as_uint(l_reg),false,false);l_reg=__uint_as_float(rr[0])+__uint_as_float(rr[1]);}
  if(hi==0)wsf[32+r32]=l_reg;asm volatile("s_waitcnt lgkmcnt(0)":::"memory");
  float rli[16];
  #pragma unroll
  for(int r=0;r<16;++r)rli[r]=__builtin_amdgcn_rcpf(wsf[32+crow(r,hi)]);
  bf16*Ow=O+(rowbase+q0+wid*QBLK)*DM+h*D;
  { bf16*stg=(bf16*)(shm+LDS_OST)+wid*2048;
    #pragma unroll
    for(int r=0;r<16;++r){const int orow=crow(r,hi);
      #pragma unroll
      for(int d0=0;d0<2;++d0)stg[orow*64+d0*32+r32]=__float2bfloat16(o[d0][r]*rli[r]);}
    asm volatile("s_waitcnt lgkmcnt(0)":::"memory");
    #pragma unroll
    for(int i=0;i<4;++i){const int row=i*8+(lane>>3),ch=lane&7; const u32x4 v=*(const u32x4*)(stg+row*64+ch*8); ATTN_STORE16(Ow+(long)row*DM+ch*8,v);} }
  asm volatile("s_waitcnt lgkmcnt(0)\n\ts_barrier":::"memory");
  #undef DMA_K
  #undef DMA_V
  #undef CMASK
  #undef START
  #undef RESC
  #undef ROT
}
constexpr int ATTN_LDS_BYTES=LDS_BYTES;
struct AttnTensors { const bf16* Q; const bf16* K; const bf16* V; bf16* O; const float* KB; const float* qg; const float* kg; };
struct AttnUnit { int bh; int qb; };
struct StaticOrder {
  int vcu;
  __device__ __forceinline__ explicit StaticOrder(int grid,int block):vcu((block%8)*(grid/8)+block/8){}
  __device__ __forceinline__ bool next(int i,AttnUnit&u)const{ if(i>=4)return false; const int s=vcu&3; u.bh=vcu>>2; u.qb=(i==0)?s:(i==1)?7-s:(i==2)?8+s:15-s; return true; }
  __device__ __forceinline__ void a_ready(const AttnUnit&)const{}
  __device__ __forceinline__ void done(const AttnUnit&)const{}
};
__device__ __forceinline__ int attn_ticket(unsigned*ctr,unsigned myx){
  for(unsigned k=0;k<8;++k){ const unsigned q=(myx+k)&7u; const unsigned m=atomicAdd(ctr+64*q,1u); if(m<128u) return (int)(q*128u+m); }
  return -1;
}
template<class Sched,int THRL=60> __device__ __forceinline__ void attn_phase(char*lds,const AttnTensors&T,const Sched&S,unsigned*ctr,volatile __attribute__((address_space(3))) unsigned*slot,unsigned myx){
  float thr; { const int l=threadIdx.x&63; float a=fabsf(T.qg[l]),c=fabsf(T.kg[l]);
    for(int o=1;o<64;o<<=1){a=fmaxf(a,__shfl_xor(a,o));c=fmaxf(c,__shfl_xor(c,o));}
    thr=2.0f*(1.05f*a*c*64.0f*C2)+40.0f; }
  if(threadIdx.x==0) slot[0]=(unsigned)attn_ticket(ctr,myx);
  __syncthreads();
  int n=(int)slot[0];
  while(n>=0){
    int pre=-1; if(threadIdx.x==0) pre=attn_ticket(ctr,myx);
    const int m=n&127, bh=8*(n>>7)+(m&7);
    attn_unit<THRL>(bh/NHEAD,bh%NHEAD,(NQB-1)-(m>>3),T.Q,T.K,T.V,T.O,T.KB,thr,lds);
    if(threadIdx.x==0) slot[0]=(unsigned)pre;
    __syncthreads();
    n=(int)slot[0];
  }
}
#undef SBAR
#undef WAIT_BAR
}

constexpr int NWAVES = 8;
constexpr int BATCH = 4, SEQ = 4096, D = 1024, H = 16, HD = 64, FF = 4096;
constexpr int M = BATCH * SEQ;
constexpr int NQKV = 3 * D, WIN_LD = 3 * D + H;
constexpr int NG = 64, NP = 64, NC = 16, LCH = 16, NCHUNK = M / LCH  , KA = LCH * NC + 2 * NP  ;

constexpr size_t MiB = 1u << 20;
constexpr size_t WS_CTL = 0;
constexpr size_t WS_BAR = 256 * 1024;
constexpr size_t WS_LAMT = 3 * MiB;
constexpr size_t WS_LF = 1 * MiB, WS_KB = 2 * MiB;
constexpr size_t WS_WQKV = 4 * MiB, WS_WO = 10 * MiB, WS_W1A = 12 * MiB, WS_W2A = 20 * MiB, WS_W1B = 28 * MiB, WS_W2B = 36 * MiB, WS_WSSM = 44 * MiB, WS_WGLU = 46 * MiB;
constexpr size_t WS_BT3 = 50 * MiB, WS_WT1 = 62 * MiB;
constexpr size_t WS_XN = 70 * MiB;
constexpr size_t WS_QO = 102 * MiB, WS_K = 134 * MiB, WS_V = 166 * MiB;
constexpr size_t WS_O = 198 * MiB;
constexpr size_t WS_H = 102 * MiB;
constexpr size_t WS_AALL = 102 * MiB, WS_SBUF = 150 * MiB, WS_Z = 182 * MiB;
constexpr size_t WS_END = 230 * MiB;

constexpr int RING_OFF = 0, RING_BYTES = 131072;
constexpr int XCH_OFF = RING_BYTES;
constexpr int MISC_OFF = XCH_OFF + 8192;
constexpr int LDS_BYTES = 147456;

#define GAS __attribute__((address_space(1)))
#define LAS __attribute__((address_space(3)))
typedef unsigned short bf16;
typedef unsigned v4u __attribute__((ext_vector_type(4)));
typedef float f32x4 __attribute__((ext_vector_type(4)));
#define LDS_WAIT() asm volatile("s_waitcnt lgkmcnt(0)" ::: "memory")
__device__ __forceinline__ unsigned f2bf(float f) { unsigned u = __builtin_bit_cast(unsigned, f); return (u + 0x7fffu + ((u >> 16) & 1u)) >> 16; }
__device__ __forceinline__ unsigned pk2(float lo, float hi) { unsigned r; asm("v_cvt_pk_bf16_f32 %0, %1, %2" : "=v"(r) : "v"(lo), "v"(hi)); return r; }
__device__ __forceinline__ float wave_sum(float v) {
#pragma unroll
    for (int o = 1; o < 64; o <<= 1) v += __shfl_xor(v, o);
    return v;
}
__device__ __forceinline__ void sincos_d(double a, double& s, double& c) {
    const double k = rint(a * 0.63661977236758134308);
    double r = fma(-k, 1.57079632679489655800e+00, a); r = fma(-k, 6.12323399573676603587e-17, r);
    const int q = ((int)k) & 3;
    const double r2 = r * r;
    const double sp = r * (1.0 + r2 * (-1.0 / 6 + r2 * (1.0 / 120 + r2 * (-1.0 / 5040 + r2 * (1.0 / 362880 + r2 * (-1.0 / 39916800 + r2 * (1.0 / 6227020800.0)))))));
    const double cp = 1.0 + r2 * (-0.5 + r2 * (1.0 / 24 + r2 * (-1.0 / 720 + r2 * (1.0 / 40320 + r2 * (-1.0 / 3628800 + r2 * (1.0 / 479001600.0 + r2 * (-1.0 / 87178291200.0)))))));
    s = (q == 0) ? sp : (q == 1) ? cp : (q == 2) ? -sp : -cp;
    c = (q == 0) ? cp : (q == 1) ? -sp : (q == 2) ? -cp : sp;
}

#define XB_TMO      128
#define XB_XCNT(j)  (256  + 64 * (j))
#define XB_XSUB(j)  (1280 + 64 * (j))
#define XB_XGEN(j)  (2304 + 64 * (j))
#define XB_TOP      3328
#define XB_TOPGEN   3392
#define XCD_BAR_WORDS 3456
#define XB_SPIN_CAP (1u << 18)

__device__ __forceinline__ unsigned xb_ld(unsigned* p)              { return __hip_atomic_load(p, __ATOMIC_RELAXED, __HIP_MEMORY_SCOPE_AGENT); }
__device__ __forceinline__ unsigned xb_add(unsigned* p, unsigned v) { return __hip_atomic_fetch_add(p, v, __ATOMIC_RELAXED, __HIP_MEMORY_SCOPE_AGENT); }
__device__ __forceinline__ unsigned xb_xcc_id() { return (unsigned)__builtin_amdgcn_s_getreg((3 << 11) | 20) & 0xFu; }
#define XB_SPIN(cond, bar) do { unsigned _sp = 0; while (cond) { __builtin_amdgcn_s_sleep(1); \
    if ((++_sp & 255u) == 0u) { if (xb_ld(&(bar)[XB_TMO])) break; if (_sp > XB_SPIN_CAP) { atomicAdd(&(bar)[XB_TMO], 1u); break; } } } } while (0)

struct XcdBarrier {
    unsigned* bar; unsigned x;
    volatile LAS unsigned* st;
};

__device__ __forceinline__ XcdBarrier xcd_barrier_post(unsigned* bar, volatile LAS unsigned* st) {
    XcdBarrier b; b.bar = bar; b.x = xb_xcc_id(); b.st = st;
    if (threadIdx.x == 0) (void)xb_add(&bar[XB_XCNT(b.x)], 1u);
    return b;
}
__device__ __forceinline__ void xcd_barrier_complete(unsigned* bar, unsigned x, unsigned& nloc, unsigned& nx) {
    const unsigned G = gridDim.x * gridDim.y * gridDim.z;
    unsigned sum, cnt, mine, sp = 0u;
    for (;;) {
        sum = 0u; cnt = 0u; mine = 0u;
#pragma unroll
        for (unsigned j = 0; j < 16; ++j) { const unsigned c = xb_ld(&bar[XB_XCNT(j)]); sum += c; cnt += (c > 0u) ? 1u : 0u; mine = (j == x) ? c : mine; }
        if (sum == G) break;
        __builtin_amdgcn_s_sleep(1);
        if ((++sp & 255u) == 0u) { if (xb_ld(&bar[XB_TMO])) break; if (sp > XB_SPIN_CAP) { atomicAdd(&bar[XB_TMO], 1u); break; } }
    }
    nloc = mine > 0u ? mine : 1u; nx = cnt > 0u ? cnt : 1u;
}

__device__ __forceinline__ void xcd_barrier(const XcdBarrier& b) {
    asm volatile("s_waitcnt vmcnt(0)" ::: "memory");
    __syncthreads();
    if (threadIdx.x == 0) {
        unsigned* bar = b.bar;
        __builtin_amdgcn_s_waitcnt(0);
        unsigned nloc = b.st[0], nx = b.st[1];
        if (nloc == 0u) { xcd_barrier_complete(bar, b.x, nloc, nx); b.st[0] = nloc; b.st[1] = nx; }
        const unsigned old = xb_add(&bar[XB_XSUB(b.x)], 1u);
        const unsigned gen = old / nloc;
        if (old + 1u == (gen + 1u) * nloc) {
            __builtin_amdgcn_fence(__ATOMIC_RELEASE, "agent");
            asm volatile("s_waitcnt vmcnt(0)" ::: "memory");
            const unsigned og = xb_add(&bar[XB_TOP], 1u);
            const unsigned tg = og / nx;
            if (og + 1u == (tg + 1u) * nx) xb_add(&bar[XB_TOPGEN], 1u);
            else XB_SPIN(xb_ld(&bar[XB_TOPGEN]) == tg, bar);
            __builtin_amdgcn_fence(__ATOMIC_ACQUIRE, "agent");
            xb_add(&bar[XB_XGEN(b.x)], 1u);
            asm volatile("s_waitcnt vmcnt(0)" ::: "memory");
        } else {
            XB_SPIN(xb_ld(&bar[XB_XGEN(b.x)]) == gen, bar);
            __builtin_amdgcn_fence(__ATOMIC_ACQUIRE, "agent");
            asm volatile("s_waitcnt vmcnt(0)" ::: "memory");
        }
    }
    __syncthreads();
}

struct Args { const float* in[20]; float* out; unsigned char* ws; int ph_lo, ph_hi; };

typedef const __attribute__((address_space(4))) Args* KArgs;
__device__ __forceinline__ KArgs kargs() { KArgs p = (KArgs)__builtin_amdgcn_kernarg_segment_ptr(); asm volatile("" : "+s"(p)); return p; }
__device__ __forceinline__ void p0_transpose_item(const float* W, int ldw, int K, int ncols, bf16* WT, LAS float* scr, int item, int lane, const float* gk, int glu) {
    const int nblk = ncols / 32, kb = item / nblk, nb = item % nblk, k0 = 64 * kb, n0 = 32 * nb;
    int src0 = n0;
    if (glu == 1) src0 = ((n0 >> 7) & 1) * 1024 + 128 * (n0 >> 8) + (n0 & 127);
    if (glu == 2) src0 = (n0 & ~255) + 64 * ((n0 >> 5) & 3) + 32 * ((n0 >> 7) & 1);
#pragma unroll 8
    for (int i = 0; i < 32; ++i) { const int kk = 2 * i + (lane >> 5); const float g = gk ? gk[k0 + kk] : 1.0f; scr[kk * 33 + (lane & 31)] = __builtin_nontemporal_load(W + (size_t)(k0 + kk) * ldw + src0 + (lane & 31)) * g; }
    LDS_WAIT(); asm volatile("" ::: "memory");
    const int c = lane & 7;
#pragma unroll
    for (int j = 0; j < 4; ++j) { const int n = (lane >> 3) + 8 * j; const LAS float* s = scr + (8 * c) * 33 + n;
        v4u o; o.x = pk2(s[0 * 33], s[1 * 33]); o.y = pk2(s[2 * 33], s[3 * 33]); o.z = pk2(s[4 * 33], s[5 * 33]); o.w = pk2(s[6 * 33], s[7 * 33]);
        *(GAS v4u*)(WT + (size_t)(n0 + n) * K + k0 + 8 * c) = o; }
    LDS_WAIT(); asm volatile("" ::: "memory");
}

__device__ __forceinline__ void ssm_setup(LAS unsigned char* lds, int tid, unsigned* ctr, volatile LAS unsigned* slot) {
    KArgs a = kargs();
    const float* a_re = a->in[9]; const float* a_im = a->in[10]; const float* b_re = a->in[11]; const float* b_im = a->in[12];
    const float* c_re = a->in[13]; const float* c_im = a->in[14]; const float* log_dt = a->in[15];
    bf16* BT3 = (bf16*)(a->ws + WS_BT3); bf16* WT1 = (bf16*)(a->ws + WS_WT1);
    LAS float* lamp = (LAS float*)lds;
    LAS float* bbt = lamp + 17 * 64 * 2;
    LAS float* cct = bbt + 64 * 16 * 2;
    LAS float* Kt = cct + 16 * 64 * 2;
    for (;;) {
        if (tid == 0) slot[0] = atomicAdd(ctr, 1u);
        __syncthreads();
        const int w = (int)slot[0];
        if (w >= 4 * NG) break;
        const int g = w >> 2, q = w & 3;
        {
            LAS double* ld = (LAS double*)(Kt);
            if (tid < 64) { const int p = tid; const double dt = exp((double)log_dt[g]), are = (double)a_re[g * 64 + p], aim = (double)a_im[g * 64 + p];
                double sn, cs; sincos_d(dt * aim, sn, cs); const double mag = exp(dt * are); const double lr = mag * cs, li = mag * sn;
                const double nr = lr - 1.0, ni = li, den = are * are + aim * aim;
                ld[p * 4] = lr; ld[p * 4 + 1] = li; ld[p * 4 + 2] = (nr * are + ni * aim) / den; ld[p * 4 + 3] = (ni * are - nr * aim) / den;
                if (q == 0) { double pr = lr, pi = li; f32x4 o;
#pragma unroll 1
                    for (int sq = 0; sq < 9; ++sq) { if (sq == 4) { o.x = (float)pr; o.y = (float)pi; } const double t = pr * pr - pi * pi; pi = 2.0 * pr * pi; pr = t; }
                    o.z = (float)pr; o.w = (float)pi; *(f32x4*)((float*)(a->ws + WS_LAMT) + (size_t)(g * 64 + p) * 4) = o; } }
            __syncthreads();
#pragma unroll 1
            for (int idx = tid; idx < 17 * 64; idx += 512) { const int tau = idx >> 6, p = idx & 63; double br = ld[p * 4], bi = ld[p * 4 + 1], rr = 1.0, ri = 0.0;
#pragma unroll
                for (int bit = 0; bit < 5; ++bit) { if ((tau >> bit) & 1) { const double t = rr * br - ri * bi; ri = rr * bi + ri * br; rr = t; } const double t2 = br * br - bi * bi; bi = 2.0 * br * bi; br = t2; }
                lamp[idx * 2] = (float)rr; lamp[idx * 2 + 1] = (float)ri; }
#pragma unroll 1
            for (int idx = tid; idx < 64 * 16; idx += 512) { const int p = idx >> 4; const double sr = ld[p * 4 + 2], si = ld[p * 4 + 3];
                const double br = (double)b_re[g * 1024 + idx], bi = (double)b_im[g * 1024 + idx];
                bbt[idx * 2] = (float)(sr * br - si * bi); bbt[idx * 2 + 1] = (float)(sr * bi + si * br); }
        }
        for (int i = tid; i < 1024; i += 512) { cct[i * 2] = c_re[g * 1024 + i]; cct[i * 2 + 1] = c_im[g * 1024 + i]; }
        __syncthreads();
        {
            const int tau = tid >> 5, cp = (tid >> 1) & 15, c0 = (tid & 1) * 8; float sacc[8];
#pragma unroll
            for (int e = 0; e < 8; ++e) sacc[e] = 0.f;
#pragma unroll 2
            for (int p = 0; p < 64; ++p) { const float cr = cct[(cp * 64 + p) * 2], ci = cct[(cp * 64 + p) * 2 + 1], lr = lamp[(tau * 64 + p) * 2], li = lamp[(tau * 64 + p) * 2 + 1];
                const float dr = cr * lr - ci * li, di = cr * li + ci * lr;
                const LAS f32x4* bp = (const LAS f32x4*)(bbt + (p * 16 + c0) * 2);
#pragma unroll
                for (int e4 = 0; e4 < 4; ++e4) { const f32x4 b4 = bp[e4]; sacc[2 * e4] += dr * b4.x - di * b4.y; sacc[2 * e4 + 1] += dr * b4.z - di * b4.w; } }
#pragma unroll
            for (int e = 0; e < 8; ++e) Kt[tau * 256 + cp * 16 + c0 + e] = sacc[e] + ((tau == 0 && c0 + e == cp) ? a->in[16][16 * g + cp] : 0.f);
        }
        __syncthreads();
#pragma unroll 1
        for (int r = 0; r < 6; ++r) { const int pc = tid + 512 * r, rr = pc / 48, k8 = (pc % 48) * 8, n = 64 * q + rr, j = n >> 4, cp = n & 15; float v[8];
            if (k8 < 256) { const int s = k8 >> 4, c0 = k8 & 15;
#pragma unroll
                for (int e = 0; e < 8; ++e) v[e] = (j >= s) ? Kt[(j - s) * 256 + cp * 16 + c0 + e] : 0.f;
            } else { const int im = (k8 - 256) >> 6, p0 = (k8 - 256) & 63;
#pragma unroll
                for (int e = 0; e < 8; ++e) { const int p = p0 + e; const float cr = cct[(cp * 64 + p) * 2], ci = cct[(cp * 64 + p) * 2 + 1], lr = lamp[((j + 1) * 64 + p) * 2], li = lamp[((j + 1) * 64 + p) * 2 + 1];
                    v[e] = im ? -(cr * li + ci * lr) : (cr * lr - ci * li); } }
            v4u o; o.x = pk2(v[0], v[1]); o.y = pk2(v[2], v[3]); o.z = pk2(v[4], v[5]); o.w = pk2(v[6], v[7]);
            *(GAS v4u*)(BT3 + (size_t)(g * 256 + n) * KA + k8) = o; }
#pragma unroll 1
        for (int r = 0; r < 4; ++r) { const int pc = tid + 512 * r, rr = pc >> 5, k8 = (pc & 31) * 8, n = 64 * q + rr; float v[8];
            if (n < 128) { const int p = n & 63, im = n >> 6, s = k8 >> 4, c0 = k8 & 15; const float lr = lamp[((15 - s) * 64 + p) * 2], li = lamp[((15 - s) * 64 + p) * 2 + 1];
#pragma unroll
                for (int e = 0; e < 8; ++e) { const float br = bbt[(p * 16 + c0 + e) * 2], bi = bbt[(p * 16 + c0 + e) * 2 + 1]; v[e] = im ? (lr * bi + li * br) : (lr * br - li * bi); }
            } else {
#pragma unroll
                for (int e = 0; e < 8; ++e) v[e] = 0.f; }
            v4u o; o.x = pk2(v[0], v[1]); o.y = pk2(v[2], v[3]); o.z = pk2(v[4], v[5]); o.w = pk2(v[6], v[7]);
            *(GAS v4u*)(WT1 + (size_t)(g * 256 + n) * 256 + k8) = o; }
        __syncthreads();
    }
}

__device__ __forceinline__ void p0_prologue(LAS unsigned char* lds, int tid, int lane, int wave, int vcu, int G) {
    const int gw = vcu * NWAVES + wave, NGW = G * NWAVES;
    { KArgs a = kargs(); const float* nmix = a->in[1]; const float* nmlp = a->in[2]; const float* w_in = a->in[3]; unsigned char* ws = a->ws;
    LAS float* scr = (LAS float*)(lds + RING_OFF + wave * 16384);
    constexpr int I_QKV = (D / 64) * (NQKV / 32), I_O = (D / 64) * (D / 32), I_1 = (D / 64) * (FF / 32), I_2 = (FF / 64) * (D / 32), I_G = (D / 64) * (2 * D / 32);
    constexpr int NITEMS = I_QKV + I_O + 2 * I_1 + 2 * I_2 + I_O + I_G;
    for (int it = gw; it < NITEMS; it += NGW) {
        int r = it;
        if (r < I_1) { p0_transpose_item(a->in[18] + (size_t)D * FF, FF, D, FF, (bf16*)(ws + WS_W1B), scr, r, lane, nmlp + D, 0); continue; } r -= I_1;
        if (r < I_2) { p0_transpose_item(a->in[19] + (size_t)FF * D, D, FF, D, (bf16*)(ws + WS_W2B), scr, r, lane, nullptr, 0); continue; } r -= I_2;
        if (r < I_G) { p0_transpose_item(a->in[17], 2 * D, D, 2 * D, (bf16*)(ws + WS_WGLU), scr, r, lane, nullptr, 1); continue; } r -= I_G;
        if (r < I_O) { p0_transpose_item(a->in[8], D, D, D, (bf16*)(ws + WS_WSSM), scr, r, lane, nmix + D, 0); continue; } r -= I_O;
        if (r < I_2) { p0_transpose_item(a->in[19], D, FF, D, (bf16*)(ws + WS_W2A), scr, r, lane, nullptr, 0); continue; } r -= I_2;
        if (r < I_1) { p0_transpose_item(a->in[18], FF, D, FF, (bf16*)(ws + WS_W1A), scr, r, lane, nmlp, 0); continue; } r -= I_1;
        if (r < I_O) { p0_transpose_item(a->in[7], D, D, D, (bf16*)(ws + WS_WO), scr, r, lane, nullptr, 0); continue; } r -= I_O;
        p0_transpose_item(w_in, WIN_LD, D, NQKV, (bf16*)(ws + WS_WQKV), scr, r, lane, nullptr, 2);
    }
    }
    KArgs a = kargs(); const float* x = a->in[0]; const float* nmix = a->in[1]; const float* w_in = a->in[3]; const float* b_f = a->in[4]; unsigned char* ws = a->ws;
    { float* rs = (float*)(ws + WS_CTL); for (int i = blockIdx.x * 512 + tid; i < 3 * M; i += G * 512) rs[i] = 0.f; }
    __syncthreads();
    LAS float* wfT = (LAS float*)(lds + RING_OFF);
    for (int i = tid; i < D * H; i += 512) { const int k = i >> 4, h = i & 15; wfT[h * D + k] = w_in[(size_t)k * WIN_LD + NQKV + h]; }
    __syncthreads();
    bf16* XN = (bf16*)(ws + WS_XN); float* LF = (float*)(ws + WS_LF);
    for (int m = gw; m < M; m += NGW) {
        const GAS f32x4* xr = (const GAS f32x4*)(x + (size_t)m * D) + lane;
        f32x4 v[4]; float s = 0.f;
#pragma unroll
        for (int j = 0; j < 4; ++j) { v[j] = __builtin_nontemporal_load(xr + 64 * j); s += (v[j].x * v[j].x + v[j].y * v[j].y) + (v[j].z * v[j].z + v[j].w * v[j].w); }
        const float ssx = wave_sum(s); const float rs = 1.0f / sqrtf(ssx * (1.f / D) + 1e-6f);
        if (lane == 0) ((float*)(ws + WS_CTL))[3 * M + m] = ssx;
        GAS unsigned long long* o8 = (GAS unsigned long long*)(XN + (size_t)m * D) + lane;
#pragma unroll
        for (int j = 0; j < 4; ++j) { const f32x4 g4 = *(const f32x4*)(nmix + 256 * j + 4 * lane); v[j] = v[j] * rs * g4;
            o8[64 * j] = (unsigned long long)pk2(v[j].x, v[j].y) | ((unsigned long long)pk2(v[j].z, v[j].w) << 32); }
        float acc[16];
#pragma unroll
        for (int h = 0; h < 16; ++h) { float t = 0.f, t2 = 0.f; if ((h & 3) == 0) asm volatile("" ::: "memory");
#pragma unroll
            for (int j = 0; j < 4; ++j) { const f32x4 w4 = *(const LAS f32x4*)(wfT + h * D + 256 * j + 4 * lane);
                if (j & 1) { t2 = __builtin_fmaf(v[j].x, w4.x, t2); t2 = __builtin_fmaf(v[j].y, w4.y, t2); t2 = __builtin_fmaf(v[j].z, w4.z, t2); t2 = __builtin_fmaf(v[j].w, w4.w, t2); }
                else { t = __builtin_fmaf(v[j].x, w4.x, t); t = __builtin_fmaf(v[j].y, w4.y, t); t = __builtin_fmaf(v[j].z, w4.z, t); t = __builtin_fmaf(v[j].w, w4.w, t); } }
            acc[h] = t + t2; }
#pragma unroll
        for (int i = 0; i < 8; ++i) { const bool hi = (lane & 32) != 0; const float send = hi ? acc[i] : acc[i + 8], keep = hi ? acc[i + 8] : acc[i]; acc[i] = keep + __shfl_xor(send, 32); }
#pragma unroll
        for (int i = 0; i < 4; ++i) { const bool hi = (lane & 16) != 0; const float send = hi ? acc[i] : acc[i + 4], keep = hi ? acc[i + 4] : acc[i]; acc[i] = keep + __shfl_xor(send, 16); }
#pragma unroll
        for (int i = 0; i < 2; ++i) { const bool hi = (lane & 8) != 0; const float send = hi ? acc[i] : acc[i + 2], keep = hi ? acc[i + 2] : acc[i]; acc[i] = keep + __shfl_xor(send, 8); }
        { const bool hi = (lane & 4) != 0; const float send = hi ? acc[0] : acc[1], keep = hi ? acc[1] : acc[0]; acc[0] = keep + __shfl_xor(send, 4); }
        float f = acc[0]; f += __shfl_xor(f, 2); f += __shfl_xor(f, 1);
        const int hh = lane >> 2;
        const float z = f + b_f[hh];
        const float lf = fminf(z, 0.f) - 0.6931471805599453f * __builtin_amdgcn_logf(1.0f + __builtin_amdgcn_exp2f(-1.4426950408889634f * fabsf(z)));
        if ((lane & 3) == 0) LF[(size_t)((m >> 12) * 16 + hh) * SEQ + (m & (SEQ - 1))] = lf;
    }
}

__device__ __forceinline__ void cumsum_phase(LAS unsigned char* lds, int tid, int lane, int wave) {
    KArgs a = kargs();
    const float* LF = (const float*)(a->ws + WS_LF); float* KB = (float*)(a->ws + WS_KB);
    LAS float* wsum = (LAS float*)(lds + MISC_OFF);
    for (int bh = blockIdx.x; bh < BATCH * H; bh += gridDim.x) {
        const float* src = LF + (size_t)bh * SEQ + 8 * tid;
        const f32x4 a0 = *(const f32x4*)src, a1 = *(const f32x4*)(src + 4);
        float p[8]; p[0] = a0.x; p[1] = p[0] + a0.y; p[2] = p[1] + a0.z; p[3] = p[2] + a0.w; p[4] = p[3] + a1.x; p[5] = p[4] + a1.y; p[6] = p[5] + a1.z; p[7] = p[6] + a1.w;
        float incl = p[7];
#pragma unroll
        for (int o = 1; o < 64; o <<= 1) { const float t = __shfl_up(incl, o); if (lane >= o) incl += t; }
        if (lane == 63) wsum[wave] = incl;
        __syncthreads();
        float off = incl - p[7];
        for (int w = 0; w < wave; ++w) off += wsum[w];
        f32x4 o0, o1;
        o0.x = -(p[0] + off) * 1.4426950408889634f; o0.y = -(p[1] + off) * 1.4426950408889634f; o0.z = -(p[2] + off) * 1.4426950408889634f; o0.w = -(p[3] + off) * 1.4426950408889634f;
        o1.x = -(p[4] + off) * 1.4426950408889634f; o1.y = -(p[5] + off) * 1.4426950408889634f; o1.z = -(p[6] + off) * 1.4426950408889634f; o1.w = -(p[7] + off) * 1.4426950408889634f;
        float* dst = KB + (size_t)bh * SEQ + 8 * tid;
        *(f32x4*)dst = o0; *(f32x4*)(dst + 4) = o1;
        __syncthreads();
    }
}

template <bool FROM_LDS> __device__ __forceinline__ void scan_phase(LAS unsigned char* lds, int lane, int wave, int vcu) {
    KArgs a = kargs();
    const float* SB = (const float*)(a->ws + WS_SBUF); bf16* AA = (bf16*)(a->ws + WS_AALL);
    LAS float* est = (LAS float*)(lds + (FROM_LDS ? 256 * pg8::SL_PITCH * 4 : RING_OFF));
    const LAS float* SL = (const LAS float*)(lds + RING_OFF);
    for (int w = vcu; w < NG * BATCH; w += gridDim.x) {
        const int g = w >> 2, b = w & 3, p = lane;
        const f32x4 lt = *(const f32x4*)((const float*)(a->ws + WS_LAMT) + (size_t)(g * 64 + p) * 4);
        const float l16r = lt.x, l16i = lt.y, l512r = lt.z, l512i = lt.w;
        const size_t row0 = (size_t)g * 1024 + b * 256 + 32 * wave;
        float sr[32], si[32];
#pragma unroll
        for (int i = 0; i < 32; ++i) { if (FROM_LDS) { sr[i] = SL[(32 * wave + i) * pg8::SL_PITCH + p]; si[i] = SL[(32 * wave + i) * pg8::SL_PITCH + 64 + p]; } else { sr[i] = SB[(row0 + i) * 128 + p]; si[i] = SB[(row0 + i) * 128 + 64 + p]; } }
        float xr = 0.f, xi = 0.f;
#pragma unroll
        for (int i = 0; i < 32; ++i) { const float nr = l16r * xr - l16i * xi + sr[i], ni = l16r * xi + l16i * xr + si[i]; xr = nr; xi = ni; sr[i] = xr; si[i] = xi; }
        est[(wave * 64 + p) * 2] = xr; est[(wave * 64 + p) * 2 + 1] = xi;
        __syncthreads();
        float pr = 0.f, pi = 0.f;
        for (int v = 0; v < wave; ++v) { const float er = est[(v * 64 + p) * 2], ei = est[(v * 64 + p) * 2 + 1]; const float nr = l512r * pr - l512i * pi + er, ni = l512r * pi + l512i * pr + ei; pr = nr; pi = ni; }
        float qr = 0.f, qi = 0.f;
#pragma unroll
        for (int i = 0; i < 32; ++i) { bf16* dst = AA + (row0 + i) * KA + 256 + p;
            { const unsigned pkd = pk2(qr + pr, qi + pi); dst[0] = (bf16)(pkd & 0xffffu); dst[64] = (bf16)(pkd >> 16); }
            qr = sr[i]; qi = si[i];
            const float nr = l16r * pr - l16i * pi, ni = l16r * pi + l16i * pr; pr = nr; pi = ni; }
        __syncthreads();
    }
}

__global__ void __launch_bounds__(NWAVES * 64, 2) fwd_megakernel(Args args) {
    extern __shared__ __attribute__((aligned(16))) unsigned char lds_raw[];
    cg::grid_group grid = cg::this_grid();
    LAS unsigned char* lds = (LAS unsigned char*)lds_raw;
    const int tid = threadIdx.x, lane = tid & 63, wave = __builtin_amdgcn_readfirstlane(tid >> 6);
    const int G = gridDim.x; const int bx = blockIdx.x; const int vcu = (G % 8 == 0) ? (bx % 8) * (G / 8) + bx / 8 : bx;
    const int lo = kargs()->ph_lo, hi = kargs()->ph_hi;
#define ws (kargs()->ws)
#define AIN(k) (kargs()->in[k])
#define AOUT (kargs()->out)
#ifndef ONLY
#define ONLY -1
#endif
#define IN(k) ((ONLY < 0 || ONLY == (k)) && lo <= (k) && (k) < hi)
#define WG_SEAM() do { asm volatile("s_waitcnt vmcnt(0) lgkmcnt(0)" ::: "memory"); __syncthreads(); if (wave == 0) { __builtin_amdgcn_fence(__ATOMIC_ACQUIRE, "agent"); asm volatile("s_waitcnt vmcnt(0)" ::: "memory"); } __syncthreads(); } while (0)
#define SEAM(k) do { if (IN(k) && IN((k) + 1)) { xcd_barrier(xbar); } } while (0)
#define rowss ((float*)(ws + WS_CTL))
#define XN ((bf16*)(ws + WS_XN))
#define HB ((bf16*)(ws + WS_H))

    if (tid < 32) ((LAS unsigned*)(lds + MISC_OFF))[tid] = 0u;
    if (bx == 0) { unsigned* bw = (unsigned*)(ws + WS_BAR); for (int i = tid; i < XCD_BAR_WORDS; i += NWAVES * 64) bw[i] = 0u; if (tid < 9) bw[4096 + 64 * tid] = 0u; }
    if (IN(0)) { p0_prologue(lds, tid, lane, wave, vcu, G); }
    grid.sync();
    XcdBarrier xbar = xcd_barrier_post((unsigned*)(ws + WS_BAR), (volatile LAS unsigned*)(lds + MISC_OFF) + 8);
    if (IN(1)) cumsum_phase(lds, tid, lane, wave);
    if (IN(1)) {
        pg8::Gemm g{XN, (const bf16*)(ws + WS_WQKV), M, NQKV, D, D, D}; pg8::StaticOrder S; S.init(M, NQKV, G, bx);
        { LAS float* gl = (LAS float*)(lds + MISC_OFF + 1024); if (tid < 64) gl[tid] = AIN(5)[tid] * attn_body::C2; else if (tid < 128) gl[tid] = AIN(6)[tid - 64]; __syncthreads(); }
        pg8::EpiQKV E{(bf16*)(ws + WS_QO), (size_t)(WS_K - WS_QO) / 2, (PG8_LAS const float*)(lds + MISC_OFF + 1024)};
        pg8::gemm_phase(lds + RING_OFF, g, S, E);
    }
    SEAM(1);
    if (IN(2)) {
        const attn_body::AttnTensors AT{(const attn_body::bf16*)(ws + WS_QO), (const attn_body::bf16*)(ws + WS_K), (const attn_body::bf16*)(ws + WS_V), (attn_body::bf16*)(ws + WS_O), (const float*)(ws + WS_KB), AIN(5), AIN(6)};
        const attn_body::StaticOrder S(G, bx);
        attn_body::attn_phase<attn_body::StaticOrder>((char*)lds_raw + RING_OFF, AT, S, (unsigned*)(ws + WS_BAR) + 4096, (volatile LAS unsigned*)(lds + MISC_OFF) + 16, xbar.x);
        ssm_setup(lds, tid, (unsigned*)(ws + WS_BAR) + 4096 + 64 * 8, (volatile LAS unsigned*)(lds + MISC_OFF) + 18);
    }
    SEAM(2);
    if (IN(3)) {
        pg8::Gemm g{(const bf16*)(ws + WS_O), (const bf16*)(ws + WS_WO), M, D, D, D, D}; pg8::StaticOrder S; S.init(M, D, G, bx);
        pg8::EpiResid E{nullptr, XN, nullptr, XN, rowss, rowss + 3 * M, AIN(1), nullptr};
        pg8::gemm_phase(lds + RING_OFF, g, S, E);
    }
    SEAM(3);
    if (IN(4)) {
        pg8::Gemm g{XN, (const bf16*)(ws + WS_W1A), M, FF, D, D, D}; pg8::StaticOrder S; S.init(M, FF, G, bx);
        pg8::EpiSqrelu E{HB, FF};
        pg8::gemm_phase(lds + RING_OFF, g, S, E);
    }
    SEAM(4);
    if (IN(5)) {
        pg8::Gemm g{HB, (const bf16*)(ws + WS_W2A), M, D, FF, FF, FF}; pg8::StaticOrder S; S.init(M, D, G, bx);
        pg8::EpiResid E{nullptr, XN, nullptr, XN, rowss + M, nullptr, nullptr, rowss};
        pg8::gemm_phase(lds + RING_OFF, g, S, E);
    }
    SEAM(5);
    if (IN(6)) {
        pg8::Gemm g{XN, (const bf16*)(ws + WS_WSSM), M, D, D, D, D}; pg8::StaticOrder S; S.init(M, D, G, bx);
        pg8::EpiU E{(bf16*)(ws + WS_AALL), rowss + M};
        pg8::gemm_phase(lds + RING_OFF, g, S, E);
    }
    SEAM(6);
    if (G == NG * BATCH) {
        if (IN(7)) {
            pg8::Gemm g{(const bf16*)(ws + WS_AALL), (const bf16*)(ws + WS_WT1), NG * 1024, 256, 256, KA, 256}; pg8::BatchOrder S; S.init(NG * 4, G, vcu);
            pg8::EpiSLds E{(PG8_LAS float*)(lds + RING_OFF)};
            pg8::gemm_phase(lds + RING_OFF, g, S, E);
        }
        __syncthreads();
        if (IN(8)) scan_phase<true>(lds, lane, wave, vcu);
        WG_SEAM();
    } else {
        if (IN(7)) {
            pg8::Gemm g{(const bf16*)(ws + WS_AALL), (const bf16*)(ws + WS_WT1), NG * 1024, 256, 256, KA, 256}; pg8::BatchOrder S; S.init(NG * 4, G, vcu);
            pg8::EpiS E{(float*)(ws + WS_SBUF)};
            pg8::gemm_phase(lds + RING_OFF, g, S, E);
        }
        SEAM(7);
        if (IN(8)) scan_phase<false>(lds, lane, wave, vcu);
        SEAM(8);
    }
    if (IN(9)) {
        pg8::Gemm g{(const bf16*)(ws + WS_AALL), (const bf16*)(ws + WS_BT3), NG * 1024, 256, KA, KA, KA}; pg8::BatchOrder S; S.init(NG * 4, G, vcu);
        pg8::EpiY E{(bf16*)(ws + WS_Z)};
        pg8::gemm_phase(lds + RING_OFF, g, S, E);
    }
    SEAM(9);
    if (IN(10)) {
        pg8::Gemm g{(const bf16*)(ws + WS_Z), (const bf16*)(ws + WS_WGLU), M, 2 * D, D, D, D}; pg8::StaticOrder S; S.init(M, 2 * D, G, bx);
        pg8::EpiGlu E{XN, rowss + 2 * M};
        pg8::gemm_phase(lds + RING_OFF, g, S, E);
    }
    SEAM(10);
    if (IN(11)) {
        pg8::Gemm g{XN, (const bf16*)(ws + WS_W1B), M, FF, D, D, D}; pg8::StaticOrder S; S.init(M, FF, G, bx);
        pg8::EpiSqrelu E{HB, FF};
        pg8::gemm_phase(lds + RING_OFF, g, S, E);
    }
    SEAM(11);
    if (IN(12)) {
        pg8::Gemm g{HB, (const bf16*)(ws + WS_W2B), M, D, FF, FF, FF}; pg8::StaticOrder S; S.init(M, D, G, bx);
        pg8::EpiResid E{nullptr, XN, AOUT, nullptr, nullptr, nullptr, nullptr, rowss + 2 * M};
        pg8::gemm_phase(lds + RING_OFF, g, S, E);
    }
#undef IN
#undef SEAM
#undef ws
#undef AIN
#undef AOUT
#undef rowss
#undef XN
#undef HB
}

extern "C" void kernel_launch(void* const* d_in, const int* in_sizes, int n_in, void* d_out, int out_size, void* d_ws, size_t ws_size, hipStream_t stream) {
    static int grid = 0;
    if (grid == 0) {
        if (n_in != 20 || in_sizes[0] != M * D || out_size != M * D || ws_size < WS_END) { fprintf(stderr, "kernel_launch: unexpected shapes (n_in %d, in0 %d, out %d, ws %zu)\n", n_in, n_in > 0 ? in_sizes[0] : -1, out_size, ws_size); grid = -1; return; }
        int dev = 0, cus = 0, per_cu = 0;
        if (hipGetDevice(&dev) != hipSuccess || hipDeviceGetAttribute(&cus, hipDeviceAttributeMultiprocessorCount, dev) != hipSuccess) { grid = -1; return; }
        if (hipFuncSetAttribute((const void*)fwd_megakernel, hipFuncAttributeMaxDynamicSharedMemorySize, LDS_BYTES) != hipSuccess) { fprintf(stderr, "kernel_launch: hipFuncSetAttribute failed\n"); grid = -1; return; }
        if (hipOccupancyMaxActiveBlocksPerMultiprocessor(&per_cu, (const void*)fwd_megakernel, NWAVES * 64, LDS_BYTES) != hipSuccess || per_cu < 1) { fprintf(stderr, "kernel_launch: occupancy query reports %d workgroups per CU\n", per_cu); (void)hipGetLastError(); per_cu = 1; }
        grid = cus;
        if (grid != 256) fprintf(stderr, "kernel_launch: %d CUs; the attention unit order expects 256\n", grid);
    }
    if (grid < 0) return;
    Args a{};
    for (int i = 0; i < 20; ++i) a.in[i] = (const float*)d_in[i];
    a.out = (float*)d_out; a.ws = (unsigned char*)d_ws; a.ph_lo = 0; a.ph_hi = 13;
    void* params[] = {&a};
    const hipError_t le = hipLaunchCooperativeKernel((const void*)fwd_megakernel, dim3(grid), dim3(NWAVES * 64), params, LDS_BYTES, stream);
    if (le != hipSuccess) fprintf(stderr, "kernel_launch: cooperative launch failed: %s (grid %d)\n", hipGetErrorName(le), grid);
}
```

```cpp
#include <hip/hip_runtime.h>
#include <hip/hip_cooperative_groups.h>
#include <hip/hip_bf16.h>
#include <cstdio>
#include <cstdint>
#include <cmath>
namespace cg = cooperative_groups;

namespace pg8 {
#define PG8_LAS __attribute__((address_space(3)))
typedef unsigned short bf16_t;
typedef short bf16x8 __attribute__((ext_vector_type(8)));
typedef float f32x4 __attribute__((ext_vector_type(4)));
typedef unsigned u32x4 __attribute__((ext_vector_type(4)));
constexpr int BM = 256, BK = 64, HALF = 128, HTB = HALF * BK * 2  , STAGE_BYTES = 8 * HTB, NXCD = 8, WGM = 8;

__host__ __device__ __forceinline__ int lds_byte(int r, int c) { const int st = (r >> 4) * 2 + (c >> 5), rr = r & 15, cc = c & 31, ob = rr * 64 + cc * 2; return st * 1024 + (ob ^ (((ob >> 9) & 1) << 5)); }
__host__ __device__ __forceinline__ void stage_rc(int b, int& R, int& C) { const int st = b / 1024, sb = b % 1024, swz = sb ^ (((sb >> 9) & 1) << 5); R = (st >> 1) * 16 + swz / 64; C = (st & 1) * 32 + (swz % 64) / 2; }
__host__ __device__ __forceinline__ int perm32(int rho) { const int n = rho >> 4, i = rho & 15; return 8 * (i >> 2) + 4 * n + (i & 3); }

struct Unit { int pm, pn; };
struct Gemm { const bf16_t* A; const bf16_t* Bt; int M, N, K, lda, ldb; };

struct StaticOrder {
    int nM, nN, nwg, G, c;
    __host__ __device__ void init(int M, int N, int G_, int c_) { nM = M / BM; nN = N / BM; nwg = nM * nN; G = G_; c = c_; }
    __host__ __device__ bool next(int i, Unit& u) const {
        const long L = (long)i * G + c; if (L >= nwg) return false;
        int wgid = (int)L; { const int q = nwg / NXCD, r = nwg % NXCD, xcd = wgid % NXCD, off = wgid / NXCD; wgid = (xcd < r ? xcd * (q + 1) : r * (q + 1) + (xcd - r) * q) + off; }
        const int nig = WGM * nN, gid = wgid / nig, fm = gid * WGM, gsz = (nM - fm) < WGM ? (nM - fm) : WGM;
        u.pm = fm + ((wgid % nig) % gsz); u.pn = (wgid % nig) / gsz; return true;
    }
};
struct BatchOrder {
    int n, G, c;
    __host__ __device__ void init(int n_, int G_, int c_) { n = n_; G = G_; c = c_; }
    __host__ __device__ bool next(int i, Unit& u) const { const long L = (long)i * G + c; if (L >= n) return false; u.pm = (int)L; u.pn = (int)(L >> 2); return true; }
};

__device__ __forceinline__ unsigned cvt_pk_bf16(float lo, float hi) { unsigned r; asm volatile("v_cvt_pk_bf16_f32 %0, %1, %2" : "=v"(r) : "v"(lo), "v"(hi)); return r; }
__device__ __forceinline__ u32x4 pack8(const f32x4 v0, const f32x4 v1) { u32x4 w; w.x = cvt_pk_bf16(v0[0], v0[1]); w.y = cvt_pk_bf16(v0[2], v0[3]); w.z = cvt_pk_bf16(v1[0], v1[1]); w.w = cvt_pk_bf16(v1[2], v1[3]); return w; }
__device__ __forceinline__ float fq_sum(float s) {
    auto a = __builtin_amdgcn_permlane16_swap(__float_as_uint(s), __float_as_uint(s), false, false); s = __uint_as_float(a[0]) + __uint_as_float(a[1]);
    auto b = __builtin_amdgcn_permlane32_swap(__float_as_uint(s), __float_as_uint(s), false, false); return __uint_as_float(b[0]) + __uint_as_float(b[1]); }
__device__ __forceinline__ float bf2f(unsigned short h) { return __uint_as_float(((unsigned)h) << 16); }
__device__ __forceinline__ float sq4(const f32x4 x) { return __builtin_fmaf(x[3], x[3], __builtin_fmaf(x[2], x[2], __builtin_fmaf(x[1], x[1], x[0] * x[0]))); }
__device__ __forceinline__ float sigmoid_f(float x) { return __builtin_amdgcn_rcpf(1.0f + __builtin_amdgcn_exp2f(-1.4426950408889634f * x)); }
__device__ __forceinline__ float gelu_tanh_f(float y) { const float a = y * (1.0f + 0.044715f * y * y) * (2.0f * 0.7978845608028654f); return y * sigmoid_f(a); }
constexpr float RMS_EPS = 1e-6f;

struct EpiQKV {
    static constexpr bool PERM = true, AFTER_DRAIN = false;
    bf16_t* Q; size_t kv_stride; PG8_LAS const float* gl;
    __device__ __forceinline__ void operator()(const f32x4 (&acc)[2][2][4][2], const Unit& u, int wr, int wc, int fr, int fq) const {
        const int t = u.pn >> 2;
        bf16_t* base = Q + (size_t)t * kv_stride;
        int row0 = u.pm * BM + wr * 64 + fr, col0 = (u.pn & 3) * BM + wc * 64 + 8 * fq;
        asm volatile("" : "+v"(row0), "+v"(col0));
        f32x4 g[2][2];
#pragma unroll
        for (int bj = 0; bj < 2; ++bj)
#pragma unroll
            for (int n = 0; n < 2; ++n) g[bj][n] = (f32x4){1.f, 1.f, 1.f, 1.f};
        if (t < 2) { PG8_LAS const float* gs = gl + 64 * t + 8 * fq;
#pragma unroll
            for (int bj = 0; bj < 2; ++bj)
#pragma unroll
                for (int n = 0; n < 2; ++n) g[bj][n] = *(PG8_LAS const f32x4*)(gs + 32 * bj + 4 * n); }
#pragma unroll
        for (int ai = 0; ai < 2; ++ai)
#pragma unroll
            for (int m = 0; m < 4; ++m) { bf16_t* rowp = base + (size_t)(row0 + ai * HALF + m * 16) * 1024 + col0;
                float r = 1.f;
                if (t < 2) { float s = (sq4(acc[ai][0][m][0]) + sq4(acc[ai][0][m][1])) + (sq4(acc[ai][1][m][0]) + sq4(acc[ai][1][m][1]));
                    s = fq_sum(s); r = __builtin_amdgcn_rsqf(s * (1.0f / 64.0f) + RMS_EPS); }
#pragma unroll
                for (int bj = 0; bj < 2; ++bj) *(u32x4*)(rowp + bj * 32) = pack8(acc[ai][bj][m][0] * r * g[bj][0], acc[ai][bj][m][1] * r * g[bj][1]); }
    }
};

__device__ __forceinline__ void unpack8(const u32x4 w, f32x4& v0, f32x4& v1) {
    v0[0] = __uint_as_float(w.x << 16); v0[1] = __uint_as_float(w.x & 0xffff0000u); v0[2] = __uint_as_float(w.y << 16); v0[3] = __uint_as_float(w.y & 0xffff0000u);
    v1[0] = __uint_as_float(w.z << 16); v1[1] = __uint_as_float(w.z & 0xffff0000u); v1[2] = __uint_as_float(w.w << 16); v1[3] = __uint_as_float(w.w & 0xffff0000u); }
struct EpiResid {
    static constexpr bool PERM = true, AFTER_DRAIN = false;
    const float* basef; const bf16_t* baseb; float* out; bf16_t* xb; float* rowss; const float* unss; const float* ung; const float* accss;
    __device__ __forceinline__ void operator()(const f32x4 (&acc)[2][2][4][2], const Unit& u, int wr, int wc, int fr, int fq) const {
        const int row0 = u.pm * BM + wr * 64 + fr, col0 = u.pn * BM + wc * 32 + 8 * fq;
        f32x4 ginv[2][2];
#pragma unroll
        for (int bj = 0; bj < 2; ++bj)
#pragma unroll
            for (int n = 0; n < 2; ++n) { ginv[bj][n] = (f32x4){1.f, 1.f, 1.f, 1.f}; if (unss) { const f32x4 gg = *(const f32x4*)(ung + col0 + bj * HALF + 4 * n);
#pragma unroll
                for (int i = 0; i < 4; ++i) ginv[bj][n][i] = __builtin_amdgcn_rcpf(gg[i]); } }
#pragma unroll
        for (int ai = 0; ai < 2; ++ai)
#pragma unroll
            for (int m = 0; m < 4; ++m) { const int row = row0 + ai * HALF + m * 16; const size_t off = (size_t)row * 1024 + col0; float sq = 0.f;
                const float asc = accss ? __builtin_amdgcn_rcpf(accss[row] * (1.0f / 1024.0f) + RMS_EPS) : 1.0f;
#pragma unroll
                for (int bj = 0; bj < 2; ++bj) {
                    f32x4 b0, b1;
                    if (basef) { b0 = *(const f32x4*)(basef + off + bj * HALF); b1 = *(const f32x4*)(basef + off + bj * HALF + 4); }
                    else { unpack8(*(const u32x4*)(baseb + off + bj * HALF), b0, b1);
                        if (unss) { const float ri = __builtin_amdgcn_sqrtf(unss[row] * (1.0f / 1024.0f) + RMS_EPS); b0 = b0 * ri * ginv[bj][0]; b1 = b1 * ri * ginv[bj][1]; } }
                    const f32x4 v0 = acc[ai][bj][m][0] * asc + b0, v1 = acc[ai][bj][m][1] * asc + b1;
                    if (out) { __builtin_nontemporal_store(v0, (f32x4*)(out + off + bj * HALF)); __builtin_nontemporal_store(v1, (f32x4*)(out + off + bj * HALF + 4)); }
                    if (xb) *(u32x4*)(xb + off + bj * HALF) = pack8(v0, v1);
                    sq += sq4(v0) + sq4(v1); }
                if (rowss) { sq = fq_sum(sq); if (fq == 0) atomicAdd(rowss + row, sq); } }
    }
};
struct EpiGlu {
    static constexpr bool PERM = true, AFTER_DRAIN = false;
    bf16_t* xb; float* rowss;
    __device__ __forceinline__ void operator()(const f32x4 (&acc)[2][2][4][2], const Unit& u, int wr, int wc, int fr, int fq) const {
        const int row0 = u.pm * BM + wr * 64 + fr, col0 = u.pn * HALF + wc * 32 + 8 * fq;
#pragma unroll
        for (int ai = 0; ai < 2; ++ai)
#pragma unroll
            for (int m = 0; m < 4; ++m) { const int row = row0 + ai * HALF + m * 16; const size_t off = (size_t)row * 1024 + col0;
                f32x4 v[2]; unpack8(*(const u32x4*)(xb + off), v[0], v[1]);
#pragma unroll
                for (int n = 0; n < 2; ++n) { const f32x4 val = acc[ai][0][m][n], gt = acc[ai][1][m][n];
#pragma unroll
                    for (int i = 0; i < 4; ++i) v[n][i] += val[i] * sigmoid_f(gt[i]); }
                *(u32x4*)(xb + off) = pack8(v[0], v[1]);
                float sq = sq4(v[0]) + sq4(v[1]);
                sq = fq_sum(sq); if (fq == 0) atomicAdd(rowss + row, sq); }
    }
};
struct EpiSqrelu {
    static constexpr bool PERM = true, AFTER_DRAIN = false;
    bf16_t* O; int ldc;
    __device__ __forceinline__ void operator()(const f32x4 (&acc)[2][2][4][2], const Unit& u, int wr, int wc, int fr, int fq) const {
        const int row0 = u.pm * BM + wr * 64 + fr, col0 = u.pn * BM + wc * 32 + 8 * fq;
#pragma unroll
        for (int ai = 0; ai < 2; ++ai)
#pragma unroll
            for (int m = 0; m < 4; ++m) { const int row = row0 + ai * HALF + m * 16;
                bf16_t* rowp = O + (size_t)row * ldc + col0;
#pragma unroll
                for (int bj = 0; bj < 2; ++bj) { f32x4 v0 = acc[ai][bj][m][0], v1 = acc[ai][bj][m][1];
#pragma unroll
                    for (int i = 0; i < 4; ++i) { const float a = fmaxf(v0[i], 0.f), b = fmaxf(v1[i], 0.f); v0[i] = a * a; v1[i] = b * b; }
                    *(u32x4*)(rowp + bj * HALF) = pack8(v0, v1); } }
    }
};
struct EpiU {
    static constexpr bool PERM = true, AFTER_DRAIN = false;
    bf16_t* AA; const float* rowss;
    __device__ __forceinline__ void operator()(const f32x4 (&acc)[2][2][4][2], const Unit& u, int wr, int wc, int fr, int fq) const {
        const int row0 = u.pm * BM + wr * 64 + fr, col0 = u.pn * BM + wc * 32 + 8 * fq;
#pragma unroll
        for (int ai = 0; ai < 2; ++ai)
#pragma unroll
            for (int m = 0; m < 4; ++m) { const int row = row0 + ai * HALF + m * 16; const float rs = __builtin_amdgcn_rsqf(rowss[row] * (1.0f / 1024.0f) + RMS_EPS);
                const int kc = row >> 4, s = row & 15;
#pragma unroll
                for (int bj = 0; bj < 2; ++bj) { const int n = col0 + bj * HALF, g = n >> 4, c0 = n & 15;
                    *(u32x4*)(AA + ((size_t)(g * 1024 + kc) * 384 + s * 16 + c0)) = pack8(acc[ai][bj][m][0] * rs, acc[ai][bj][m][1] * rs); } }
    }
};
struct EpiS {
    static constexpr bool PERM = true, AFTER_DRAIN = false;
    float* S;
    __device__ __forceinline__ void operator()(const f32x4 (&acc)[2][2][4][2], const Unit& u, int wr, int wc, int fr, int fq) const {
        const int row0 = u.pm * BM + wr * 64 + fr, col0 = wc * 32 + 8 * fq;
#pragma unroll
        for (int ai = 0; ai < 2; ++ai)
#pragma unroll
            for (int m = 0; m < 4; ++m) { float* p = S + (size_t)(row0 + ai * HALF + m * 16) * 128 + col0;
                *(f32x4*)p = acc[ai][0][m][0]; *(f32x4*)(p + 4) = acc[ai][0][m][1]; }
    }
};
constexpr int SL_PITCH = 132;
struct EpiSLds {
    static constexpr bool PERM = true, AFTER_DRAIN = true;
    PG8_LAS float* SL;
    __device__ __forceinline__ void operator()(const f32x4 (&acc)[2][2][4][2], const Unit& u, int wr, int wc, int fr, int fq) const {
        const int row0 = wr * 64 + fr, col0 = wc * 32 + 8 * fq;
#pragma unroll
        for (int ai = 0; ai < 2; ++ai)
#pragma unroll
            for (int m = 0; m < 4; ++m) { PG8_LAS float* p = SL + (row0 + ai * HALF + m * 16) * SL_PITCH + col0;
                *(PG8_LAS f32x4*)p = acc[ai][0][m][0]; *(PG8_LAS f32x4*)(p + 4) = acc[ai][0][m][1]; }
    }
};
struct EpiY {
    static constexpr bool PERM = true, AFTER_DRAIN = false;
    bf16_t* Z;
    __device__ __forceinline__ void operator()(const f32x4 (&acc)[2][2][4][2], const Unit& u, int wr, int wc, int fr, int fq) const {
        int row0 = u.pm * BM + wr * 64 + fr, n0 = wc * 32 + 8 * fq; const int g = u.pn;
        asm volatile("" : "+v"(row0), "+v"(n0));
#pragma unroll
        for (int ai = 0; ai < 2; ++ai)
#pragma unroll
            for (int m = 0; m < 4; ++m) { const int row = row0 + ai * HALF + m * 16, kc = row & 1023;
#pragma unroll
                for (int bj = 0; bj < 2; ++bj) { const int n = n0 + bj * HALF, j = n >> 4, c0 = n & 15, ch = 16 * g + c0;
                    f32x4 v0 = acc[ai][bj][m][0], v1 = acc[ai][bj][m][1];
#pragma unroll
                    for (int i = 0; i < 4; ++i) { v0[i] = gelu_tanh_f(v0[i]); v1[i] = gelu_tanh_f(v1[i]); }
                    *(u32x4*)(Z + (size_t)(kc * 16 + j) * 1024 + ch) = pack8(v0, v1); } }
    }
};

template <class Epi, class Sched>
__device__ __forceinline__ void gemm_phase(PG8_LAS unsigned char* lds, const Gemm g, const Sched& S, const Epi& E) {
    int tid_ = threadIdx.x; asm volatile("" : "+v"(tid_));
    const int tid = tid_, wid = __builtin_amdgcn_readfirstlane(tid >> 6), lane = tid & 63, wr = wid >> 2, wc = wid & 3, fr = lane & 15, fq = lane >> 4;
    const int K = g.K, nt = K / BK;
    unsigned voffA[2], voffB[2];
#pragma unroll
    for (int i = 0; i < 2; ++i) { int R, C; stage_rc(tid * 16 + i * 8192, R, C); const int Rb = Epi::PERM ? ((R & ~31) + perm32(R & 31)) : R;
        voffA[i] = (unsigned)(R * g.lda + C) * 2u; voffB[i] = (unsigned)(Rb * g.ldb + C) * 2u; }
    const size_t kstep = (size_t)(BK * 2);
    const size_t hA = (size_t)HALF * g.lda * 2, hB = (size_t)HALF * g.ldb * 2;
    const size_t tA = 2 * hA, tB = 2 * hB;
    const unsigned ldsw = (unsigned)wid * 1024u;
    const int aoff = lds_byte(wr * 64 + fr, fq * 8), boff = lds_byte(wc * 32 + fr, fq * 8);
#define PG8_SA(b, h) (((b) * 2 + (h)) * HTB)
#define PG8_SB(b, h) ((4 + (b) * 2 + (h)) * HTB)
#define PG8_STAGE(bufoff, gbase, voff) do { _Pragma("unroll") for (int _i = 0; _i < 2; ++_i) \
        __builtin_amdgcn_global_load_lds((const unsigned*)((const char*)(gbase) + (voff)[_i]), (PG8_LAS unsigned*)(lds + (bufoff) + ldsw + _i * 8192), 16, 0, 0); } while (0)
#define PG8_LDA(dst, b, h) do { _Pragma("unroll") for (int m = 0; m < 4; ++m) _Pragma("unroll") for (int k = 0; k < 2; ++k) dst[m][k] = *(const PG8_LAS bf16x8*)(lds + PG8_SA(b, h) + aoff + m * 2048 + k * 1024); } while (0)
#define PG8_LDB(dst, b, h) do { _Pragma("unroll") for (int n = 0; n < 2; ++n) _Pragma("unroll") for (int k = 0; k < 2; ++k) dst[n][k] = *(const PG8_LAS bf16x8*)(lds + PG8_SB(b, h) + boff + n * 2048 + k * 1024); } while (0)
#define PG8_MMA(ai, bj, At, Bt) do { __builtin_amdgcn_s_setprio(1); _Pragma("unroll") for (int m = 0; m < 4; ++m) _Pragma("unroll") for (int n = 0; n < 2; ++n) _Pragma("unroll") for (int k = 0; k < 2; ++k) \
        acc[ai][bj][m][n] = __builtin_amdgcn_mfma_f32_16x16x32_bf16(Bt[n][k], At[m][k], acc[ai][bj][m][n], 0, 0, 0); __builtin_amdgcn_s_setprio(0); } while (0)
#define PG8_WAIT_V(n) asm volatile("s_waitcnt vmcnt(" #n ")" ::: "memory")
#define PG8_WAIT_L(n) asm volatile("s_waitcnt lgkmcnt(" #n ")" ::: "memory")
#define PG8_BAR __builtin_amdgcn_s_barrier()
#define PG8_SCHED __builtin_amdgcn_sched_barrier(0)
    Unit cur, nxt; int ui = 0;
    if (!S.next(0, cur)) return;
    f32x4 acc[2][2][4][2];
#pragma unroll
    for (int a = 0; a < 2; ++a)
#pragma unroll
        for (int b = 0; b < 2; ++b)
#pragma unroll
            for (int m = 0; m < 4; ++m)
#pragma unroll
                for (int n = 0; n < 2; ++n) acc[a][b][m][n] = (f32x4){0.f, 0.f, 0.f, 0.f};
    bf16x8 At[4][2], B0[2][2], B1[2][2];
    const char* cA = (const char*)g.A + (size_t)cur.pm * tA; const char* cB = (const char*)g.Bt + (size_t)cur.pn * tB;
    PG8_STAGE(PG8_SB(0, 0), cB, voffB); PG8_STAGE(PG8_SB(0, 1), cB + hB, voffB); PG8_STAGE(PG8_SA(0, 0), cA, voffA); PG8_STAGE(PG8_SA(0, 1), cA + hA, voffA);
    if (wr == 1) PG8_BAR;
    PG8_WAIT_V(2); PG8_BAR;
    PG8_STAGE(PG8_SB(1, 0), cB + kstep, voffB); PG8_STAGE(PG8_SA(1, 0), cA + kstep, voffA); PG8_STAGE(PG8_SB(1, 1), cB + hB + kstep, voffB);
    PG8_WAIT_V(6); PG8_BAR;
    for (;;) {
        const bool has_next = S.next(ui + 1, nxt);
        const char* nA = has_next ? (const char*)g.A + (size_t)nxt.pm * tA : cA; const char* nB = has_next ? (const char*)g.Bt + (size_t)nxt.pn * tB : cB;
        for (int t = 0; t < nt; t += 2) {
            const bool last = (t == nt - 2);
            const char* a1 = cA + (size_t)(t + 1) * kstep;
            const char* a2 = last ? nA : cA + (size_t)(t + 2) * kstep; const char* b2 = last ? nB : cB + (size_t)(t + 2) * kstep;
            const char* a3 = a2 + kstep; const char* b3 = b2 + kstep;
            PG8_LDB(B0, 0, 0); PG8_LDB(B1, 0, 1); PG8_SCHED; PG8_LDA(At, 0, 0); PG8_STAGE(PG8_SA(1, 1), a1 + hA, voffA);
            PG8_WAIT_V(8); PG8_WAIT_L(0); PG8_BAR; PG8_MMA(0, 0, At, B0); PG8_MMA(0, 1, At, B1); PG8_BAR; PG8_SCHED;
            PG8_LDA(At, 0, 1); PG8_STAGE(PG8_SB(0, 0), b2, voffB); PG8_STAGE(PG8_SB(0, 1), b2 + hB, voffB); PG8_STAGE(PG8_SA(0, 0), a2, voffA);
            PG8_WAIT_V(8); PG8_WAIT_L(0); PG8_BAR; PG8_MMA(1, 0, At, B0); PG8_MMA(1, 1, At, B1); PG8_BAR; PG8_SCHED;
            PG8_LDB(B0, 1, 0); PG8_LDB(B1, 1, 1); PG8_SCHED; PG8_LDA(At, 1, 0); PG8_STAGE(PG8_SA(0, 1), a2 + hA, voffA);
            PG8_WAIT_V(8); PG8_WAIT_L(0); PG8_BAR; PG8_MMA(0, 0, At, B0); PG8_MMA(0, 1, At, B1); PG8_BAR; PG8_SCHED;
            PG8_LDA(At, 1, 1); PG8_STAGE(PG8_SB(1, 0), b3, voffB); PG8_STAGE(PG8_SB(1, 1), b3 + hB, voffB); PG8_STAGE(PG8_SA(1, 0), a3, voffA);
            PG8_WAIT_V(8); PG8_WAIT_L(0); PG8_BAR; PG8_MMA(1, 0, At, B0); PG8_MMA(1, 1, At, B1); PG8_BAR; PG8_SCHED;
        }
        if (wr == 0) PG8_BAR;
        if constexpr (!Epi::AFTER_DRAIN) E(acc, cur, wr, wc, fr, fq);
        if (!has_next) break;
#pragma unroll
        for (int a = 0; a < 2; ++a)
#pragma unroll
            for (int b = 0; b < 2; ++b)
#pragma unroll
                for (int m = 0; m < 4; ++m)
#pragma unroll
                    for (int n = 0; n < 2; ++n) acc[a][b][m][n] = (f32x4){0.f, 0.f, 0.f, 0.f};
        cur = nxt; cA = nA; cB = nB; ++ui;
        if (wr == 1) PG8_BAR;
    }
    PG8_WAIT_V(0);
    PG8_BAR;
    if constexpr (Epi::AFTER_DRAIN) E(acc, cur, wr, wc, fr, fq);
#undef PG8_SA
#undef PG8_SB
#undef PG8_STAGE
#undef PG8_LDA
#undef PG8_LDB
#undef PG8_MMA
#undef PG8_WAIT_V
#undef PG8_WAIT_L
#undef PG8_BAR
#undef PG8_SCHED
}
}

#include <hip/hip_bf16.h>
#include <cmath>
namespace attn_body {
using bf16=__hip_bfloat16;
using bf16x8=__attribute__((ext_vector_type(8)))short;
using s16x4=__attribute__((ext_vector_type(4)))short;
using f32x16=__attribute__((ext_vector_type(16)))float;
using u32x4=__attribute__((ext_vector_type(4)))unsigned;
constexpr int BATCH=4,NHEAD=16,SEQ=4096,D=64,DM=NHEAD*D;
constexpr int NW=8,QBLK=32,QB=QBLK*NW,KVBLK=64,NQB=SEQ/QB;
constexpr int ATTN_PITCH=DM, ATTN_UNIT_ROWS=QB;
__device__ __forceinline__ int crow(int r,int hi){return (r&3)+8*(r>>2)+4*hi;}
#define SBAR() __builtin_amdgcn_sched_barrier(0)
__device__ __forceinline__ void cmask(f32x16&p0,f32x16&p1,int jb,int qrel,int hi){
  const float NEG=-INFINITY; int kb=64*jb+4*hi;
  #pragma unroll
  for(int r=0;r<16;++r){int kv=kb+(r&3)+8*(r>>2); if(kv>qrel)p0[r]=NEG; if(kv+32>qrel)p1[r]=NEG;}
}

constexpr int NSLOT=3, SLOTB=8192;
constexpr int LDS_K=0, LDS_V=NSLOT*SLOTB, LDS_WS=2*NSLOT*SLOTB, LDS_OST=LDS_WS+NW*64*4, LDS_KBIAS=LDS_OST+NW*4096, LDS_BYTES=LDS_KBIAS+(SEQ+64)*4;
constexpr float C2=0.125f*1.4426950408889634f;
__device__ __forceinline__ void glds16(const void*gsrc,unsigned lds_dst){unsigned keep;
  asm volatile("s_mov_b32 %0, m0\n\ts_mov_b32 m0, %2\n\ts_nop 0\n\tglobal_load_lds_dwordx4 %1, off\n\ts_mov_b32 m0, %0":"=&s"(keep):"v"(gsrc),"s"(lds_dst):"memory");}
__device__ __forceinline__ float max3f(float a,float b,float c){float r;asm("v_max3_f32 %0, %1, %2, %3":"=v"(r):"v"(a),"v"(b),"v"(c));return r;}
__device__ __forceinline__ float max2f(float a,float b){float r;asm("v_max_f32_e32 %0, %1, %2":"=v"(r):"v"(a),"v"(b));return r;}
__device__ __forceinline__ float fadd_s(float a,float b){float r;asm("v_add_f32_e32 %0, %1, %2":"=v"(r):"v"(a),"v"(b));return r;}
__device__ __forceinline__ float fsub_s(float a,float b){float r;asm("v_sub_f32_e32 %0, %1, %2":"=v"(r):"v"(a),"v"(b));return r;}
typedef float f32x2_t __attribute__((ext_vector_type(2))); typedef __bf16 bf16x2_t __attribute__((ext_vector_type(2)));
__device__ __forceinline__ unsigned cvtpk_s(float lo,float hi){f32x2_t v={lo,hi};bf16x2_t b=__builtin_convertvector(v,bf16x2_t);return __builtin_bit_cast(unsigned,b);}
#define WAIT_BAR(N) asm volatile("s_waitcnt vmcnt(" #N ") lgkmcnt(0)\n\ts_barrier":::"memory")

__device__ __forceinline__ void qkt(f32x16&p0,f32x16&p1,const char*Kslot,const bf16x8*qr,int r32,int hi){
  const char*kb=Kslot+hi*1024+r32*16;
  #pragma unroll
  for(int d0=0;d0<4;++d0){
    const bf16x8 b0=*reinterpret_cast<const bf16x8*>(kb+d0*2048);
    const bf16x8 b1=*reinterpret_cast<const bf16x8*>(kb+d0*2048+512);
    {p0=__builtin_amdgcn_mfma_f32_32x32x16_bf16(b0,qr[d0],p0,0,0,0);p1=__builtin_amdgcn_mfma_f32_32x32x16_bf16(b1,qr[d0],p1,0,0,0);}}
}
typedef __attribute__((address_space(3))) const char* lds_cptr;
typedef short v4i16_t __attribute__((ext_vector_type(4)));
__device__ __forceinline__ void kload8(bf16x8*kf,lds_cptr kp){
  kf[0]=*(const __attribute__((address_space(3))) bf16x8*)(kp);      kf[1]=*(const __attribute__((address_space(3))) bf16x8*)(kp+512);
  kf[2]=*(const __attribute__((address_space(3))) bf16x8*)(kp+2048); kf[3]=*(const __attribute__((address_space(3))) bf16x8*)(kp+2560);
  kf[4]=*(const __attribute__((address_space(3))) bf16x8*)(kp+4096); kf[5]=*(const __attribute__((address_space(3))) bf16x8*)(kp+4608);
  kf[6]=*(const __attribute__((address_space(3))) bf16x8*)(kp+6144); kf[7]=*(const __attribute__((address_space(3))) bf16x8*)(kp+6656);
}
__device__ __forceinline__ void kload2(bf16x8*kf,lds_cptr kp,int j){ kf[2*j]=*(const __attribute__((address_space(3))) bf16x8*)(kp+j*2048); kf[2*j+1]=*(const __attribute__((address_space(3))) bf16x8*)(kp+j*2048+512); }
__device__ __forceinline__ s16x4 vtr(lds_cptr p){ return __builtin_bit_cast(s16x4,__builtin_amdgcn_ds_read_tr16_b64_v4i16((__attribute__((address_space(3))) v4i16_t*)p)); }
__device__ __forceinline__ float rowmax(const f32x16&p0,const f32x16&p1){
  float a=max3f(p0[0],p0[1],p1[0]),b=max3f(p0[2],p0[3],p1[1]);a=max3f(a,p1[2],p1[3]);
  #pragma unroll
  for(int r=4;r<16;r+=4){a=max3f(a,p0[r],p0[r+1]);b=max3f(b,p0[r+2],p0[r+3]);a=max3f(a,p1[r],p1[r+1]);b=max3f(b,p1[r+2],p1[r+3]);}
  const float m=max2f(a,b);
  auto rr=__builtin_amdgcn_permlane32_swap(__float_as_uint(m),__float_as_uint(m),false,false);
  return max2f(__uint_as_float(rr[0]),__uint_as_float(rr[1]));
}
__device__ __forceinline__ void pv(f32x16*o,int vb,bf16x8 pa0,bf16x8 pa1,bf16x8 pa2,bf16x8 pa3){
  #pragma unroll
  for(int d0=0;d0<2;++d0){s16x4 lo[4],hi[4];
    #pragma unroll
    for(int ks=0;ks<4;++ks){
      asm volatile("ds_read_b64_tr_b16 %0,%1 offset:%c2":"=&v"(lo[ks]):"v"(vb),"i"(d0*4096+ks*1024):"memory");
      asm volatile("ds_read_b64_tr_b16 %0,%1 offset:%c2":"=&v"(hi[ks]):"v"(vb),"i"(d0*4096+ks*1024+512):"memory");}
    asm volatile("s_waitcnt lgkmcnt(0)":::"memory");SBAR();
    #define PK(k) (bf16x8){lo[k][0],lo[k][1],lo[k][2],lo[k][3],hi[k][0],hi[k][1],hi[k][2],hi[k][3]}
    o[d0]=__builtin_amdgcn_mfma_f32_32x32x16_bf16(pa0,PK(0),o[d0],0,0,0);
    o[d0]=__builtin_amdgcn_mfma_f32_32x32x16_bf16(pa1,PK(1),o[d0],0,0,0);
    o[d0]=__builtin_amdgcn_mfma_f32_32x32x16_bf16(pa2,PK(2),o[d0],0,0,0);
    o[d0]=__builtin_amdgcn_mfma_f32_32x32x16_bf16(pa3,PK(3),o[d0],0,0,0);
    #undef PK
  }
}

#ifndef ATTN_STORE16
#define ATTN_STORE16(p,v) (*(u32x4*)(p)=(v))
#endif
template<int THRL> __device__ __forceinline__ void attn_unit(int b,int h,int qb,const bf16*Q,const bf16*__restrict__ K,const bf16*__restrict__ V,bf16*O,const float*__restrict__ KBg,const float skip_thr,char*shm){
  int tid_=threadIdx.x; asm volatile("":"+v"(tid_)); const int tid=tid_,lane=tid&63,r32=lane&31,hi=lane>>5; const int wid=__builtin_amdgcn_readfirstlane(tid>>6);
  const long rowbase=(long)b*SEQ; const int q0=qb*QB;
  const bf16*Qw=Q+(rowbase+q0+wid*QBLK)*DM+h*D;
  const int NTF=(q0+QB)/KVBLK; int t0=0;
  { const float*kbg=KBg+(long)(b*NHEAD+h)*SEQ; const float kq=kbg[q0]; bool sk=false; if(lane<NTF-4) sk=(kq-kbg[64*lane+63])>skip_thr;
    const unsigned long long mk=__ballot(sk); t0=(mk==~0ull)?64:__builtin_ctzll(~mk); t0&=~1; if(t0>NTF-4)t0=NTF-4; t0=__builtin_amdgcn_readfirstlane(t0); }
  const bf16*Kh=K+(rowbase+(long)t0*KVBLK)*DM+h*D,*Vh=V+(rowbase+(long)t0*KVBLK)*DM+h*D;
  const lds_cptr shm3=(lds_cptr)shm;
  const unsigned lds0=(unsigned)(uintptr_t)shm;
  float*wsf=(float*)(shm+LDS_WS)+wid*64;
  const bf16*ksrc=Kh+(long)lane*DM+wid*8;
  const bf16*vsrc=Vh+(long)(16*(wid&3)+(lane>>2))*DM+(wid>>2)*32+(lane&3)*8;
  const unsigned kdst=lds0+LDS_K+wid*1024, vdst=lds0+LDS_V+wid*1024;
  #define DMA_K(t,slot) glds16(ksrc+(long)(t)*KVBLK*DM,(unsigned)__builtin_amdgcn_readfirstlane(kdst+(slot)))
  #define DMA_V(t,slot) glds16(vsrc+(long)(t)*KVBLK*DM,(unsigned)__builtin_amdgcn_readfirstlane(vdst+(slot)))
  const int vb0=(int)(lds0+LDS_V)+((lane>>4)&1)*32+(lane&3)*8+(4*hi+((lane&15)>>2))*64;
  const char*Kbase=shm+LDS_K; bf16x8 kf[8];
  const lds_cptr kp0=shm3+LDS_K+hi*1024+r32*16; const lds_cptr vp0=shm3+LDS_V+((lane>>4)&1)*32+(lane&3)*8+(4*hi+((lane&15)>>2))*64;
  const int NT=NTF-t0;
  DMA_K(0,0);DMA_V(0,0);DMA_K(1,SLOTB);
  typedef __attribute__((address_space(3))) float* lds_fptr; typedef float f32x4_t __attribute__((ext_vector_type(4)));
  const lds_fptr kbL=(lds_fptr)(shm3+LDS_KBIAS);
  { const float*kbsrc=KBg+(long)(b*NHEAD+h)*SEQ+64*t0; int i0_=4*tid; asm volatile("":"+v"(i0_));   for(int i=i0_;i<64*NT;i+=4*NW*64) *(__attribute__((address_space(3))) f32x4_t*)(kbL+i)=*(const f32x4_t*)(kbsrc+i); }
  #define KBLOAD(P0,P1,t) do{ int h4_=4*hi; asm volatile("":"+v"(h4_));   const lds_fptr kq_=kbL+64*(t)+h4_; _Pragma("unroll") for(int i_=0;i_<4;++i_){ const f32x4_t a_=*(const __attribute__((address_space(3))) f32x4_t*)(kq_+8*i_); const f32x4_t b_=*(const __attribute__((address_space(3))) f32x4_t*)(kq_+32+8*i_); \
      P0[4*i_]=a_[0];P0[4*i_+1]=a_[1];P0[4*i_+2]=a_[2];P0[4*i_+3]=a_[3]; P1[4*i_]=b_[0];P1[4*i_+1]=b_[1];P1[4*i_+2]=b_[2];P1[4*i_+3]=b_[3]; } }while(0)
  bf16x8 qr[4];
  #pragma unroll
  for(int d0=0;d0<4;++d0)qr[d0]=*reinterpret_cast<const bf16x8*>(&Qw[(long)r32*DM+d0*16+hi*8]);
  float mhat=0.f,l_reg=0.f;f32x16 o[2];o[0]=f32x16{};o[1]=f32x16{};
  const int qrel=wid*QBLK+r32;
  #define CMASK(P0,P1,t) do{int jb_=(t)-(NT-4); if(jb_>=0)cmask(P0,P1,jb_,qrel,hi);}while(0)
  bool resc=false;
  #define START(P0,P1) do{ const float rm=rowmax(P0,P1); resc=false; \
    { const float dl=rm; mhat=fadd_s(mhat,dl); \
      _Pragma("unroll") for(int r=0;r<16;++r){P0[r]=fsub_s(P0[r],dl);P1[r]=fsub_s(P1[r],dl);} } \
    _Pragma("unroll") for(int r=0;r<16;++r)P0[r]=__builtin_amdgcn_exp2f(P0[r]); }while(0)
  #define RESC() do{ if(resc){ asm volatile("s_waitcnt lgkmcnt(0)":::"memory"); \
      _Pragma("unroll") for(int d_=0;d_<2;++d_) _Pragma("unroll") for(int r=0;r<16;++r)o[d_][r]*=wsf[crow(r,hi)]; } }while(0)
  f32x16 pA0,pA1,pB0,pB1;
  int sl_prev=0,sl_cur=0,sl_next=SLOTB;
  #define ROT() do{sl_prev=sl_cur;sl_cur=sl_next;sl_next=(sl_next==(NSLOT-1)*SLOTB)?0:sl_next+SLOTB;}while(0)
  DMA_K(2,2*SLOTB);
  WAIT_BAR(3);
  KBLOAD(pA0,pA1,0);
  qkt(pA0,pA1,Kbase,qr,r32,hi);asm volatile("s_nop 15\n\ts_nop 7":"+v"(pA0),"+v"(pA1));CMASK(pA0,pA1,0);
  START(pA0,pA1);
  KBLOAD(pB0,pB1,1);
  _Pragma("unroll") for(int r=0;r<16;++r){pB0[r]-=mhat;pB1[r]-=mhat;}
  _Pragma("unroll") for(int r=0;r<16;++r)pA1[r]=__builtin_amdgcn_exp2f(pA1[r]);
  WAIT_BAR(0);
  DMA_K(3,0);DMA_V(1,SLOTB);
  ROT();
  kload8(kf,kp0+sl_cur);
  WAIT_BAR(2);
  s16x4 vlo[8],vhi[8]; u32x4 pw0,pw1,pw2,pw3;
  #define PKW(P,B) cvtpk_s(P[B],P[B+1])
  #define PAF(k) __builtin_bit_cast(bf16x8,pw##k)
  #define VFR(i) (bf16x8){vlo[i][0],vlo[i][1],vlo[i][2],vlo[i][3],vhi[i][0],vhi[i][1],vhi[i][2],vhi[i][3]}
  #define PIN(x) asm volatile("":"+v"(x))
  #define MX3(a,b,c) __builtin_fmaxf(__builtin_fmaxf((a),(b)),(c))
  #define GAPA(MF,A0,A1,A2,A3,W0,W1,PW) do{ MF; sacc+=A0; sacc+=A1; sacc+=A2; sacc+=A3; PIN(sacc); W0; W1; PIN(PW); SBAR(); }while(0)
  #define EX(v) __builtin_amdgcn_exp2f(v)
  #define GAPB(MF,X,B) do{ MF; X[B]=EX(X[B]); X[B+1]=EX(X[B+1]); X[B+2]=EX(X[B+2]); X[B+3]=EX(X[B+3]); PIN(X); SBAR(); }while(0)
  #define VRD(i) do{ vlo[i]=vtr(vp_+(((i)>>2)*4096+((i)&3)*1024)); vhi[i]=vtr(vp_+(((i)>>2)*4096+((i)&3)*1024+512)); }while(0)
  #define KRD(G,j) do{ if(G){ kload2(kf,kp0+sl_next,j); SBAR(); } }while(0)
  #define NB(G,Y,B) do{ if(G){ Y[B]-=mhat; Y[B+1]-=mhat; Y[B+2]-=mhat; Y[B+3]-=mhat; PIN(Y); SBAR(); } }while(0)
  #define STEP(C0,C1,P0,P1,t,GK,GV,GL,GN) do{ SBAR(); \
    const lds_cptr vp_=vp0+sl_prev; \
    VRD(0); SBAR(); float sacc=(P0[0]+P0[1]); \
    GAPA(C0=__builtin_amdgcn_mfma_f32_32x32x16_bf16(kf[0],qr[0],C0,0,0,0), P0[2],P0[3],P0[4],P0[5],     pw0[0]=PKW(P0,0), pw0[1]=PKW(P0,2), pw0); \
    VRD(4); SBAR(); GAPA(C1=__builtin_amdgcn_mfma_f32_32x32x16_bf16(kf[1],qr[0],C1,0,0,0), P0[6],P0[7],P0[8],P0[9],     pw0[2]=PKW(P0,4), pw0[3]=PKW(P0,6), pw0); \
    VRD(1); SBAR(); GAPA(C0=__builtin_amdgcn_mfma_f32_32x32x16_bf16(kf[2],qr[1],C0,0,0,0),   P0[10],P0[11],P0[12],P0[13], pw1[0]=PKW(P0,8), pw1[1]=PKW(P0,10), pw1); \
    VRD(5); SBAR(); GAPA(C1=__builtin_amdgcn_mfma_f32_32x32x16_bf16(kf[3],qr[1],C1,0,0,0),   P0[14],P0[15],P1[0],P1[1],   pw1[2]=PKW(P0,12),pw1[3]=PKW(P0,14), pw1); \
    VRD(2); SBAR(); GAPA(C0=__builtin_amdgcn_mfma_f32_32x32x16_bf16(kf[4],qr[2],C0,0,0,0),   P1[2],P1[3],P1[4],P1[5],     pw2[0]=PKW(P1,0), pw2[1]=PKW(P1,2), pw2); \
    VRD(6); SBAR(); GAPA(C1=__builtin_amdgcn_mfma_f32_32x32x16_bf16(kf[5],qr[2],C1,0,0,0),   P1[6],P1[7],P1[8],P1[9],     pw2[2]=PKW(P1,4), pw2[3]=PKW(P1,6), pw2); \
    VRD(3); SBAR(); GAPA(C0=__builtin_amdgcn_mfma_f32_32x32x16_bf16(kf[6],qr[3],C0,0,0,0),   P1[10],P1[11],P1[12],P1[13], pw3[0]=PKW(P1,8), pw3[1]=PKW(P1,10), pw3); \
    VRD(7); SBAR(); GAPA(C1=__builtin_amdgcn_mfma_f32_32x32x16_bf16(kf[7],qr[3],C1,0,0,0),   P1[14],P1[15],0.f,0.f,       pw3[2]=PKW(P1,12),pw3[3]=PKW(P1,14), pw3); \
    l_reg+=sacc; \
    if(GK){DMA_K((t)+3,sl_cur);} if(GV){DMA_V((t)+1,sl_next);} \
    CMASK(C0,C1,t); \
    { float a=MX3(C0[0],C0[1],C1[0]),b=MX3(C0[2],C0[3],C1[1]); a=MX3(a,C1[2],C1[3]); \
      _Pragma("unroll") for(int r=4;r<16;r+=4){a=MX3(a,C0[r],C0[r+1]);b=MX3(b,C0[r+2],C0[r+3]);a=MX3(a,C1[r],C1[r+1]);b=MX3(b,C1[r+2],C1[r+3]);} \
      float rm=__builtin_fmaxf(a,b); { auto rr=__builtin_amdgcn_permlane32_swap(__float_as_uint(rm),__float_as_uint(rm),false,false); rm=__builtin_fmaxf(__uint_as_float(rr[0]),__uint_as_float(rr[1])); } \
      resc=false; \
      if(__builtin_expect(__any(rm>(float)THRL),0)){ const float dl=__builtin_fmaxf(rm,0.f); mhat+=dl; \
        _Pragma("unroll") for(int r=0;r<16;++r){C0[r]-=dl;C1[r]-=dl;} \
        const float f=__builtin_amdgcn_exp2f(-dl); l_reg*=f; if(hi==0)wsf[r32]=f; resc=true; } } \
    if(GN){ KBLOAD(P0,P1,(t)+1); } \
    SBAR(); \
    GAPB(o[0]=__builtin_amdgcn_mfma_f32_32x32x16_bf16(PAF(0),VFR(0),o[0],0,0,0), C0,0); NB(GN,P0,0); \
    GAPB(o[1]=__builtin_amdgcn_mfma_f32_32x32x16_bf16(PAF(0),VFR(4),o[1],0,0,0), C0,4); NB(GN,P0,4); \
    KRD(GL,0); GAPB(o[0]=__builtin_amdgcn_mfma_f32_32x32x16_bf16(PAF(1),VFR(1),o[0],0,0,0), C0,8); NB(GN,P0,8); \
    KRD(GL,1); GAPB(o[1]=__builtin_amdgcn_mfma_f32_32x32x16_bf16(PAF(1),VFR(5),o[1],0,0,0), C0,12); NB(GN,P0,12); \
    KRD(GL,2); GAPB(o[0]=__builtin_amdgcn_mfma_f32_32x32x16_bf16(PAF(2),VFR(2),o[0],0,0,0), C1,0); NB(GN,P1,0); \
    KRD(GL,3); GAPB(o[1]=__builtin_amdgcn_mfma_f32_32x32x16_bf16(PAF(2),VFR(6),o[1],0,0,0), C1,4); NB(GN,P1,4); \
    GAPB(o[0]=__builtin_amdgcn_mfma_f32_32x32x16_bf16(PAF(3),VFR(3),o[0],0,0,0), C1,8); NB(GN,P1,8); \
    GAPB(o[1]=__builtin_amdgcn_mfma_f32_32x32x16_bf16(PAF(3),VFR(7),o[1],0,0,0), C1,12); NB(GN,P1,12); \
    }while(0)
  int t=1;
  #undef CMASK
  #define CMASK(P0,P1,t) do{}while(0)
  for(;t+5<NT;t+=2){
    STEP(pB0,pB1,pA0,pA1,t,true,true,true,true);     WAIT_BAR(2); RESC(); ROT();
    STEP(pA0,pA1,pB0,pB1,t+1,true,true,true,true);   WAIT_BAR(2); RESC(); ROT();
  }
  #undef CMASK
  #define CMASK(P0,P1,t) do{int jb_=(t)-(NT-4); if(jb_>=0)cmask(P0,P1,jb_,qrel,hi);}while(0)
  #define ENDW(tt) do{ if((tt)+3<NT){WAIT_BAR(2);} else if((tt)+2<NT){WAIT_BAR(1);} else {WAIT_BAR(0);} }while(0)
  for(;t+1<NT;t+=2){
    STEP(pB0,pB1,pA0,pA1,t,(t+3<NT),(t+1<NT),(t+1<NT),(t+1<NT));       ENDW(t);   RESC(); ROT();
    STEP(pA0,pA1,pB0,pB1,t+1,(t+4<NT),(t+2<NT),(t+2<NT),(t+2<NT));     ENDW(t+1); RESC(); ROT();
  }
  STEP(pB0,pB1,pA0,pA1,NT-1,false,false,false,false); RESC();
  { float sacc=pB0[0]+pB0[1]; _Pragma("unroll") for(int r=2;r<16;++r)sacc+=pB0[r]; _Pragma("unroll") for(int r=0;r<16;++r)sacc+=pB1[r]; l_reg+=sacc;
    pw0=(u32x4){PKW(pB0,0),PKW(pB0,2),PKW(pB0,4),PKW(pB0,6)};pw1=(u32x4){PKW(pB0,8),PKW(pB0,10),PKW(pB0,12),PKW(pB0,14)};pw2=(u32x4){PKW(pB1,0),PKW(pB1,2),PKW(pB1,4),PKW(pB1,6)};pw3=(u32x4){PKW(pB1,8),PKW(pB1,10),PKW(pB1,12),PKW(pB1,14)};
    SBAR(); pv(o,vb0+sl_cur,PAF(0),PAF(1),PAF(2),PAF(3)); }
  #undef PKW
  #undef PAF
  #undef VFR
  #undef PIN
  #undef MX3
  #undef GAPA
  #undef GAPB
  #undef EX
  #undef VRD
  #undef KRD
  #undef NB
  #undef KBLOAD
  #undef STEP
  #undef ENDW
  {auto rr=__builtin_amdgcn_permlane32_swap(__float_as_uint(l_reg),__float_as_uint(l_reg),false,false);l_reg=__uint_as_float(rr[0])+__uint_as_float(rr[1]);}
  if(hi==0)wsf[32+r32]=l_reg;asm volatile("s_waitcnt lgkmcnt(0)":::"memory");
  float rli[16];
  #pragma unroll
  for(int r=0;r<16;++r)rli[r]=__builtin_amdgcn_rcpf(wsf[32+crow(r,hi)]);
  bf16*Ow=O+(rowbase+q0+wid*QBLK)*DM+h*D;
  { bf16*stg=(bf16*)(shm+LDS_OST)+wid*2048;
    #pragma unroll
    for(int r=0;r<16;++r){const int orow=crow(r,hi);
      #pragma unroll
      for(int d0=0;d0<2;++d0)stg[orow*64+d0*32+r32]=__float2bfloat16(o[d0][r]*rli[r]);}
    asm volatile("s_waitcnt lgkmcnt(0)":::"memory");
    #pragma unroll
    for(int i=0;i<4;++i){const int row=i*8+(lane>>3),ch=lane&7; const u32x4 v=*(const u32x4*)(stg+row*64+ch*8); ATTN_STORE16(Ow+(long)row*DM+ch*8,v);} }
  asm volatile("s_waitcnt lgkmcnt(0)\n\ts_barrier":::"memory");
  #undef DMA_K
  #undef DMA_V
  #undef CMASK
  #undef START
  #undef RESC
  #undef ROT
}
constexpr int ATTN_LDS_BYTES=LDS_BYTES;
struct AttnTensors { const bf16* Q; const bf16* K; const bf16* V; bf16* O; const float* KB; const float* qg; const float* kg; };
struct AttnUnit { int bh; int qb; };
struct StaticOrder {
  int vcu;
  __device__ __forceinline__ explicit StaticOrder(int grid,int block):vcu((block%8)*(grid/8)+block/8){}
  __device__ __forceinline__ bool next(int i,AttnUnit&u)const{ if(i>=4)return false; const int s=vcu&3; u.bh=vcu>>2; u.qb=(i==0)?s:(i==1)?7-s:(i==2)?8+s:15-s; return true; }
  __device__ __forceinline__ void a_ready(const AttnUnit&)const{}
  __device__ __forceinline__ void done(const AttnUnit&)const{}
};
__device__ __forceinline__ int attn_ticket(unsigned*ctr,unsigned myx){
  for(unsigned k=0;k<8;++k){ const unsigned q=(myx+k)&7u; const unsigned m=atomicAdd(ctr+64*q,1u); if(m<128u) return (int)(q*128u+m); }
  return -1;
}
template<class Sched,int THRL=60> __device__ __forceinline__ void attn_phase(char*lds,const AttnTensors&T,const Sched&S,unsigned*ctr,volatile __attribute__((address_space(3))) unsigned*slot,unsigned myx){
  float thr; { const int l=threadIdx.x&63; float a=fabsf(T.qg[l]),c=fabsf(T.kg[l]);
    for(int o=1;o<64;o<<=1){a=fmaxf(a,__shfl_xor(a,o));c=fmaxf(c,__shfl_xor(c,o));}
    thr=2.0f*(1.05f*a*c*64.0f*C2)+40.0f; }
  if(threadIdx.x==0) slot[0]=(unsigned)attn_ticket(ctr,myx);
  __syncthreads();
  int n=(int)slot[0];
  while(n>=0){
    int pre=-1; if(threadIdx.x==0) pre=attn_ticket(ctr,myx);
    const int m=n&127, bh=8*(n>>7)+(m&7);
    attn_unit<THRL>(bh/NHEAD,bh%NHEAD,(NQB-1)-(m>>3),T.Q,T.K,T.V,T.O,T.KB,thr,lds);
    if(threadIdx.x==0) slot[0]=(unsigned)pre;
    __syncthreads();
    n=(int)slot[0];
  }
}
#undef SBAR
#undef WAIT_BAR
}

constexpr int NWAVES = 8;
constexpr int BATCH = 4, SEQ = 4096, D = 1024, H = 16, HD = 64, FF = 4096;
constexpr int M = BATCH * SEQ;
constexpr int NQKV = 3 * D, WIN_LD = 3 * D + H;
constexpr int NG = 64, NP = 64, NC = 16, LCH = 16, NCHUNK = M / LCH  , KA = LCH * NC + 2 * NP  ;

constexpr size_t MiB = 1u << 20;
constexpr size_t WS_CTL = 0;
constexpr size_t WS_BAR = 256 * 1024;
constexpr size_t WS_LAMT = 3 * MiB;
constexpr size_t WS_LF = 1 * MiB, WS_KB = 2 * MiB;
constexpr size_t WS_WQKV = 4 * MiB, WS_WO = 10 * MiB, WS_W1A = 12 * MiB, WS_W2A = 20 * MiB, WS_W1B = 28 * MiB, WS_W2B = 36 * MiB, WS_WSSM = 44 * MiB, WS_WGLU = 46 * MiB;
constexpr size_t WS_BT3 = 50 * MiB, WS_WT1 = 62 * MiB;
constexpr size_t WS_XN = 70 * MiB;
constexpr size_t WS_QO = 102 * MiB, WS_K = 134 * MiB, WS_V = 166 * MiB;
constexpr size_t WS_O = 198 * MiB;
constexpr size_t WS_H = 102 * MiB;
constexpr size_t WS_AALL = 102 * MiB, WS_SBUF = 150 * MiB, WS_Z = 182 * MiB;
constexpr size_t WS_END = 230 * MiB;

constexpr int RING_OFF = 0, RING_BYTES = 131072;
constexpr int XCH_OFF = RING_BYTES;
constexpr int MISC_OFF = XCH_OFF + 8192;
constexpr int LDS_BYTES = 147456;

#define GAS __attribute__((address_space(1)))
#define LAS __attribute__((address_space(3)))
typedef unsigned short bf16;
typedef unsigned v4u __attribute__((ext_vector_type(4)));
typedef float f32x4 __attribute__((ext_vector_type(4)));
#define LDS_WAIT() asm volatile("s_waitcnt lgkmcnt(0)" ::: "memory")
__device__ __forceinline__ unsigned f2bf(float f) { unsigned u = __builtin_bit_cast(unsigned, f); return (u + 0x7fffu + ((u >> 16) & 1u)) >> 16; }
__device__ __forceinline__ unsigned pk2(float lo, float hi) { unsigned r; asm("v_cvt_pk_bf16_f32 %0, %1, %2" : "=v"(r) : "v"(lo), "v"(hi)); return r; }
__device__ __forceinline__ float wave_sum(float v) {
#pragma unroll
    for (int o = 1; o < 64; o <<= 1) v += __shfl_xor(v, o);
    return v;
}
__device__ __forceinline__ void sincos_d(double a, double& s, double& c) {
    const double k = rint(a * 0.63661977236758134308);
    double r = fma(-k, 1.57079632679489655800e+00, a); r = fma(-k, 6.12323399573676603587e-17, r);
    const int q = ((int)k) & 3;
    const double r2 = r * r;
    const double sp = r * (1.0 + r2 * (-1.0 / 6 + r2 * (1.0 / 120 + r2 * (-1.0 / 5040 + r2 * (1.0 / 362880 + r2 * (-1.0 / 39916800 + r2 * (1.0 / 6227020800.0)))))));
    const double cp = 1.0 + r2 * (-0.5 + r2 * (1.0 / 24 + r2 * (-1.0 / 720 + r2 * (1.0 / 40320 + r2 * (-1.0 / 3628800 + r2 * (1.0 / 479001600.0 + r2 * (-1.0 / 87178291200.0)))))));
    s = (q == 0) ? sp : (q == 1) ? cp : (q == 2) ? -sp : -cp;
    c = (q == 0) ? cp : (q == 1) ? -sp : (q == 2) ? -cp : sp;
}

#define XB_TMO      128
#define XB_XCNT(j)  (256  + 64 * (j))
#define XB_XSUB(j)  (1280 + 64 * (j))
#define XB_XGEN(j)  (2304 + 64 * (j))
#define XB_TOP      3328
#define XB_TOPGEN   3392
#define XCD_BAR_WORDS 3456
#define XB_SPIN_CAP (1u << 18)

__device__ __forceinline__ unsigned xb_ld(unsigned* p)              { return __hip_atomic_load(p, __ATOMIC_RELAXED, __HIP_MEMORY_SCOPE_AGENT); }
__device__ __forceinline__ unsigned xb_add(unsigned* p, unsigned v) { return __hip_atomic_fetch_add(p, v, __ATOMIC_RELAXED, __HIP_MEMORY_SCOPE_AGENT); }
__device__ __forceinline__ unsigned xb_xcc_id() { return (unsigned)__builtin_amdgcn_s_getreg((3 << 11) | 20) & 0xFu; }
#define XB_SPIN(cond, bar) do { unsigned _sp = 0; while (cond) { __builtin_amdgcn_s_sleep(1); \
    if ((++_sp & 255u) == 0u) { if (xb_ld(&(bar)[XB_TMO])) break; if (_sp > XB_SPIN_CAP) { atomicAdd(&(bar)[XB_TMO], 1u); break; } } } } while (0)

struct XcdBarrier {
    unsigned* bar; unsigned x;
    volatile LAS unsigned* st;
};

__device__ __forceinline__ XcdBarrier xcd_barrier_post(unsigned* bar, volatile LAS unsigned* st) {
    XcdBarrier b; b.bar = bar; b.x = xb_xcc_id(); b.st = st;
    if (threadIdx.x == 0) (void)xb_add(&bar[XB_XCNT(b.x)], 1u);
    return b;
}
__device__ __forceinline__ void xcd_barrier_complete(unsigned* bar, unsigned x, unsigned& nloc, unsigned& nx) {
    const unsigned G = gridDim.x * gridDim.y * gridDim.z;
    unsigned sum, cnt, mine, sp = 0u;
    for (;;) {
        sum = 0u; cnt = 0u; mine = 0u;
#pragma unroll
        for (unsigned j = 0; j < 16; ++j) { const unsigned c = xb_ld(&bar[XB_XCNT(j)]); sum += c; cnt += (c > 0u) ? 1u : 0u; mine = (j == x) ? c : mine; }
        if (sum == G) break;
        __builtin_amdgcn_s_sleep(1);
        if ((++sp & 255u) == 0u) { if (xb_ld(&bar[XB_TMO])) break; if (sp > XB_SPIN_CAP) { atomicAdd(&bar[XB_TMO], 1u); break; } }
    }
    nloc = mine > 0u ? mine : 1u; nx = cnt > 0u ? cnt : 1u;
}

__device__ __forceinline__ void xcd_barrier(const XcdBarrier& b) {
    asm volatile("s_waitcnt vmcnt(0)" ::: "memory");
    __syncthreads();
    if (threadIdx.x == 0) {
        unsigned* bar = b.bar;
        __builtin_amdgcn_s_waitcnt(0);
        unsigned nloc = b.st[0], nx = b.st[1];
        if (nloc == 0u) { xcd_barrier_complete(bar, b.x, nloc, nx); b.st[0] = nloc; b.st[1] = nx; }
        const unsigned old = xb_add(&bar[XB_XSUB(b.x)], 1u);
        const unsigned gen = old / nloc;
        if (old + 1u == (gen + 1u) * nloc) {
            __builtin_amdgcn_fence(__ATOMIC_RELEASE, "agent");
            asm volatile("s_waitcnt vmcnt(0)" ::: "memory");
            const unsigned og = xb_add(&bar[XB_TOP], 1u);
            const unsigned tg = og / nx;
            if (og + 1u == (tg + 1u) * nx) xb_add(&bar[XB_TOPGEN], 1u);
            else XB_SPIN(xb_ld(&bar[XB_TOPGEN]) == tg, bar);
            __builtin_amdgcn_fence(__ATOMIC_ACQUIRE, "agent");
            xb_add(&bar[XB_XGEN(b.x)], 1u);
            asm volatile("s_waitcnt vmcnt(0)" ::: "memory");
        } else {
            XB_SPIN(xb_ld(&bar[XB_XGEN(b.x)]) == gen, bar);
            __builtin_amdgcn_fence(__ATOMIC_ACQUIRE, "agent");
            asm volatile("s_waitcnt vmcnt(0)" ::: "memory");
        }
    }
    __syncthreads();
}

struct Args { const float* in[20]; float* out; unsigned char* ws; int ph_lo, ph_hi; };

typedef const __attribute__((address_space(4))) Args* KArgs;
__device__ __forceinline__ KArgs kargs() { KArgs p = (KArgs)__builtin_amdgcn_kernarg_segment_ptr(); asm volatile("" : "+s"(p)); return p; }
__device__ __forceinline__ void p0_transpose_item(const float* W, int ldw, int K, int ncols, bf16* WT, LAS float* scr, int item, int lane, const float* gk, int glu) {
    const int nblk = ncols / 32, kb = item / nblk, nb = item % nblk, k0 = 64 * kb, n0 = 32 * nb;
    int src0 = n0;
    if (glu == 1) src0 = ((n0 >> 7) & 1) * 1024 + 128 * (n0 >> 8) + (n0 & 127);
    if (glu == 2) src0 = (n0 & ~255) + 64 * ((n0 >> 5) & 3) + 32 * ((n0 >> 7) & 1);
#pragma unroll 8
    for (int i = 0; i < 32; ++i) { const int kk = 2 * i + (lane >> 5); const float g = gk ? gk[k0 + kk] : 1.0f; scr[kk * 33 + (lane & 31)] = __builtin_nontemporal_load(W + (size_t)(k0 + kk) * ldw + src0 + (lane & 31)) * g; }
    LDS_WAIT(); asm volatile("" ::: "memory");
    const int c = lane & 7;
#pragma unroll
    for (int j = 0; j < 4; ++j) { const int n = (lane >> 3) + 8 * j; const LAS float* s = scr + (8 * c) * 33 + n;
        v4u o; o.x = pk2(s[0 * 33], s[1 * 33]); o.y = pk2(s[2 * 33], s[3 * 33]); o.z = pk2(s[4 * 33], s[5 * 33]); o.w = pk2(s[6 * 33], s[7 * 33]);
        *(GAS v4u*)(WT + (size_t)(n0 + n) * K + k0 + 8 * c) = o; }
    LDS_WAIT(); asm volatile("" ::: "memory");
}

__device__ __forceinline__ void ssm_setup(LAS unsigned char* lds, int tid, unsigned* ctr, volatile LAS unsigned* slot) {
    KArgs a = kargs();
    const float* a_re = a->in[9]; const float* a_im = a->in[10]; const float* b_re = a->in[11]; const float* b_im = a->in[12];
    const float* c_re = a->in[13]; const float* c_im = a->in[14]; const float* log_dt = a->in[15];
    bf16* BT3 = (bf16*)(a->ws + WS_BT3); bf16* WT1 = (bf16*)(a->ws + WS_WT1);
    LAS float* lamp = (LAS float*)lds;
    LAS float* bbt = lamp + 17 * 64 * 2;
    LAS float* cct = bbt + 64 * 16 * 2;
    LAS float* Kt = cct + 16 * 64 * 2;
    for (;;) {
        if (tid == 0) slot[0] = atomicAdd(ctr, 1u);
        __syncthreads();
        const int w = (int)slot[0];
        if (w >= 4 * NG) break;
        const int g = w >> 2, q = w & 3;
        {
            LAS double* ld = (LAS double*)(Kt);
            if (tid < 64) { const int p = tid; const double dt = exp((double)log_dt[g]), are = (double)a_re[g * 64 + p], aim = (double)a_im[g * 64 + p];
                double sn, cs; sincos_d(dt * aim, sn, cs); const double mag = exp(dt * are); const double lr = mag * cs, li = mag * sn;
                const double nr = lr - 1.0, ni = li, den = are * are + aim * aim;
                ld[p * 4] = lr; ld[p * 4 + 1] = li; ld[p * 4 + 2] = (nr * are + ni * aim) / den; ld[p * 4 + 3] = (ni * are - nr * aim) / den;
                if (q == 0) { double pr = lr, pi = li; f32x4 o;
#pragma unroll 1
                    for (int sq = 0; sq < 9; ++sq) { if (sq == 4) { o.x = (float)pr; o.y = (float)pi; } const double t = pr * pr - pi * pi; pi = 2.0 * pr * pi; pr = t; }
                    o.z = (float)pr; o.w = (float)pi; *(f32x4*)((float*)(a->ws + WS_LAMT) + (size_t)(g * 64 + p) * 4) = o; } }
            __syncthreads();
#pragma unroll 1
            for (int idx = tid; idx < 17 * 64; idx += 512) { const int tau = idx >> 6, p = idx & 63; double br = ld[p * 4], bi = ld[p * 4 + 1], rr = 1.0, ri = 0.0;
#pragma unroll
                for (int bit = 0; bit < 5; ++bit) { if ((tau >> bit) & 1) { const double t = rr * br - ri * bi; ri = rr * bi + ri * br; rr = t; } const double t2 = br * br - bi * bi; bi = 2.0 * br * bi; br = t2; }
                lamp[idx * 2] = (float)rr; lamp[idx * 2 + 1] = (float)ri; }
#pragma unroll 1
            for (int idx = tid; idx < 64 * 16; idx += 512) { const int p = idx >> 4; const double sr = ld[p * 4 + 2], si = ld[p * 4 + 3];
                const double br = (double)b_re[g * 1024 + idx], bi = (double)b_im[g * 1024 + idx];
                bbt[idx * 2] = (float)(sr * br - si * bi); bbt[idx * 2 + 1] = (float)(sr * bi + si * br); }
        }
        for (int i = tid; i < 1024; i += 512) { cct[i * 2] = c_re[g * 1024 + i]; cct[i * 2 + 1] = c_im[g * 1024 + i]; }
        __syncthreads();
        {
            const int tau = tid >> 5, cp = (tid >> 1) & 15, c0 = (tid & 1) * 8; float sacc[8];
#pragma unroll
            for (int e = 0; e < 8; ++e) sacc[e] = 0.f;
#pragma unroll 2
            for (int p = 0; p < 64; ++p) { const float cr = cct[(cp * 64 + p) * 2], ci = cct[(cp * 64 + p) * 2 + 1], lr = lamp[(tau * 64 + p) * 2], li = lamp[(tau * 64 + p) * 2 + 1];
                const float dr = cr * lr - ci * li, di = cr * li + ci * lr;
                const LAS f32x4* bp = (const LAS f32x4*)(bbt + (p * 16 + c0) * 2);
#pragma unroll
                for (int e4 = 0; e4 < 4; ++e4) { const f32x4 b4 = bp[e4]; sacc[2 * e4] += dr * b4.x - di * b4.y; sacc[2 * e4 + 1] += dr * b4.z - di * b4.w; } }
#pragma unroll
            for (int e = 0; e < 8; ++e) Kt[tau * 256 + cp * 16 + c0 + e] = sacc[e] + ((tau == 0 && c0 + e == cp) ? a->in[16][16 * g + cp] : 0.f);
        }
        __syncthreads();
#pragma unroll 1
        for (int r = 0; r < 6; ++r) { const int pc = tid + 512 * r, rr = pc / 48, k8 = (pc % 48) * 8, n = 64 * q + rr, j = n >> 4, cp = n & 15; float v[8];
            if (k8 < 256) { const int s = k8 >> 4, c0 = k8 & 15;
#pragma unroll
                for (int e = 0; e < 8; ++e) v[e] = (j >= s) ? Kt[(j - s) * 256 + cp * 16 + c0 + e] : 0.f;
            } else { const int im = (k8 - 256) >> 6, p0 = (k8 - 256) & 63;
#pragma unroll
                for (int e = 0; e < 8; ++e) { const int p = p0 + e; const float cr = cct[(cp * 64 + p) * 2], ci = cct[(cp * 64 + p) * 2 + 1], lr = lamp[((j + 1) * 64 + p) * 2], li = lamp[((j + 1) * 64 + p) * 2 + 1];
                    v[e] = im ? -(cr * li + ci * lr) : (cr * lr - ci * li); } }
            v4u o; o.x = pk2(v[0], v[1]); o.y = pk2(v[2], v[3]); o.z = pk2(v[4], v[5]); o.w = pk2(v[6], v[7]);
            *(GAS v4u*)(BT3 + (size_t)(g * 256 + n) * KA + k8) = o; }
#pragma unroll 1
        for (int r = 0; r < 4; ++r) { const int pc = tid + 512 * r, rr = pc >> 5, k8 = (pc & 31) * 8, n = 64 * q + rr; float v[8];
            if (n < 128) { const int p = n & 63, im = n >> 6, s = k8 >> 4, c0 = k8 & 15; const float lr = lamp[((15 - s) * 64 + p) * 2], li = lamp[((15 - s) * 64 + p) * 2 + 1];
#pragma unroll
                for (int e = 0; e < 8; ++e) { const float br = bbt[(p * 16 + c0 + e) * 2], bi = bbt[(p * 16 + c0 + e) * 2 + 1]; v[e] = im ? (lr * bi + li * br) : (lr * br - li * bi); }
            } else {
#pragma unroll
                for (int e = 0; e < 8; ++e) v[e] = 0.f; }
            v4u o; o.x = pk2(v[0], v[1]); o.y = pk2(v[2], v[3]); o.z = pk2(v[4], v[5]); o.w = pk2(v[6], v[7]);
            *(GAS v4u*)(WT1 + (size_t)(g * 256 + n) * 256 + k8) = o; }
        __syncthreads();
    }
}

__device__ __forceinline__ void p0_prologue(LAS unsigned char* lds, int tid, int lane, int wave, int vcu, int G) {
    const int gw = vcu * NWAVES + wave, NGW = G * NWAVES;
    { KArgs a = kargs(); const float* nmix = a->in[1]; const float* nmlp = a->in[2]; const float* w_in = a->in[3]; unsigned char* ws = a->ws;
    LAS float* scr = (LAS float*)(lds + RING_OFF + wave * 16384);
    constexpr int I_QKV = (D / 64) * (NQKV / 32), I_O = (D / 64) * (D / 32), I_1 = (D / 64) * (FF / 32), I_2 = (FF / 64) * (D / 32), I_G = (D / 64) * (2 * D / 32);
    constexpr int NITEMS = I_QKV + I_O + 2 * I_1 + 2 * I_2 + I_O + I_G;
    for (int it = gw; it < NITEMS; it += NGW) {
        int r = it;
        if (r < I_1) { p0_transpose_item(a->in[18] + (size_t)D * FF, FF, D, FF, (bf16*)(ws + WS_W1B), scr, r, lane, nmlp + D, 0); continue; } r -= I_1;
        if (r < I_2) { p0_transpose_item(a->in[19] + (size_t)FF * D, D, FF, D, (bf16*)(ws + WS_W2B), scr, r, lane, nullptr, 0); continue; } r -= I_2;
        if (r < I_G) { p0_transpose_item(a->in[17], 2 * D, D, 2 * D, (bf16*)(ws + WS_WGLU), scr, r, lane, nullptr, 1); continue; } r -= I_G;
        if (r < I_O) { p0_transpose_item(a->in[8], D, D, D, (bf16*)(ws + WS_WSSM), scr, r, lane, nmix + D, 0); continue; } r -= I_O;
        if (r < I_2) { p0_transpose_item(a->in[19], D, FF, D, (bf16*)(ws + WS_W2A), scr, r, lane, nullptr, 0); continue; } r -= I_2;
        if (r < I_1) { p0_transpose_item(a->in[18], FF, D, FF, (bf16*)(ws + WS_W1A), scr, r, lane, nmlp, 0); continue; } r -= I_1;
        if (r < I_O) { p0_transpose_item(a->in[7], D, D, D, (bf16*)(ws + WS_WO), scr, r, lane, nullptr, 0); continue; } r -= I_O;
        p0_transpose_item(w_in, WIN_LD, D, NQKV, (bf16*)(ws + WS_WQKV), scr, r, lane, nullptr, 2);
    }
    }
    KArgs a = kargs(); const float* x = a->in[0]; const float* nmix = a->in[1]; const float* w_in = a->in[3]; const float* b_f = a->in[4]; unsigned char* ws = a->ws;
    { float* rs = (float*)(ws + WS_CTL); for (int i = blockIdx.x * 512 + tid; i < 3 * M; i += G * 512) rs[i] = 0.f; }
    __syncthreads();
    LAS float* wfT = (LAS float*)(lds + RING_OFF);
    for (int i = tid; i < D * H; i += 512) { const int k = i >> 4, h = i & 15; wfT[h * D + k] = w_in[(size_t)k * WIN_LD + NQKV + h]; }
    __syncthreads();
    bf16* XN = (bf16*)(ws + WS_XN); float* LF = (float*)(ws + WS_LF);
    for (int m = gw; m < M; m += NGW) {
        const GAS f32x4* xr = (const GAS f32x4*)(x + (size_t)m * D) + lane;
        f32x4 v[4]; float s = 0.f;
#pragma unroll
        for (int j = 0; j < 4; ++j) { v[j] = __builtin_nontemporal_load(xr + 64 * j); s += (v[j].x * v[j].x + v[j].y * v[j].y) + (v[j].z * v[j].z + v[j].w * v[j].w); }
        const float ssx = wave_sum(s); const float rs = 1.0f / sqrtf(ssx * (1.f / D) + 1e-6f);
        if (lane == 0) ((float*)(ws + WS_CTL))[3 * M + m] = ssx;
        GAS unsigned long long* o8 = (GAS unsigned long long*)(XN + (size_t)m * D) + lane;
#pragma unroll
        for (int j = 0; j < 4; ++j) { const f32x4 g4 = *(const f32x4*)(nmix + 256 * j + 4 * lane); v[j] = v[j] * rs * g4;
            o8[64 * j] = (unsigned long long)pk2(v[j].x, v[j].y) | ((unsigned long long)pk2(v[j].z, v[j].w) << 32); }
        float acc[16];
#pragma unroll
        for (int h = 0; h < 16; ++h) { float t = 0.f, t2 = 0.f; if ((h & 3) == 0) asm volatile("" ::: "memory");
#pragma unroll
            for (int j = 0; j < 4; ++j) { const f32x4 w4 = *(const LAS f32x4*)(wfT + h * D + 256 * j + 4 * lane);
                if (j & 1) { t2 = __builtin_fmaf(v[j].x, w4.x, t2); t2 = __builtin_fmaf(v[j].y, w4.y, t2); t2 = __builtin_fmaf(v[j].z, w4.z, t2); t2 = __builtin_fmaf(v[j].w, w4.w, t2); }
                else { t = __builtin_fmaf(v[j].x, w4.x, t); t = __builtin_fmaf(v[j].y, w4.y, t); t = __builtin_fmaf(v[j].z, w4.z, t); t = __builtin_fmaf(v[j].w, w4.w, t); } }
            acc[h] = t + t2; }
#pragma unroll
        for (int i = 0; i < 8; ++i) { const bool hi = (lane & 32) != 0; const float send = hi ? acc[i] : acc[i + 8], keep = hi ? acc[i + 8] : acc[i]; acc[i] = keep + __shfl_xor(send, 32); }
#pragma unroll
        for (int i = 0; i < 4; ++i) { const bool hi = (lane & 16) != 0; const float send = hi ? acc[i] : acc[i + 4], keep = hi ? acc[i + 4] : acc[i]; acc[i] = keep + __shfl_xor(send, 16); }
#pragma unroll
        for (int i = 0; i < 2; ++i) { const bool hi = (lane & 8) != 0; const float send = hi ? acc[i] : acc[i + 2], keep = hi ? acc[i + 2] : acc[i]; acc[i] = keep + __shfl_xor(send, 8); }
        { const bool hi = (lane & 4) != 0; const float send = hi ? acc[0] : acc[1], keep = hi ? acc[1] : acc[0]; acc[0] = keep + __shfl_xor(send, 4); }
        float f = acc[0]; f += __shfl_xor(f, 2); f += __shfl_xor(f, 1);
        const int hh = lane >> 2;
        const float z = f + b_f[hh];
        const float lf = fminf(z, 0.f) - 0.6931471805599453f * __builtin_amdgcn_logf(1.0f + __builtin_amdgcn_exp2f(-1.4426950408889634f * fabsf(z)));
        if ((lane & 3) == 0) LF[(size_t)((m >> 12) * 16 + hh) * SEQ + (m & (SEQ - 1))] = lf;
    }
}

__device__ __forceinline__ void cumsum_phase(LAS unsigned char* lds, int tid, int lane, int wave) {
    KArgs a = kargs();
    const float* LF = (const float*)(a->ws + WS_LF); float* KB = (float*)(a->ws + WS_KB);
    LAS float* wsum = (LAS float*)(lds + MISC_OFF);
    for (int bh = blockIdx.x; bh < BATCH * H; bh += gridDim.x) {
        const float* src = LF + (size_t)bh * SEQ + 8 * tid;
        const f32x4 a0 = *(const f32x4*)src, a1 = *(const f32x4*)(src + 4);
        float p[8]; p[0] = a0.x; p[1] = p[0] + a0.y; p[2] = p[1] + a0.z; p[3] = p[2] + a0.w; p[4] = p[3] + a1.x; p[5] = p[4] + a1.y; p[6] = p[5] + a1.z; p[7] = p[6] + a1.w;
        float incl = p[7];
#pragma unroll
        for (int o = 1; o < 64; o <<= 1) { const float t = __shfl_up(incl, o); if (lane >= o) incl += t; }
        if (lane == 63) wsum[wave] = incl;
        __syncthreads();
        float off = incl - p[7];
        for (int w = 0; w < wave; ++w) off += wsum[w];
        f32x4 o0, o1;
        o0.x = -(p[0] + off) * 1.4426950408889634f; o0.y = -(p[1] + off) * 1.4426950408889634f; o0.z = -(p[2] + off) * 1.4426950408889634f; o0.w = -(p[3] + off) * 1.4426950408889634f;
        o1.x = -(p[4] + off) * 1.4426950408889634f; o1.y = -(p[5] + off) * 1.4426950408889634f; o1.z = -(p[6] + off) * 1.4426950408889634f; o1.w = -(p[7] + off) * 1.4426950408889634f;
        float* dst = KB + (size_t)bh * SEQ + 8 * tid;
        *(f32x4*)dst = o0; *(f32x4*)(dst + 4) = o1;
        __syncthreads();
    }
}

template <bool FROM_LDS> __device__ __forceinline__ void scan_phase(LAS unsigned char* lds, int lane, int wave, int vcu) {
    KArgs a = kargs();
    const float* SB = (const float*)(a->ws + WS_SBUF); bf16* AA = (bf16*)(a->ws + WS_AALL);
    LAS float* est = (LAS float*)(lds + (FROM_LDS ? 256 * pg8::SL_PITCH * 4 : RING_OFF));
    const LAS float* SL = (const LAS float*)(lds + RING_OFF);
    for (int w = vcu; w < NG * BATCH; w += gridDim.x) {
        const int g = w >> 2, b = w & 3, p = lane;
        const f32x4 lt = *(const f32x4*)((const float*)(a->ws + WS_LAMT) + (size_t)(g * 64 + p) * 4);
        const float l16r = lt.x, l16i = lt.y, l512r = lt.z, l512i = lt.w;
        const size_t row0 = (size_t)g * 1024 + b * 256 + 32 * wave;
        float sr[32], si[32];
#pragma unroll
        for (int i = 0; i < 32; ++i) { if (FROM_LDS) { sr[i] = SL[(32 * wave + i) * pg8::SL_PITCH + p]; si[i] = SL[(32 * wave + i) * pg8::SL_PITCH + 64 + p]; } else { sr[i] = SB[(row0 + i) * 128 + p]; si[i] = SB[(row0 + i) * 128 + 64 + p]; } }
        float xr = 0.f, xi = 0.f;
#pragma unroll
        for (int i = 0; i < 32; ++i) { const float nr = l16r * xr - l16i * xi + sr[i], ni = l16r * xi + l16i * xr + si[i]; xr = nr; xi = ni; sr[i] = xr; si[i] = xi; }
        est[(wave * 64 + p) * 2] = xr; est[(wave * 64 + p) * 2 + 1] = xi;
        __syncthreads();
        float pr = 0.f, pi = 0.f;
        for (int v = 0; v < wave; ++v) { const float er = est[(v * 64 + p) * 2], ei = est[(v * 64 + p) * 2 + 1]; const float nr = l512r * pr - l512i * pi + er, ni = l512r * pi + l512i * pr + ei; pr = nr; pi = ni; }
        float qr = 0.f, qi = 0.f;
#pragma unroll
        for (int i = 0; i < 32; ++i) { bf16* dst = AA + (row0 + i) * KA + 256 + p;
            { const unsigned pkd = pk2(qr + pr, qi + pi); dst[0] = (bf16)(pkd & 0xffffu); dst[64] = (bf16)(pkd >> 16); }
            qr = sr[i]; qi = si[i];
            const float nr = l16r * pr - l16i * pi, ni = l16r * pi + l16i * pr; pr = nr; pi = ni; }
        __syncthreads();
    }
}

__global__ void __launch_bounds__(NWAVES * 64, 2) fwd_megakernel(Args args) {
    extern __shared__ __attribute__((aligned(16))) unsigned char lds_raw[];
    cg::grid_group grid = cg::this_grid();
    LAS unsigned char* lds = (LAS unsigned char*)lds_raw;
    const int tid = threadIdx.x, lane = tid & 63, wave = __builtin_amdgcn_readfirstlane(tid >> 6);
    const int G = gridDim.x; const int bx = blockIdx.x; const int vcu = (G % 8 == 0) ? (bx % 8) * (G / 8) + bx / 8 : bx;
    const int lo = kargs()->ph_lo, hi = kargs()->ph_hi;
#define ws (kargs()->ws)
#define AIN(k) (kargs()->in[k])
#define AOUT (kargs()->out)
#ifndef ONLY
#define ONLY -1
#endif
#define IN(k) ((ONLY < 0 || ONLY == (k)) && lo <= (k) && (k) < hi)
#define WG_SEAM() do { asm volatile("s_waitcnt vmcnt(0) lgkmcnt(0)" ::: "memory"); __syncthreads(); if (wave == 0) { __builtin_amdgcn_fence(__ATOMIC_ACQUIRE, "agent"); asm volatile("s_waitcnt vmcnt(0)" ::: "memory"); } __syncthreads(); } while (0)
#define SEAM(k) do { if (IN(k) && IN((k) + 1)) { xcd_barrier(xbar); } } while (0)
#define rowss ((float*)(ws + WS_CTL))
#define XN ((bf16*)(ws + WS_XN))
#define HB ((bf16*)(ws + WS_H))

    if (tid < 32) ((LAS unsigned*)(lds + MISC_OFF))[tid] = 0u;
    if (bx == 0) { unsigned* bw = (unsigned*)(ws + WS_BAR); for (int i = tid; i < XCD_BAR_WORDS; i += NWAVES * 64) bw[i] = 0u; if (tid < 9) bw[4096 + 64 * tid] = 0u; }
    grid.sync();
    XcdBarrier xbar = xcd_barrier_post((unsigned*)(ws + WS_BAR), (volatile LAS unsigned*)(lds + MISC_OFF) + 8);
    if (IN(0)) { p0_prologue(lds, tid, lane, wave, vcu, G); }
    SEAM(0);
    if (IN(1)) cumsum_phase(lds, tid, lane, wave);
    if (IN(1)) {
        pg8::Gemm g{XN, (const bf16*)(ws + WS_WQKV), M, NQKV, D, D, D}; pg8::StaticOrder S; S.init(M, NQKV, G, bx);
        { LAS float* gl = (LAS float*)(lds + MISC_OFF + 1024); if (tid < 64) gl[tid] = AIN(5)[tid] * attn_body::C2; else if (tid < 128) gl[tid] = AIN(6)[tid - 64]; __syncthreads(); }
        pg8::EpiQKV E{(bf16*)(ws + WS_QO), (size_t)(WS_K - WS_QO) / 2, (PG8_LAS const float*)(lds + MISC_OFF + 1024)};
        pg8::gemm_phase(lds + RING_OFF, g, S, E);
    }
    SEAM(1);
    if (IN(2)) {
        const attn_body::AttnTensors AT{(const attn_body::bf16*)(ws + WS_QO), (const attn_body::bf16*)(ws + WS_K), (const attn_body::bf16*)(ws + WS_V), (attn_body::bf16*)(ws + WS_O), (const float*)(ws + WS_KB), AIN(5), AIN(6)};
        const attn_body::StaticOrder S(G, bx);
        attn_body::attn_phase<attn_body::StaticOrder>((char*)lds_raw + RING_OFF, AT, S, (unsigned*)(ws + WS_BAR) + 4096, (volatile LAS unsigned*)(lds + MISC_OFF) + 16, xbar.x);
        ssm_setup(lds, tid, (unsigned*)(ws + WS_BAR) + 4096 + 64 * 8, (volatile LAS unsigned*)(lds + MISC_OFF) + 18);
    }
    SEAM(2);
    if (IN(3)) {
        pg8::Gemm g{(const bf16*)(ws + WS_O), (const bf16*)(ws + WS_WO), M, D, D, D, D}; pg8::StaticOrder S; S.init(M, D, G, bx);
        pg8::EpiResid E{nullptr, XN, nullptr, XN, rowss, rowss + 3 * M, AIN(1), nullptr};
        pg8::gemm_phase(lds + RING_OFF, g, S, E);
    }
    SEAM(3);
    if (IN(4)) {
        pg8::Gemm g{XN, (const bf16*)(ws + WS_W1A), M, FF, D, D, D}; pg8::StaticOrder S; S.init(M, FF, G, bx);
        pg8::EpiSqrelu E{HB, FF};
        pg8::gemm_phase(lds + RING_OFF, g, S, E);
    }
    SEAM(4);
    if (IN(5)) {
        pg8::Gemm g{HB, (const bf16*)(ws + WS_W2A), M, D, FF, FF, FF}; pg8::StaticOrder S; S.init(M, D, G, bx);
        pg8::EpiResid E{nullptr, XN, nullptr, XN, rowss + M, nullptr, nullptr, rowss};
        pg8::gemm_phase(lds + RING_OFF, g, S, E);
    }
    SEAM(5);
    if (IN(6)) {
        pg8::Gemm g{XN, (const bf16*)(ws + WS_WSSM), M, D, D, D, D}; pg8::StaticOrder S; S.init(M, D, G, bx);
        pg8::EpiU E{(bf16*)(ws + WS_AALL), rowss + M};
        pg8::gemm_phase(lds + RING_OFF, g, S, E);
    }
    SEAM(6);
    if (G == NG * BATCH) {
        if (IN(7)) {
            pg8::Gemm g{(const bf16*)(ws + WS_AALL), (const bf16*)(ws + WS_WT1), NG * 1024, 256, 256, KA, 256}; pg8::BatchOrder S; S.init(NG * 4, G, vcu);
            pg8::EpiSLds E{(PG8_LAS float*)(lds + RING_OFF)};
            pg8::gemm_phase(lds + RING_OFF, g, S, E);
        }
        __syncthreads();
        if (IN(8)) scan_phase<true>(lds, lane, wave, vcu);
        WG_SEAM();
    } else {
        if (IN(7)) {
            pg8::Gemm g{(const bf16*)(ws + WS_AALL), (const bf16*)(ws + WS_WT1), NG * 1024, 256, 256, KA, 256}; pg8::BatchOrder S; S.init(NG * 4, G, vcu);
            pg8::EpiS E{(float*)(ws + WS_SBUF)};
            pg8::gemm_phase(lds + RING_OFF, g, S, E);
        }
        SEAM(7);
        if (IN(8)) scan_phase<false>(lds, lane, wave, vcu);
        SEAM(8);
    }
    if (IN(9)) {
        pg8::Gemm g{(const bf16*)(ws + WS_AALL), (const bf16*)(ws + WS_BT3), NG * 1024, 256, KA, KA, KA}; pg8::BatchOrder S; S.init(NG * 4, G, vcu);
        pg8::EpiY E{(bf16*)(ws + WS_Z)};
        pg8::gemm_phase(lds + RING_OFF, g, S, E);
    }
    SEAM(9);
    if (IN(10)) {
        pg8::Gemm g{(const bf16*)(ws + WS_Z), (const bf16*)(ws + WS_WGLU), M, 2 * D, D, D, D}; pg8::StaticOrder S; S.init(M, 2 * D, G, bx);
        pg8::EpiGlu E{XN, rowss + 2 * M};
        pg8::gemm_phase(lds + RING_OFF, g, S, E);
    }
    SEAM(10);
    if (IN(11)) {
        pg8::Gemm g{XN, (const bf16*)(ws + WS_W1B), M, FF, D, D, D}; pg8::StaticOrder S; S.init(M, FF, G, bx);
        pg8::EpiSqrelu E{HB, FF};
        pg8::gemm_phase(lds + RING_OFF, g, S, E);
    }
    SEAM(11);
    if (IN(12)) {
        pg8::Gemm g{HB, (const bf16*)(ws + WS_W2B), M, D, FF, FF, FF}; pg8::StaticOrder S; S.init(M, D, G, bx);
        pg8::EpiResid E{nullptr, XN, AOUT, nullptr, nullptr, nullptr, nullptr, rowss + 2 * M};
        pg8::gemm_phase(lds + RING_OFF, g, S, E);
    }
#undef IN
#undef SEAM
#undef ws
#undef AIN
#undef AOUT
#undef rowss
#undef XN
#undef HB
}

extern "C" void kernel_launch(void* const* d_in, const int* in_sizes, int n_in, void* d_out, int out_size, void* d_ws, size_t ws_size, hipStream_t stream) {
    static int grid = 0;
    if (grid == 0) {
        if (n_in != 20 || in_sizes[0] != M * D || out_size != M * D || ws_size < WS_END) { fprintf(stderr, "kernel_launch: unexpected shapes (n_in %d, in0 %d, out %d, ws %zu)\n", n_in, n_in > 0 ? in_sizes[0] : -1, out_size, ws_size); grid = -1; return; }
        int dev = 0, cus = 0, per_cu = 0;
        if (hipGetDevice(&dev) != hipSuccess || hipDeviceGetAttribute(&cus, hipDeviceAttributeMultiprocessorCount, dev) != hipSuccess) { grid = -1; return; }
        if (hipFuncSetAttribute((const void*)fwd_megakernel, hipFuncAttributeMaxDynamicSharedMemorySize, LDS_BYTES) != hipSuccess) { fprintf(stderr, "kernel_launch: hipFuncSetAttribute failed\n"); grid = -1; return; }
        if (hipOccupancyMaxActiveBlocksPerMultiprocessor(&per_cu, (const void*)fwd_megakernel, NWAVES * 64, LDS_BYTES) != hipSuccess || per_cu < 1) { fprintf(stderr, "kernel_launch: occupancy query reports %d workgroups per CU\n", per_cu); (void)hipGetLastError(); per_cu = 1; }
        grid = cus;
        if (grid != 256) fprintf(stderr, "kernel_launch: %d CUs; the attention unit order expects 256\n", grid);
    }
    if (grid < 0) return;
    Args a{};
    for (int i = 0; i < 20; ++i) a.in[i] = (const float*)d_in[i];
    a.out = (float*)d_out; a.ws = (unsigned char*)d_ws; a.ph_lo = 0; a.ph_hi = 13;
    void* params[] = {&a};
    const hipError_t le = hipLaunchCooperativeKernel((const void*)fwd_megakernel, dim3(grid), dim3(NWAVES * 64), params, LDS_BYTES, stream);
    if (le != hipSuccess) fprintf(stderr, "kernel_launch: cooperative launch failed: %s (grid %d)\n", hipGetErrorName(le), grid);
}
```
